# Optimizing an MI355X kernel written in HIP

```python
import jax, jax.numpy as jnp
from jax import lax
import numpy as np

D_MODEL = 1024
BATCH = 2
SEQ = 8192
DEPTH = 1

N_META = 16
CONV_CH = 512
CONV_WIDTH = 31
N_HEADS = 8
HEAD_DIM = 64
ATTN_W = N_HEADS * HEAD_DIM
MIX_W = CONV_CH + ATTN_W
IDX_HEADS = 8
IDX_DIM = 64
INDEX_TOPK = 256
Q_BLOCK = 128
ROPE_DIM = HEAD_DIM // 4
ROPE_THETA = 500000.0
N_EXPERTS = 64
TOP_K = 8
N_GROUPS = 8
TOPK_GROUPS = 4
D_EXPERT = 256
D_SHARED = 256
ROUTED_SCALE = 2.5
EXPERT_BLOCK = 256
LN_EPS = 1e-5
DN_ALPHA = (2.0 * DEPTH) ** 0.25
DN_BETA = (8.0 * DEPTH) ** -0.25
SPLIT_SIZES = (CONV_CH, CONV_CH, ATTN_W, ATTN_W, ATTN_W, IDX_HEADS * IDX_DIM, IDX_DIM, IDX_HEADS)
IN_W = sum(SPLIT_SIZES)
SPLIT_POINTS = [int(v) for v in np.cumsum(SPLIT_SIZES)[:-1]]

kernel_name = 'hymba_conformer_dsa_moe_deepnorm'


def layer_norm(x, g, b):
    xf = x.astype(jnp.float32)
    mu = jnp.mean(xf, axis=-1, keepdims=True)
    xc = xf - mu
    var = jnp.mean(xc * xc, axis=-1, keepdims=True)
    y = xc * lax.rsqrt(var + LN_EPS) * g.astype(jnp.float32) + b.astype(jnp.float32)
    return y.astype(x.dtype)


def rope_partial(x, pos):
    half = ROPE_DIM // 2
    inv = jnp.power(ROPE_THETA, -2.0 * jnp.arange(half, dtype=jnp.float32) / ROPE_DIM)
    ang = pos[:, None] * inv[None, :]
    cos = jnp.cos(ang)[:, None, :]
    sin = jnp.sin(ang)[:, None, :]
    xr = x[..., :ROPE_DIM].astype(jnp.float32)
    x1, x2 = xr[..., :half], xr[..., half:]
    rot = jnp.concatenate([x1 * cos - x2 * sin, x2 * cos + x1 * sin], axis=-1).astype(x.dtype)
    return jnp.concatenate([rot, x[..., ROPE_DIM:]], axis=-1)


def conformer_conv_group(a, g, conv_w, conv_b, lnc_g, lnc_b):
    u = a * jax.nn.sigmoid(g)
    u = lax.conv_general_dilated(u, conv_w[:, None, :].astype(u.dtype), (1,),
                                 [(CONV_WIDTH - 1, 0)],
                                 dimension_numbers=('NWC', 'WIO', 'NWC'),
                                 feature_group_count=CONV_CH) + conv_b
    return jax.nn.silu(layer_norm(u, lnc_g, lnc_b))


def dsa_attention(q, k, v, qi, ki, wi, k_sel):
    B, T = k.shape[0], k.shape[1]
    nb = -(-T // Q_BLOCK)
    pad = nb * Q_BLOCK - T

    def to_blocks(t):
        t = jnp.pad(t, [(0, 0), (0, pad)] + [(0, 0)] * (t.ndim - 2))
        return jnp.moveaxis(t.reshape((B, nb, Q_BLOCK) + t.shape[2:]), 1, 0)

    qpos = jnp.arange(nb * Q_BLOCK).reshape(nb, Q_BLOCK)
    kpos = jnp.arange(T)
    ki32 = ki.astype(jnp.float32)
    bidx = jnp.arange(B)[:, None, None]

    def one_block(args):
        qb, qib, wib, qp = args
        s = jnp.einsum('bqhd,bkd->bqhk', qib.astype(jnp.float32), ki32)
        score = jnp.einsum('bqh,bqhk->bqk', wib.astype(jnp.float32), jax.nn.relu(s)) * (IDX_DIM ** -0.5)
        causal = kpos[None, :] <= qp[:, None]
        score = jnp.where(causal[None], score, -jnp.inf)
        _, sel = lax.top_k(score, k_sel)
        valid = sel <= qp[None, :, None]
        kg = k[bidx, sel]
        vg = v[bidx, sel]
        logits = jnp.einsum('bqhd,bqkhd->bqhk', qb.astype(jnp.float32), kg.astype(jnp.float32)) * (HEAD_DIM ** -0.5)
        logits = jnp.where(valid[:, :, None, :], logits, -jnp.inf)
        p = jax.nn.softmax(logits, axis=-1)
        return jnp.einsum('bqhk,bqkhd->bqhd', p.astype(v.dtype), vg)

    out = lax.map(one_block, (to_blocks(q), to_blocks(qi), to_blocks(wi), qpos))
    out = jnp.moveaxis(out, 0, 1).reshape(B, nb * Q_BLOCK, ATTN_W)
    return out[:, :T]


def hybrid_mixer(h, w_in, conv_w, conv_b, lnc_g, lnc_b, lnk_g, lnk_b, w_out, k_sel):
    B, T, _ = h.shape
    proj = h @ w_in
    a, g, q, k, v, qi, ki, wi = jnp.split(proj, SPLIT_POINTS, axis=-1)
    conv_out = conformer_conv_group(a, g, conv_w, conv_b, lnc_g, lnc_b)
    pos = jnp.arange(T, dtype=jnp.float32)
    q = rope_partial(q.reshape(B, T, N_HEADS, HEAD_DIM), pos)
    k = rope_partial(k.reshape(B, T, N_HEADS, HEAD_DIM), pos)
    v = v.reshape(B, T, N_HEADS, HEAD_DIM)
    qi = rope_partial(qi.reshape(B, T, IDX_HEADS, IDX_DIM), pos)
    ki = rope_partial(layer_norm(ki, lnk_g, lnk_b)[:, :, None, :], pos)[:, :, 0, :]
    wi = wi * (IDX_HEADS ** -0.5)
    attn_out = dsa_attention(q, k, v, qi, ki, wi, k_sel)
    return jnp.concatenate([conv_out, attn_out.astype(conv_out.dtype)], axis=-1) @ w_out


def route(xf, w_router, r_bias):
    N = xf.shape[0]
    scores = jax.nn.sigmoid(xf.astype(jnp.float32) @ w_router.astype(jnp.float32))
    biased = scores + r_bias.astype(jnp.float32)
    grp = biased.reshape(N, N_GROUPS, N_EXPERTS // N_GROUPS)
    grp_score = jnp.sum(lax.top_k(grp, 2)[0], axis=-1)
    _, top_g = lax.top_k(grp_score, TOPK_GROUPS)
    gmask = jnp.any(top_g[:, :, None] == jnp.arange(N_GROUPS)[None, None, :], axis=1)
    emask = jnp.repeat(gmask, N_EXPERTS // N_GROUPS, axis=1)
    _, idx = lax.top_k(jnp.where(emask, biased, -jnp.inf), TOP_K)
    w = jnp.take_along_axis(scores, idx, axis=1)
    w = w / jnp.sum(w, axis=-1, keepdims=True) * ROUTED_SCALE
    return idx, w


def routed_experts(xf, idx, wts, w_gate, w_up, w_down):
    N, D = xf.shape
    NK = N * TOP_K
    e_flat = idx.reshape(NK)
    order = jnp.argsort(e_flat)
    e_sorted = e_flat[order]
    tok_sorted = (order // TOP_K).astype(jnp.int32)
    w_sorted = wts.reshape(NK)[order]
    counts = jnp.bincount(e_flat, length=N_EXPERTS)
    padded = (counts + EXPERT_BLOCK - 1) // EXPERT_BLOCK * EXPERT_BLOCK
    pad_end = jnp.cumsum(padded)
    pad_start = pad_end - padded
    start = jnp.cumsum(counts) - counts
    dest = pad_start[e_sorted] + jnp.arange(NK) - start[e_sorted]
    n_blocks = -(-NK // EXPERT_BLOCK) + N_EXPERTS
    P = n_blocks * EXPERT_BLOCK
    buf_tok = jnp.zeros((P,), jnp.int32).at[dest].set(tok_sorted)
    buf_w = jnp.zeros((P,), wts.dtype).at[dest].set(w_sorted)
    blk_exp = jnp.minimum(jnp.searchsorted(pad_end, jnp.arange(n_blocks) * EXPERT_BLOCK, side='right'),
                          N_EXPERTS - 1)

    def one(args):
        tok, wt, e = args
        xb = xf[tok]
        hdn = jax.nn.silu(xb @ w_gate[e]) * (xb @ w_up[e])
        return (hdn @ w_down[e]) * wt[:, None].astype(xf.dtype)

    ys = lax.map(one, (buf_tok.reshape(n_blocks, EXPERT_BLOCK),
                       buf_w.reshape(n_blocks, EXPERT_BLOCK), blk_exp))
    return jnp.zeros_like(xf).at[buf_tok].add(ys.reshape(P, D))


def moe_ffn(h, w_router, r_bias, w_gate, w_up, w_down, ws_gate, ws_up, ws_down):
    B, T, D = h.shape
    xf = h.reshape(B * T, D)
    idx, wts = route(xf, w_router, r_bias)
    routed = routed_experts(xf, idx, wts, w_gate, w_up, w_down)
    shared = (jax.nn.silu(xf @ ws_gate) * (xf @ ws_up)) @ ws_down
    return (routed + shared).reshape(B, T, D)


def setup_inputs(seed: int = 0) -> dict:
    key = jax.random.key(seed)
    ks = jax.random.split(key, 26)
    L = DEPTH
    f32 = jnp.float32

    def nrm(k, shape, s):
        return jax.random.normal(k, shape, f32) * s

    return {
        'x': nrm(ks[0], (BATCH, SEQ, D_MODEL), 1.0),
        'meta_tokens': nrm(ks[1], (N_META, D_MODEL), 1.0),
        'ln_emb_g': 1.0 + nrm(ks[2], (D_MODEL,), 0.02),
        'ln_emb_b': nrm(ks[3], (D_MODEL,), 0.02),
        'w_in': nrm(ks[4], (L, D_MODEL, IN_W), D_MODEL ** -0.5),
        'conv_w': nrm(ks[5], (L, CONV_WIDTH, CONV_CH), CONV_WIDTH ** -0.5),
        'conv_b': nrm(ks[6], (L, CONV_CH), 0.02),
        'ln_conv_g': 1.0 + nrm(ks[7], (L, CONV_CH), 0.02),
        'ln_conv_b': nrm(ks[8], (L, CONV_CH), 0.02),
        'ln_kidx_g': 1.0 + nrm(ks[9], (L, IDX_DIM), 0.02),
        'ln_kidx_b': nrm(ks[10], (L, IDX_DIM), 0.02),
        'w_out': nrm(ks[11], (L, MIX_W, D_MODEL), DN_BETA * MIX_W ** -0.5),
        'ln1_g': 1.0 + nrm(ks[12], (L, D_MODEL), 0.02),
        'ln1_b': nrm(ks[13], (L, D_MODEL), 0.02),
        'w_router': nrm(ks[14], (L, D_MODEL, N_EXPERTS), D_MODEL ** -0.5),
        'router_bias': nrm(ks[15], (L, N_EXPERTS), 0.01),
        'w_gate': nrm(ks[16], (L, N_EXPERTS, D_MODEL, D_EXPERT), D_MODEL ** -0.5),
        'w_up': nrm(ks[17], (L, N_EXPERTS, D_MODEL, D_EXPERT), D_MODEL ** -0.5),
        'w_down': nrm(ks[18], (L, N_EXPERTS, D_EXPERT, D_MODEL), DN_BETA * D_EXPERT ** -0.5),
        'ws_gate': nrm(ks[19], (L, D_MODEL, D_SHARED), D_MODEL ** -0.5),
        'ws_up': nrm(ks[20], (L, D_MODEL, D_SHARED), D_MODEL ** -0.5),
        'ws_down': nrm(ks[21], (L, D_SHARED, D_MODEL), DN_BETA * D_SHARED ** -0.5),
        'ln2_g': 1.0 + nrm(ks[22], (L, D_MODEL), 0.02),
        'ln2_b': nrm(ks[23], (L, D_MODEL), 0.02),
    }


def reference(x, meta_tokens, ln_emb_g, ln_emb_b, w_in, conv_w, conv_b, ln_conv_g, ln_conv_b,
              ln_kidx_g, ln_kidx_b, w_out, ln1_g, ln1_b, w_router, router_bias, w_gate, w_up,
              w_down, ws_gate, ws_up, ws_down, ln2_g, ln2_b):
    B, L_seq, D = x.shape
    k_sel = min(INDEX_TOPK, L_seq // 4)
    meta = jnp.broadcast_to(meta_tokens[None].astype(x.dtype), (B, N_META, D))
    h = jnp.concatenate([meta, x], axis=1)
    h = layer_norm(h, ln_emb_g, ln_emb_b)
    for l in range(DEPTH):
        mix = hybrid_mixer(h, w_in[l], conv_w[l], conv_b[l], ln_conv_g[l], ln_conv_b[l],
                           ln_kidx_g[l], ln_kidx_b[l], w_out[l], k_sel)
        h = layer_norm(DN_ALPHA * h + mix, ln1_g[l], ln1_b[l])
        ffn = moe_ffn(h, w_router[l], router_bias[l], w_gate[l], w_up[l], w_down[l],
                      ws_gate[l], ws_up[l], ws_down[l])
        h = layer_norm(DN_ALPHA * h + ffn, ln2_g[l], ln2_b[l])
    return h[:, N_META:]
```

```cpp
#include <hip/hip_runtime.h>
#include <cstdint>
#include <cstdio>
#include <cmath>

constexpr int D = 1024, NB = 2, SEQ = 8192, NMETA = 16, TP = SEQ + NMETA;
constexpr int NR = NB * SEQ;
constexpr int NROWS = NR + NB * NMETA;
constexpr int CONV_CH = 512, CONV_W = 31, NH = 8, HD = 64, IH = 8, IDD = 64, TOPK = 256;
constexpr int IN_W = 3144;
constexpr int OFF_A = 0, OFF_G = 512, OFF_Q = 1024, OFF_K = 1536, OFF_V = 2048, OFF_QI = 2560, OFF_KI = 3072, OFF_WI = 3136;
constexpr int NE = 64, TOPE = 8, DE = 256;
constexpr float LN_EPS = 1e-5f;
constexpr float DN_ALPHA = 1.189207115002721f;
constexpr float ROUTED_SCALE = 2.5f;

__device__ __forceinline__ int row_of(int b, int t) { return t < NMETA ? NR + b * NMETA + t : b * SEQ + (t - NMETA); }
__device__ __forceinline__ void row_bt(int m, int& b, int& t) { if (m < NR) { b = m >> 13; t = (m & (SEQ - 1)) + NMETA; } else { b = (m - NR) >> 4; t = (m - NR) & 15; } }

__device__ __forceinline__ float wave_sum(float v) {
#pragma unroll
  for (int o = 32; o > 0; o >>= 1) v += __shfl_xor(v, o);
  return v;
}
__device__ __forceinline__ float sigmoidf_(float x) { return 1.0f / (1.0f + expf(-x)); }

__global__ void __launch_bounds__(256) k_ln_emb(const float* __restrict__ x, const float* __restrict__ meta, const float* __restrict__ g, const float* __restrict__ bb,
                                                float* __restrict__ h0, float2* __restrict__ st0) {
  const int lane = threadIdx.x & 63, m = blockIdx.x * 4 + (threadIdx.x >> 6);
  if (m >= NROWS) return;
  const float* src = m < NR ? x + (size_t)m * D : meta + (size_t)((m - NR) & 15) * D;
  float v[16]; float s = 0.f;
#pragma unroll
  for (int i = 0; i < 16; ++i) { v[i] = src[i * 64 + lane]; s += v[i]; }
  const float mu = wave_sum(s) * (1.0f / D);
  float q = 0.f;
#pragma unroll
  for (int i = 0; i < 16; ++i) { const float d = v[i] - mu; q += d * d; }
  const float rstd = rsqrtf(wave_sum(q) * (1.0f / D) + LN_EPS);
#pragma unroll
  for (int i = 0; i < 16; ++i) { const int c = i * 64 + lane; h0[(size_t)m * D + c] = (v[i] - mu) * rstd * g[c] + bb[c]; }
  if (lane == 0) st0[m] = make_float2(mu, rstd);
}

__global__ void __launch_bounds__(256) k_gemm_f32(const float* __restrict__ A, const float* __restrict__ W, float* __restrict__ C, int M, int N, int K, int lda, int ldw, int ldc) {
  __shared__ float As[16][68];
  __shared__ float Bs[16][68];
  const int tid = threadIdx.x, tx = tid & 15, ty = tid >> 4;
  const int m0 = blockIdx.y * 64, n0 = blockIdx.x * 64;
  float acc[4][4];
#pragma unroll
  for (int i = 0; i < 4; ++i)
#pragma unroll
    for (int j = 0; j < 4; ++j) acc[i][j] = 0.f;
  const int ar = tid >> 2, ak = (tid & 3) * 4;
  const int bk = tid >> 4, bc = (tid & 15) * 4;
  for (int k0 = 0; k0 < K; k0 += 16) {
    float4 a = make_float4(0.f, 0.f, 0.f, 0.f), b = make_float4(0.f, 0.f, 0.f, 0.f);
    if (m0 + ar < M) a = *(const float4*)(A + (size_t)(m0 + ar) * lda + k0 + ak);
    if (n0 + bc < N) b = *(const float4*)(W + (size_t)(k0 + bk) * ldw + n0 + bc);
    __syncthreads();
    As[ak + 0][ar] = a.x; As[ak + 1][ar] = a.y; As[ak + 2][ar] = a.z; As[ak + 3][ar] = a.w;
    *(float4*)&Bs[bk][bc] = b;
    __syncthreads();
#pragma unroll
    for (int kk = 0; kk < 16; ++kk) {
      const float4 av = *(const float4*)&As[kk][ty * 4];
      const float4 bv = *(const float4*)&Bs[kk][tx * 4];
      const float aa[4] = {av.x, av.y, av.z, av.w}, bbv[4] = {bv.x, bv.y, bv.z, bv.w};
#pragma unroll
      for (int i = 0; i < 4; ++i)
#pragma unroll
        for (int j = 0; j < 4; ++j) acc[i][j] += aa[i] * bbv[j];
    }
  }
#pragma unroll
  for (int i = 0; i < 4; ++i) {
    const int r = m0 + ty * 4 + i; if (r >= M) continue;
    const int c = n0 + tx * 4; if (c >= N) continue;
    *(float4*)(C + (size_t)r * ldc + c) = make_float4(acc[i][0], acc[i][1], acc[i][2], acc[i][3]);
  }
}

struct RopeInv { float v[8]; };
__device__ __forceinline__ void rope16(float* p, int t, const RopeInv& inv) {
#pragma unroll
  for (int i = 0; i < 8; ++i) {
    const float ang = (float)t * inv.v[i]; float sn, cs; sincosf(ang, &sn, &cs);
    const float x1 = p[i], x2 = p[i + 8];
    p[i] = x1 * cs - x2 * sn; p[i + 8] = x2 * cs + x1 * sn;
  }
}
__global__ void __launch_bounds__(64) k_post_proj(float* __restrict__ proj, const float* __restrict__ lnk_g, const float* __restrict__ lnk_b, RopeInv inv) {
  const int m = blockIdx.x, l = threadIdx.x; int b, t; row_bt(m, b, t);
  float* row = proj + (size_t)m * IN_W;
  if (l < 8) rope16(row + OFF_Q + l * HD, t, inv);
  else if (l < 16) rope16(row + OFF_K + (l - 8) * HD, t, inv);
  else if (l < 24) rope16(row + OFF_QI + (l - 16) * IDD, t, inv);
  else if (l == 24) {
    float* ki = row + OFF_KI; float s = 0.f;
    for (int i = 0; i < IDD; ++i) s += ki[i];
    const float mu = s * (1.0f / IDD); float q = 0.f;
    for (int i = 0; i < IDD; ++i) { const float d = ki[i] - mu; q += d * d; }
    const float rstd = rsqrtf(q * (1.0f / IDD) + LN_EPS);
    for (int i = 0; i < IDD; ++i) ki[i] = (ki[i] - mu) * rstd * lnk_g[i] + lnk_b[i];
    rope16(ki, t, inv);
  } else if (l == 25) {
    for (int i = 0; i < IH; ++i) row[OFF_WI + i] *= 0.35355339059327373f;
  }
}

__global__ void __launch_bounds__(512) k_conv(const float* __restrict__ proj, const float* __restrict__ conv_w, const float* __restrict__ conv_b,
                                              const float* __restrict__ lg, const float* __restrict__ lb, float* __restrict__ mix) {
  __shared__ float red[16];
  const int m = blockIdx.x, c = threadIdx.x, b = m >> 13, t = (m & (SEQ - 1)) + NMETA;
  float acc = conv_b[c];
  for (int w = 0; w < CONV_W; ++w) {
    const int tt = t - (CONV_W - 1) + w; if (tt < 0) continue;
    const float* r = proj + (size_t)row_of(b, tt) * IN_W;
    const float u = r[OFF_A + c] * sigmoidf_(r[OFF_G + c]);
    acc += conv_w[w * CONV_CH + c] * u;
  }
  float s = wave_sum(acc);
  if ((c & 63) == 0) red[c >> 6] = s;
  __syncthreads();
  float tot = 0.f;
  for (int i = 0; i < 8; ++i) tot += red[i];
  const float mu = tot * (1.0f / CONV_CH), d = acc - mu;
  float q = wave_sum(d * d);
  if ((c & 63) == 0) red[8 + (c >> 6)] = q;
  __syncthreads();
  float tq = 0.f;
  for (int i = 0; i < 8; ++i) tq += red[8 + i];
  const float y = d * rsqrtf(tq * (1.0f / CONV_CH) + LN_EPS) * lg[c] + lb[c];
  mix[(size_t)m * D + c] = y * sigmoidf_(y);
}

__device__ __forceinline__ unsigned fkey(float f) { unsigned u = __float_as_uint(f); return (u & 0x80000000u) ? ~u : (u | 0x80000000u); }
__global__ void __launch_bounds__(256) k_topk(const float* __restrict__ proj, unsigned short* __restrict__ sel, int* __restrict__ selcnt) {
  __shared__ float qs[IH * IDD];
  __shared__ float wsm[IH];
  __shared__ unsigned keys[TP];
  __shared__ int cnts[256];
  __shared__ int scan_a[256], scan_b[256];
  const int m = blockIdx.x, tid = threadIdx.x, b = m >> 13, t = (m & (SEQ - 1)) + NMETA, n = t + 1;
  const float* qrow = proj + (size_t)m * IN_W;
  for (int i = tid; i < IH * IDD; i += 256) qs[i] = qrow[OFF_QI + i];
  if (tid < IH) wsm[tid] = qrow[OFF_WI + tid];
  __syncthreads();
  for (int c = tid; c < n; c += 256) {
    const float* kr = proj + (size_t)row_of(b, c) * IN_W + OFF_KI;
    float kv[IDD];
#pragma unroll
    for (int i = 0; i < IDD; i += 4) { const float4 v = *(const float4*)(kr + i); kv[i] = v.x; kv[i + 1] = v.y; kv[i + 2] = v.z; kv[i + 3] = v.w; }
    float sc = 0.f;
#pragma unroll
    for (int h = 0; h < IH; ++h) {
      float s = 0.f;
#pragma unroll
      for (int i = 0; i < IDD; ++i) s += qs[h * IDD + i] * kv[i];
      sc += wsm[h] * fmaxf(s, 0.f);
    }
    keys[c] = fkey(sc * 0.125f);
  }
  __syncthreads();
  unsigned short* out = sel + (size_t)m * TOPK;
  if (n <= TOPK) {
    for (int c = tid; c < TOPK; c += 256) out[c] = (unsigned short)(c < n ? c : 0);
    if (tid == 0) selcnt[m] = n;
    return;
  }
  unsigned lo = 0u;
  for (int bit = 31; bit >= 0; --bit) {
    const unsigned cand = lo | (1u << bit);
    int c0 = 0;
    for (int c = tid; c < n; c += 256) c0 += (keys[c] >= cand) ? 1 : 0;
    c0 = (int)wave_sum((float)c0);
    __syncthreads();
    if ((tid & 63) == 0) cnts[tid >> 6] = c0;
    __syncthreads();
    const int tot = cnts[0] + cnts[1] + cnts[2] + cnts[3];
    if (tot >= TOPK) lo = cand;
  }
  const unsigned T = lo;
  const int chunk = (n + 255) / 256, c_lo = tid * chunk, c_hi = min(n, c_lo + chunk);
  int ngt = 0, neq = 0;
  for (int c = c_lo; c < c_hi; ++c) { const unsigned k = keys[c]; ngt += (k > T); neq += (k == T); }
  scan_a[tid] = ngt; scan_b[tid] = neq;
  __syncthreads();
  if (tid == 0) { int a = 0, e = 0; for (int i = 0; i < 256; ++i) { const int x = scan_a[i], y = scan_b[i]; scan_a[i] = a; scan_b[i] = e; a += x; e += y; } cnts[0] = a; }
  __syncthreads();
  const int total_gt = cnts[0], need_eq = TOPK - total_gt;
  int pg = scan_a[tid], pe = scan_b[tid];
  for (int c = c_lo; c < c_hi; ++c) {
    const unsigned k = keys[c];
    if (k > T) { out[pg + min(pe, need_eq)] = (unsigned short)c; ++pg; }
    else if (k == T) { if (pe < need_eq) out[pg + pe] = (unsigned short)c; ++pe; }
  }
  if (tid == 0) selcnt[m] = TOPK;
}

__global__ void __launch_bounds__(256) k_attn(const float* __restrict__ proj, const unsigned short* __restrict__ sel, const int* __restrict__ selcnt, float* __restrict__ mix) {
  __shared__ float qs[NH * HD];
  __shared__ float lg[NH][TOPK];
  __shared__ int rows[TOPK];
  const int m = blockIdx.x, tid = threadIdx.x, b = m >> 13, cnt = selcnt[m];
  for (int i = tid; i < NH * HD; i += 256) qs[i] = proj[(size_t)m * IN_W + OFF_Q + i];
  rows[tid] = tid < cnt ? row_of(b, (int)sel[(size_t)m * TOPK + tid]) : 0;
  __syncthreads();
  if (tid < cnt) {
    const float* kr = proj + (size_t)rows[tid] * IN_W + OFF_K;
    for (int h = 0; h < NH; ++h) {
      float s = 0.f;
      for (int i = 0; i < HD; i += 4) { const float4 v = *(const float4*)(kr + h * HD + i); s += qs[h * HD + i] * v.x + qs[h * HD + i + 1] * v.y + qs[h * HD + i + 2] * v.z + qs[h * HD + i + 3] * v.w; }
      lg[h][tid] = s * 0.125f;
    }
  } else {
    for (int h = 0; h < NH; ++h) lg[h][tid] = -INFINITY;
  }
  __syncthreads();
  {
    const int h = tid >> 5, l = tid & 31;
    float mx = -INFINITY;
    for (int j = l; j < TOPK; j += 32) mx = fmaxf(mx, lg[h][j]);
    for (int o = 16; o > 0; o >>= 1) mx = fmaxf(mx, __shfl_xor(mx, o));
    float sm = 0.f;
    for (int j = l; j < TOPK; j += 32) { const float e = expf(lg[h][j] - mx); lg[h][j] = e; sm += e; }
    for (int o = 16; o > 0; o >>= 1) sm += __shfl_xor(sm, o);
    const float inv = 1.0f / sm;
    for (int j = l; j < TOPK; j += 32) lg[h][j] *= inv;
  }
  __syncthreads();
  for (int o = tid; o < NH * HD; o += 256) {
    const int h = o >> 6; float acc = 0.f;
    for (int j = 0; j < cnt; ++j) acc += lg[h][j] * proj[(size_t)rows[j] * IN_W + OFF_V + o];
    mix[(size_t)m * D + CONV_CH + o] = acc;
  }
}

__global__ void __launch_bounds__(256) k_ln1(const float* __restrict__ x, const float2* __restrict__ st0, const float* __restrict__ eg, const float* __restrict__ eb,
                                             const float* __restrict__ tmp, const float* __restrict__ g, const float* __restrict__ bb, float* __restrict__ h1) {
  const int lane = threadIdx.x & 63, m = blockIdx.x * 4 + (threadIdx.x >> 6);
  const float2 st = st0[m];
  float v[16]; float s = 0.f;
#pragma unroll
  for (int i = 0; i < 16; ++i) { const int c = i * 64 + lane; const float h0 = (x[(size_t)m * D + c] - st.x) * st.y * eg[c] + eb[c]; v[i] = DN_ALPHA * h0 + tmp[(size_t)m * D + c]; s += v[i]; }
  const float mu = wave_sum(s) * (1.0f / D);
  float q = 0.f;
#pragma unroll
  for (int i = 0; i < 16; ++i) { const float d = v[i] - mu; q += d * d; }
  const float rstd = rsqrtf(wave_sum(q) * (1.0f / D) + LN_EPS);
#pragma unroll
  for (int i = 0; i < 16; ++i) { const int c = i * 64 + lane; h1[(size_t)m * D + c] = (v[i] - mu) * rstd * g[c] + bb[c]; }
}

__global__ void __launch_bounds__(256) k_router(const float* __restrict__ h1, const float* __restrict__ wr, const float* __restrict__ rbias, int* __restrict__ ridx, float* __restrict__ rw, int* __restrict__ ecnt) {
  const int lane = threadIdx.x & 63, m = blockIdx.x * 4 + (threadIdx.x >> 6);
  const float* hr = h1 + (size_t)m * D;
  float lgt = 0.f;
  for (int k = 0; k < D; ++k) lgt += hr[k] * wr[k * NE + lane];
  const float score = sigmoidf_(lgt), biased = score + rbias[lane];
  float m1 = -INFINITY, m2 = -INFINITY;
  for (int j = 0; j < 8; ++j) { const float v = __shfl(biased, (lane & ~7) + j); if (v > m1) { m2 = m1; m1 = v; } else if (v > m2) m2 = v; }
  const float gs = m1 + m2; const int g = lane >> 3;
  int grank = 0;
  for (int j = 0; j < 8; ++j) { const float v = __shfl(gs, j * 8); grank += (v > gs || (v == gs && j < g)) ? 1 : 0; }
  const float val = grank < 4 ? biased : -INFINITY;
  int rank = 0;
  for (int j = 0; j < 64; ++j) { const float v = __shfl(val, j); rank += (v > val || (v == val && j < lane)) ? 1 : 0; }
  const bool selq = rank < TOPE;
  const float ssum = wave_sum(selq ? score : 0.f);
  if (selq) { ridx[m * TOPE + rank] = lane; rw[m * TOPE + rank] = score / ssum * ROUTED_SCALE; atomicAdd(&ecnt[lane], 1); }
}
__global__ void k_moe_offsets(const int* __restrict__ ecnt, int* __restrict__ eoff, int* __restrict__ ecur) {
  if (threadIdx.x == 0) { int a = 0; for (int e = 0; e < NE; ++e) { eoff[e] = a; a += ecnt[e]; ecur[e] = 0; } eoff[NE] = a; }
}
__global__ void __launch_bounds__(256) k_moe_fill(const int* __restrict__ ridx, const float* __restrict__ rw, const int* __restrict__ eoff, int* __restrict__ ecur, int* __restrict__ ltok, float* __restrict__ lw) {
  const int i = blockIdx.x * 256 + threadIdx.x;
  if (i >= NR * TOPE) return;
  const int e = ridx[i], p = eoff[e] + atomicAdd(&ecur[e], 1);
  ltok[p] = i / TOPE; lw[p] = rw[i];
}

__global__ void __launch_bounds__(256) k_expert(const float* __restrict__ h1, const float* __restrict__ wg, const float* __restrict__ wu, const float* __restrict__ wd,
                                                const float* __restrict__ sg, const float* __restrict__ su, const float* __restrict__ sd,
                                                const int* __restrict__ eoff, const int* __restrict__ ltok, const float* __restrict__ lw, float* __restrict__ acc) {
  __shared__ float xs[16][D];
  __shared__ float hs[16][DE];
  __shared__ int toks[16]; __shared__ float wts[16];
  const int e = blockIdx.y, chunk = blockIdx.x, tid = threadIdx.x;
  int base, cnt;
  if (e < NE) { base = eoff[e]; cnt = eoff[e + 1] - base; } else { base = 0; cnt = NR; }
  const int i0 = chunk * 16; if (i0 >= cnt) return;
  const int nn = min(16, cnt - i0);
  if (tid < 16) { if (tid < nn) { toks[tid] = e < NE ? ltok[base + i0 + tid] : i0 + tid; wts[tid] = e < NE ? lw[base + i0 + tid] : 1.0f; } else { toks[tid] = 0; wts[tid] = 0.f; } }
  __syncthreads();
  for (int i = tid; i < 16 * D; i += 256) { const int r = i >> 10, c = i & (D - 1); xs[r][c] = h1[(size_t)toks[r] * D + c]; }
  __syncthreads();
  const float* Wg = e < NE ? wg + (size_t)e * D * DE : sg;
  const float* Wu = e < NE ? wu + (size_t)e * D * DE : su;
  const float* Wd = e < NE ? wd + (size_t)e * DE * D : sd;
  float ga[16], ua[16];
#pragma unroll
  for (int r = 0; r < 16; ++r) { ga[r] = 0.f; ua[r] = 0.f; }
  for (int k = 0; k < D; ++k) {
    const float a = Wg[(size_t)k * DE + tid], b = Wu[(size_t)k * DE + tid];
#pragma unroll
    for (int r = 0; r < 16; ++r) { const float xv = xs[r][k]; ga[r] += xv * a; ua[r] += xv * b; }
  }
#pragma unroll
  for (int r = 0; r < 16; ++r) hs[r][tid] = ga[r] * sigmoidf_(ga[r]) * ua[r];
  __syncthreads();
  for (int cb = 0; cb < 4; ++cb) {
    const int col = cb * 256 + tid;
    float o[16];
#pragma unroll
    for (int r = 0; r < 16; ++r) o[r] = 0.f;
    for (int k = 0; k < DE; ++k) {
      const float w = Wd[(size_t)k * D + col];
#pragma unroll
      for (int r = 0; r < 16; ++r) o[r] += hs[r][k] * w;
    }
#pragma unroll
    for (int r = 0; r < 16; ++r) if (r < nn) atomicAdd(&acc[(size_t)toks[r] * D + col], o[r] * wts[r]);
  }
}

__global__ void __launch_bounds__(256) k_ln2(const float* __restrict__ h1, const float* __restrict__ g, const float* __restrict__ bb, float* __restrict__ out) {
  const int lane = threadIdx.x & 63, m = blockIdx.x * 4 + (threadIdx.x >> 6);
  float v[16]; float s = 0.f;
#pragma unroll
  for (int i = 0; i < 16; ++i) { const int c = i * 64 + lane; v[i] = DN_ALPHA * h1[(size_t)m * D + c] + out[(size_t)m * D + c]; s += v[i]; }
  const float mu = wave_sum(s) * (1.0f / D);
  float q = 0.f;
#pragma unroll
  for (int i = 0; i < 16; ++i) { const float d = v[i] - mu; q += d * d; }
  const float rstd = rsqrtf(wave_sum(q) * (1.0f / D) + LN_EPS);
#pragma unroll
  for (int i = 0; i < 16; ++i) { const int c = i * 64 + lane; out[(size_t)m * D + c] = (v[i] - mu) * rstd * g[c] + bb[c]; }
}

extern "C" void kernel_launch(void* const* d_in, const int* in_sizes, int n_in, void* d_out, int out_size, void* d_ws, size_t ws_size, hipStream_t stream) {
  const float* x = (const float*)d_in[0];        const float* meta = (const float*)d_in[1];
  const float* ln_emb_g = (const float*)d_in[2]; const float* ln_emb_b = (const float*)d_in[3];
  const float* w_in = (const float*)d_in[4];     const float* conv_w = (const float*)d_in[5];   const float* conv_b = (const float*)d_in[6];
  const float* lnc_g = (const float*)d_in[7];    const float* lnc_b = (const float*)d_in[8];
  const float* lnk_g = (const float*)d_in[9];    const float* lnk_b = (const float*)d_in[10];
  const float* w_out = (const float*)d_in[11];   const float* ln1_g = (const float*)d_in[12];   const float* ln1_b = (const float*)d_in[13];
  const float* w_router = (const float*)d_in[14]; const float* r_bias = (const float*)d_in[15];
  const float* w_gate = (const float*)d_in[16];  const float* w_up = (const float*)d_in[17];    const float* w_down = (const float*)d_in[18];
  const float* ws_gate = (const float*)d_in[19]; const float* ws_up = (const float*)d_in[20];   const float* ws_down = (const float*)d_in[21];
  const float* ln2_g = (const float*)d_in[22];   const float* ln2_b = (const float*)d_in[23];
  float* out = (float*)d_out;
  unsigned char* ws = (unsigned char*)d_ws;
  size_t off = 0;
  auto carve = [&](size_t bytes) { void* p = ws + off; off += (bytes + 255) & ~(size_t)255; return p; };
  int* ctl = (int*)carve(4096);
  float2* st0 = (float2*)carve((size_t)NROWS * 8);
  unsigned short* sel = (unsigned short*)carve((size_t)NR * TOPK * 2);
  int* selcnt = (int*)carve((size_t)NR * 4);
  int* ridx = (int*)carve((size_t)NR * TOPE * 4);  float* rw = (float*)carve((size_t)NR * TOPE * 4);
  int* ltok = (int*)carve((size_t)NR * TOPE * 4);  float* lw = (float*)carve((size_t)NR * TOPE * 4);
  float* bufA = (float*)carve((size_t)NROWS * D * 4);
  float* proj = (float*)carve((size_t)NROWS * IN_W * 4);
  if (off > ws_size) fprintf(stderr, "workspace too small: need %zu have %zu\n", off, ws_size);
  float* h0 = bufA; float* mix = bufA;
  float* tmp = proj; float* h1 = proj + (size_t)NR * D;
  int* ecnt = ctl, *eoff = ctl + 64, *ecur = ctl + 192;
  (void)ws_size; (void)in_sizes; (void)n_in; (void)out_size;

  RopeInv inv; for (int i = 0; i < 8; ++i) inv.v[i] = (float)pow(500000.0, -2.0 * i / 16.0);

  hipMemsetAsync(ctl, 0, 4096, stream);
  hipMemsetAsync(out, 0, (size_t)NR * D * 4, stream);
  k_ln_emb<<<NROWS / 4, 256, 0, stream>>>(x, meta, ln_emb_g, ln_emb_b, h0, st0);
  k_gemm_f32<<<dim3((IN_W + 63) / 64, (NROWS + 63) / 64), 256, 0, stream>>>(h0, w_in, proj, NROWS, IN_W, D, D, IN_W, IN_W);
  k_post_proj<<<NROWS, 64, 0, stream>>>(proj, lnk_g, lnk_b, inv);
  k_conv<<<NR, 512, 0, stream>>>(proj, conv_w, conv_b, lnc_g, lnc_b, mix);
  k_topk<<<NR, 256, 0, stream>>>(proj, sel, selcnt);
  k_attn<<<NR, 256, 0, stream>>>(proj, sel, selcnt, mix);
  k_gemm_f32<<<dim3(D / 64, NR / 64), 256, 0, stream>>>(mix, w_out, tmp, NR, D, D, D, D, D);
  k_ln1<<<NR / 4, 256, 0, stream>>>(x, st0, ln_emb_g, ln_emb_b, tmp, ln1_g, ln1_b, h1);
  k_router<<<NR / 4, 256, 0, stream>>>(h1, w_router, r_bias, ridx, rw, ecnt);
  k_moe_offsets<<<1, 64, 0, stream>>>(ecnt, eoff, ecur);
  k_moe_fill<<<NR * TOPE / 256, 256, 0, stream>>>(ridx, rw, eoff, ecur, ltok, lw);
  k_expert<<<dim3(NR / 16, NE + 1), 256, 0, stream>>>(h1, w_gate, w_up, w_down, ws_gate, ws_up, ws_down, eoff, ltok, lw, out);
  k_ln2<<<NR / 4, 256, 0, stream>>>(h1, ln2_g, ln2_b, out);
}
```

```cpp
#include <hip/hip_runtime.h>
#include <cstdint>
#include <cstdio>
#include <cmath>

constexpr int D = 1024, NB = 2, SEQ = 8192, NMETA = 16, TP = SEQ + NMETA;
constexpr int NR = NB * SEQ;
constexpr int NROWS = NR + NB * NMETA;
constexpr int CONV_CH = 512, CONV_W = 31, NH = 8, HD = 64, IH = 8, IDD = 64, TOPK = 256;
constexpr int IN_W = 3144;
constexpr int OFF_A = 0, OFF_G = 512, OFF_Q = 1024, OFF_K = 1536, OFF_V = 2048, OFF_QI = 2560, OFF_KI = 3072, OFF_WI = 3136;
constexpr int NE = 64, TOPE = 8, DE = 256;
constexpr float LN_EPS = 1e-5f;
constexpr float DN_ALPHA = 1.189207115002721f;
constexpr float ROUTED_SCALE = 2.5f;

__device__ __forceinline__ int row_of(int b, int t) { return t < NMETA ? NR + b * NMETA + t : b * SEQ + (t - NMETA); }
__device__ __forceinline__ void row_bt(int m, int& b, int& t) { if (m < NR) { b = m >> 13; t = (m & (SEQ - 1)) + NMETA; } else { b = (m - NR) >> 4; t = (m - NR) & 15; } }

__device__ __forceinline__ float wave_sum(float v) {
#pragma unroll
  for (int o = 32; o > 0; o >>= 1) v += __shfl_xor(v, o);
  return v;
}
__device__ __forceinline__ float sigmoidf_(float x) { return 1.0f / (1.0f + expf(-x)); }

#define XB_TMO      128
#define XB_XCNT(j)  (256  + 64 * (j))
#define XB_XSUB(j)  (1280 + 64 * (j))
#define XB_XGEN(j)  (2304 + 64 * (j))
#define XB_TOP      3328
#define XB_TOPGEN   3392
#define XCD_BAR_WORDS 3456
#define XB_SPIN_CAP (1u << 18)
#define LAS __attribute__((address_space(3)))

__device__ __forceinline__ unsigned xb_ld(unsigned* p)              { return __hip_atomic_load(p, __ATOMIC_RELAXED, __HIP_MEMORY_SCOPE_AGENT); }
__device__ __forceinline__ unsigned xb_add(unsigned* p, unsigned v) { return __hip_atomic_fetch_add(p, v, __ATOMIC_RELAXED, __HIP_MEMORY_SCOPE_AGENT); }
__device__ __forceinline__ unsigned xb_xcc_id() { return (unsigned)__builtin_amdgcn_s_getreg((3 << 11) | 20) & 0xFu; }
#define XB_SPIN(cond, bar) do { unsigned _sp = 0; while (cond) { __builtin_amdgcn_s_sleep(1); \
    if ((++_sp & 255u) == 0u) { if (xb_ld(&(bar)[XB_TMO])) break; if (_sp > XB_SPIN_CAP) { atomicAdd(&(bar)[XB_TMO], 1u); break; } } } } while (0)

struct XcdBarrier {
    unsigned* bar; unsigned x;
    volatile LAS unsigned* st;
};

__device__ __forceinline__ XcdBarrier xcd_barrier_post(unsigned* bar, volatile LAS unsigned* st) {
    XcdBarrier b; b.bar = bar; b.x = xb_xcc_id(); b.st = st;
    if (threadIdx.x == 0) (void)xb_add(&bar[XB_XCNT(b.x)], 1u);
    return b;
}
__device__ __forceinline__ void xcd_barrier_complete(unsigned* bar, unsigned x, unsigned& nloc, unsigned& nx) {
    const unsigned G = gridDim.x * gridDim.y * gridDim.z;
    unsigned sum, cnt, mine, sp = 0u;
    for (;;) {
        sum = 0u; cnt = 0u; mine = 0u;
#pragma unroll
        for (unsigned j = 0; j < 16; ++j) { const unsigned c = xb_ld(&bar[XB_XCNT(j)]); sum += c; cnt += (c > 0u) ? 1u : 0u; mine = (j == x) ? c : mine; }
        if (sum == G) break;
        __builtin_amdgcn_s_sleep(1);
        if ((++sp & 255u) == 0u) { if (xb_ld(&bar[XB_TMO])) break; if (sp > XB_SPIN_CAP) { atomicAdd(&bar[XB_TMO], 1u); break; } }
    }
    nloc = mine > 0u ? mine : 1u; nx = cnt > 0u ? cnt : 1u;
}

__device__ __forceinline__ void xcd_barrier(const XcdBarrier& b) {
    asm volatile("s_waitcnt vmcnt(0)" ::: "memory");
    __syncthreads();
    if (threadIdx.x == 0) {
        unsigned* bar = b.bar;
        __builtin_amdgcn_s_waitcnt(0);
        unsigned nloc = b.st[0], nx = b.st[1];
        if (nloc == 0u) { xcd_barrier_complete(bar, b.x, nloc, nx); b.st[0] = nloc; b.st[1] = nx; }
        const unsigned old = xb_add(&bar[XB_XSUB(b.x)], 1u);
        const unsigned gen = old / nloc;
        if (old + 1u == (gen + 1u) * nloc) {
            __builtin_amdgcn_fence(__ATOMIC_RELEASE, "agent");
            asm volatile("s_waitcnt vmcnt(0)" ::: "memory");
            const unsigned og = xb_add(&bar[XB_TOP], 1u);
            const unsigned tg = og / nx;
            if (og + 1u == (tg + 1u) * nx) xb_add(&bar[XB_TOPGEN], 1u);
            else XB_SPIN(xb_ld(&bar[XB_TOPGEN]) == tg, bar);
            __builtin_amdgcn_fence(__ATOMIC_ACQUIRE, "agent");
            xb_add(&bar[XB_XGEN(b.x)], 1u);
            asm volatile("s_waitcnt vmcnt(0)" ::: "memory");
        } else {
            XB_SPIN(xb_ld(&bar[XB_XGEN(b.x)]) == gen, bar);
            __builtin_amdgcn_fence(__ATOMIC_ACQUIRE, "agent");
            asm volatile("s_waitcnt vmcnt(0)" ::: "memory");
        }
    }
    __syncthreads();
}


constexpr int NTHR = 512, NWAVES = 8;
constexpr int LDS_BYTES = 147456;
constexpr int MISC_OFF = 131072 + 8192;
constexpr size_t CTL_BYTES = 65536;

struct RopeInv { float v[8]; };
struct Args {
  const float *x, *meta, *ln_emb_g, *ln_emb_b, *w_in, *conv_w, *conv_b, *lnc_g, *lnc_b, *lnk_g, *lnk_b, *w_out, *ln1_g, *ln1_b, *w_router, *r_bias,
              *w_gate, *w_up, *w_down, *ws_gate, *ws_up, *ws_down, *ln2_g, *ln2_b;
  float* out; unsigned char* ws;
  float ropeinv[8];
};
__device__ __forceinline__ void rope16(float* p, int t, const RopeInv inv) {
#pragma unroll
  for (int i = 0; i < 8; ++i) {
    const float ang = (float)t * inv.v[i]; float sn, cs; sincosf(ang, &sn, &cs);
    const float x1 = p[i], x2 = p[i + 8];
    p[i] = x1 * cs - x2 * sn; p[i + 8] = x2 * cs + x1 * sn;
  }
}
__device__ __forceinline__ unsigned fkey(float f) { unsigned u = __float_as_uint(f); return (u & 0x80000000u) ? ~u : (u | 0x80000000u); }

__device__ __forceinline__ void gemm_f32_phase(const float* __restrict__ A, const float* __restrict__ W, float* __restrict__ C, int M, int N, int K, int lda, int ldw, int ldc, float* lds) {
  const int tid = threadIdx.x, half = tid >> 8, vt = tid & 255, tx = vt & 15, ty = vt >> 4;
  float (*As)[68] = (float (*)[68])(lds + half * 2 * 16 * 68);
  float (*Bs)[68] = (float (*)[68])(lds + half * 2 * 16 * 68 + 16 * 68);
  const int ntn = (N + 63) / 64, ntm = (M + 63) / 64, ntiles = ntn * ntm;
  const int ar = vt >> 2, ak = (vt & 3) * 4, bk = vt >> 4, bc = (vt & 15) * 4;
  for (int it = blockIdx.x; it * 2 < ntiles; it += gridDim.x) {
    int tile = it * 2 + half; const bool live = tile < ntiles; if (!live) tile = ntiles - 1;
    const int m0 = (tile / ntn) * 64, n0 = (tile % ntn) * 64;
    float acc[4][4];
#pragma unroll
    for (int i = 0; i < 4; ++i)
#pragma unroll
      for (int j = 0; j < 4; ++j) acc[i][j] = 0.f;
    for (int k0 = 0; k0 < K; k0 += 16) {
      float4 a = make_float4(0.f, 0.f, 0.f, 0.f), b = make_float4(0.f, 0.f, 0.f, 0.f);
      if (m0 + ar < M) a = *(const float4*)(A + (size_t)(m0 + ar) * lda + k0 + ak);
      if (n0 + bc < N) b = *(const float4*)(W + (size_t)(k0 + bk) * ldw + n0 + bc);
      __syncthreads();
      As[ak + 0][ar] = a.x; As[ak + 1][ar] = a.y; As[ak + 2][ar] = a.z; As[ak + 3][ar] = a.w;
      *(float4*)&Bs[bk][bc] = b;
      __syncthreads();
#pragma unroll
      for (int kk = 0; kk < 16; ++kk) {
        const float4 av = *(const float4*)&As[kk][ty * 4];
        const float4 bv = *(const float4*)&Bs[kk][tx * 4];
        const float aa[4] = {av.x, av.y, av.z, av.w}, bbv[4] = {bv.x, bv.y, bv.z, bv.w};
#pragma unroll
        for (int i = 0; i < 4; ++i)
#pragma unroll
          for (int j = 0; j < 4; ++j) acc[i][j] += aa[i] * bbv[j];
      }
    }
    if (live) {
#pragma unroll
      for (int i = 0; i < 4; ++i) {
        const int r = m0 + ty * 4 + i, c = n0 + tx * 4;
        if (r < M && c < N) *(float4*)(C + (size_t)r * ldc + c) = make_float4(acc[i][0], acc[i][1], acc[i][2], acc[i][3]);
      }
    }
  }
  __syncthreads();
}

__global__ void __launch_bounds__(NTHR, 2) mega_fwd(Args a) {
  extern __shared__ __attribute__((aligned(16))) unsigned char lds_raw[];
  float* lds = (float*)lds_raw;
  const int tid = threadIdx.x, lane = tid & 63, wave = tid >> 6, G = gridDim.x, bid = blockIdx.x;
  const int gw = bid * NWAVES + wave, NGW = G * NWAVES;
  unsigned char* ws = a.ws;
  size_t off = CTL_BYTES;
  auto carve = [&](size_t bytes) { unsigned char* p = ws + off; off += (bytes + 255) & ~(size_t)255; return p; };
  unsigned* barw = (unsigned*)ws;
  int* ecnt = (int*)(ws + 16384); int* ecur = ecnt + 64; int* eoff = (int*)(ws + 32768);
  float2* st0 = (float2*)carve((size_t)NROWS * 8);
  unsigned short* sel = (unsigned short*)carve((size_t)NR * TOPK * 2);
  int* selcnt = (int*)carve((size_t)NR * 4);
  int* ridx = (int*)carve((size_t)NR * TOPE * 4);  float* rw = (float*)carve((size_t)NR * TOPE * 4);
  int* ltok = (int*)carve((size_t)NR * TOPE * 4);  float* lw = (float*)carve((size_t)NR * TOPE * 4);
  float* bufA = (float*)carve((size_t)NROWS * D * 4);
  float* proj = (float*)carve((size_t)NROWS * IN_W * 4);
  float* h0 = bufA; float* mix = bufA; float* tmp = proj; float* h1 = proj + (size_t)NR * D;
  float* out = a.out;

  volatile LAS unsigned* misc = (volatile LAS unsigned*)((LAS unsigned char*)lds_raw + MISC_OFF);
  if (tid < 16) misc[tid] = 0u;
  __syncthreads();
  XcdBarrier bar = xcd_barrier_post(barw, misc);

  {
    float4* o4 = (float4*)out;
    for (size_t i = (size_t)bid * NTHR + tid; i < (size_t)NR * D / 4; i += (size_t)G * NTHR) o4[i] = make_float4(0.f, 0.f, 0.f, 0.f);
    for (int m = gw; m < NROWS; m += NGW) {
      const float* src = m < NR ? a.x + (size_t)m * D : a.meta + (size_t)((m - NR) & 15) * D;
      float v[16]; float s = 0.f;
#pragma unroll
      for (int i = 0; i < 16; ++i) { v[i] = src[i * 64 + lane]; s += v[i]; }
      const float mu = wave_sum(s) * (1.0f / D);
      float q = 0.f;
#pragma unroll
      for (int i = 0; i < 16; ++i) { const float d = v[i] - mu; q += d * d; }
      const float rstd = rsqrtf(wave_sum(q) * (1.0f / D) + LN_EPS);
#pragma unroll
      for (int i = 0; i < 16; ++i) { const int c = i * 64 + lane; h0[(size_t)m * D + c] = (v[i] - mu) * rstd * a.ln_emb_g[c] + a.ln_emb_b[c]; }
      if (lane == 0) st0[m] = make_float2(mu, rstd);
    }
  }
  xcd_barrier(bar);
  gemm_f32_phase(h0, a.w_in, proj, NROWS, IN_W, D, D, IN_W, IN_W, lds);
  xcd_barrier(bar);
  RopeInv rinv; rinv.v[0] = a.ropeinv[0]; rinv.v[1] = a.ropeinv[1]; rinv.v[2] = a.ropeinv[2]; rinv.v[3] = a.ropeinv[3]; rinv.v[4] = a.ropeinv[4]; rinv.v[5] = a.ropeinv[5]; rinv.v[6] = a.ropeinv[6]; rinv.v[7] = a.ropeinv[7];
  for (int m = gw; m < NROWS; m += NGW) {
    int b, t; row_bt(m, b, t);
    float* row = proj + (size_t)m * IN_W; const int l = lane;
    if (l < 8) rope16(row + OFF_Q + l * HD, t, rinv);
    else if (l < 16) rope16(row + OFF_K + (l - 8) * HD, t, rinv);
    else if (l < 24) rope16(row + OFF_QI + (l - 16) * IDD, t, rinv);
    else if (l == 24) {
      float* ki = row + OFF_KI; float s = 0.f;
      for (int i = 0; i < IDD; ++i) s += ki[i];
      const float mu = s * (1.0f / IDD); float q = 0.f;
      for (int i = 0; i < IDD; ++i) { const float d = ki[i] - mu; q += d * d; }
      const float rstd = rsqrtf(q * (1.0f / IDD) + LN_EPS);
      for (int i = 0; i < IDD; ++i) ki[i] = (ki[i] - mu) * rstd * a.lnk_g[i] + a.lnk_b[i];
      rope16(ki, t, rinv);
    } else if (l == 25) {
      for (int i = 0; i < IH; ++i) row[OFF_WI + i] *= 0.35355339059327373f;
    }
  }
  for (int m = bid; m < NR; m += G) {
    float* red = lds;
    const int c = tid, b = m >> 13, t = (m & (SEQ - 1)) + NMETA;
    float acc = a.conv_b[c];
    for (int w = 0; w < CONV_W; ++w) {
      const int tt = t - (CONV_W - 1) + w; if (tt < 0) continue;
      const float* r = proj + (size_t)row_of(b, tt) * IN_W;
      const float u = r[OFF_A + c] * sigmoidf_(r[OFF_G + c]);
      acc += a.conv_w[w * CONV_CH + c] * u;
    }
    const float s = wave_sum(acc);
    __syncthreads();
    if (lane == 0) red[wave] = s;
    __syncthreads();
    float tot = 0.f;
    for (int i = 0; i < 8; ++i) tot += red[i];
    const float mu = tot * (1.0f / CONV_CH), d = acc - mu;
    const float q = wave_sum(d * d);
    if (lane == 0) red[8 + wave] = q;
    __syncthreads();
    float tq = 0.f;
    for (int i = 0; i < 8; ++i) tq += red[8 + i];
    const float y = d * rsqrtf(tq * (1.0f / CONV_CH) + LN_EPS) * a.lnc_g[c] + a.lnc_b[c];
    mix[(size_t)m * D + c] = y * sigmoidf_(y);
  }
  xcd_barrier(bar);
  for (int m = bid; m < NR; m += G) {
    float* qs = lds;
    float* wsm = lds + 512;
    unsigned* keys = (unsigned*)(lds + 1024);
    int* cnts = (int*)(lds + 1024 + 8320);
    int* scan_a = cnts + 16; int* scan_b = scan_a + 512;
    const int b = m >> 13, t = (m & (SEQ - 1)) + NMETA, n = t + 1;
    const float* qrow = proj + (size_t)m * IN_W;
    __syncthreads();
    qs[tid] = qrow[OFF_QI + tid];
    if (tid < IH) wsm[tid] = qrow[OFF_WI + tid];
    __syncthreads();
    for (int c = tid; c < n; c += NTHR) {
      const float* kr = proj + (size_t)row_of(b, c) * IN_W + OFF_KI;
      float kv[IDD];
#pragma unroll
      for (int i = 0; i < IDD; i += 4) { const float4 v = *(const float4*)(kr + i); kv[i] = v.x; kv[i + 1] = v.y; kv[i + 2] = v.z; kv[i + 3] = v.w; }
      float sc = 0.f;
#pragma unroll 1
      for (int h = 0; h < IH; ++h) {
        float s = 0.f;
#pragma unroll
        for (int i = 0; i < IDD; ++i) s += qs[h * IDD + i] * kv[i];
        sc += wsm[h] * fmaxf(s, 0.f);
      }
      keys[c] = fkey(sc * 0.125f);
    }
    __syncthreads();
    unsigned short* o = sel + (size_t)m * TOPK;
    if (n <= TOPK) {
      if (tid < TOPK) o[tid] = (unsigned short)(tid < n ? tid : 0);
      if (tid == 0) selcnt[m] = n;
    } else {
      unsigned lo = 0u;
      for (int bit = 31; bit >= 0; --bit) {
        const unsigned cand = lo | (1u << bit);
        int c0 = 0;
        for (int c = tid; c < n; c += NTHR) c0 += (keys[c] >= cand) ? 1 : 0;
        c0 = (int)wave_sum((float)c0);
        __syncthreads();
        if (lane == 0) cnts[wave] = c0;
        __syncthreads();
        int tot = 0;
        for (int i = 0; i < 8; ++i) tot += cnts[i];
        if (tot >= TOPK) lo = cand;
      }
      const unsigned T = lo;
      const int chunk = (n + NTHR - 1) / NTHR, c_lo = min(n, tid * chunk), c_hi = min(n, c_lo + chunk);
      int ngt = 0, neq = 0;
      for (int c = c_lo; c < c_hi; ++c) { const unsigned k = keys[c]; ngt += (k > T); neq += (k == T); }
      __syncthreads();
      scan_a[tid] = ngt; scan_b[tid] = neq;
      __syncthreads();
      if (tid == 0) { int aa = 0, e = 0; for (int i = 0; i < NTHR; ++i) { const int xg = scan_a[i], y = scan_b[i]; scan_a[i] = aa; scan_b[i] = e; aa += xg; e += y; } cnts[8] = aa; }
      __syncthreads();
      const int total_gt = cnts[8], need_eq = TOPK - total_gt;
      int pg = scan_a[tid], pe = scan_b[tid];
      for (int c = c_lo; c < c_hi; ++c) {
        const unsigned k = keys[c];
        if (k > T) { o[pg + min(pe, need_eq)] = (unsigned short)c; ++pg; }
        else if (k == T) { if (pe < need_eq) o[pg + pe] = (unsigned short)c; ++pe; }
      }
      if (tid == 0) selcnt[m] = TOPK;
    }
  }
  xcd_barrier(bar);
  for (int it = bid; it * 2 < NR; it += G) {
    const int half = tid >> 8, vt = tid & 255;
    int m = it * 2 + half; const bool live = m < NR; if (!live) m = NR - 1;
    float* qs = lds + half * 4096;
    float* lg = qs + 512;
    int* rows = (int*)(qs + 512 + 2048);
    const int b = m >> 13, cnt = selcnt[m];
    __syncthreads();
    for (int i = vt; i < NH * HD; i += 256) qs[i] = proj[(size_t)m * IN_W + OFF_Q + i];
    rows[vt] = vt < cnt ? row_of(b, (int)sel[(size_t)m * TOPK + vt]) : 0;
    __syncthreads();
    if (vt < cnt) {
      const float* kr = proj + (size_t)rows[vt] * IN_W + OFF_K;
      for (int h = 0; h < NH; ++h) {
        float s = 0.f;
        for (int i = 0; i < HD; i += 4) { const float4 v = *(const float4*)(kr + h * HD + i); s += qs[h * HD + i] * v.x + qs[h * HD + i + 1] * v.y + qs[h * HD + i + 2] * v.z + qs[h * HD + i + 3] * v.w; }
        lg[h * TOPK + vt] = s * 0.125f;
      }
    } else {
      for (int h = 0; h < NH; ++h) lg[h * TOPK + vt] = -INFINITY;
    }
    __syncthreads();
    {
      const int h = vt >> 5, l = vt & 31;
      float mx = -INFINITY;
      for (int j = l; j < TOPK; j += 32) mx = fmaxf(mx, lg[h * TOPK + j]);
      for (int o = 16; o > 0; o >>= 1) mx = fmaxf(mx, __shfl_xor(mx, o));
      float sm = 0.f;
      for (int j = l; j < TOPK; j += 32) { const float e = expf(lg[h * TOPK + j] - mx); lg[h * TOPK + j] = e; sm += e; }
      for (int o = 16; o > 0; o >>= 1) sm += __shfl_xor(sm, o);
      const float inv = 1.0f / sm;
      for (int j = l; j < TOPK; j += 32) lg[h * TOPK + j] *= inv;
    }
    __syncthreads();
    for (int o = vt; o < NH * HD; o += 256) {
      const int h = o >> 6; float acc = 0.f;
      for (int j = 0; j < cnt; ++j) acc += lg[h * TOPK + j] * proj[(size_t)rows[j] * IN_W + OFF_V + o];
      if (live) mix[(size_t)m * D + CONV_CH + o] = acc;
    }
  }
  xcd_barrier(bar);
  gemm_f32_phase(mix, a.w_out, tmp, NR, D, D, D, D, D, lds);
  xcd_barrier(bar);
  for (int m = gw; m < NR; m += NGW) {
    const float2 st = st0[m];
    float v[16]; float s = 0.f;
#pragma unroll
    for (int i = 0; i < 16; ++i) { const int c = i * 64 + lane; const float hh = (a.x[(size_t)m * D + c] - st.x) * st.y * a.ln_emb_g[c] + a.ln_emb_b[c]; v[i] = DN_ALPHA * hh + tmp[(size_t)m * D + c]; s += v[i]; }
    const float mu = wave_sum(s) * (1.0f / D);
    float q = 0.f;
#pragma unroll
    for (int i = 0; i < 16; ++i) { const float d = v[i] - mu; q += d * d; }
    const float rstd = rsqrtf(wave_sum(q) * (1.0f / D) + LN_EPS);
#pragma unroll
    for (int i = 0; i < 16; ++i) { const int c = i * 64 + lane; v[i] = (v[i] - mu) * rstd * a.ln1_g[c] + a.ln1_b[c]; h1[(size_t)m * D + c] = v[i]; }
    float lgt = 0.f;
#pragma unroll
    for (int i = 0; i < 16; ++i)
      for (int j = 0; j < 64; ++j) lgt += __shfl(v[i], j) * a.w_router[(i * 64 + j) * NE + lane];
    const float score = sigmoidf_(lgt), biased = score + a.r_bias[lane];
    float m1 = -INFINITY, m2 = -INFINITY;
    for (int j = 0; j < 8; ++j) { const float vv = __shfl(biased, (lane & ~7) + j); if (vv > m1) { m2 = m1; m1 = vv; } else if (vv > m2) m2 = vv; }
    const float gs = m1 + m2; const int g = lane >> 3;
    int grank = 0;
    for (int j = 0; j < 8; ++j) { const float vv = __shfl(gs, j * 8); grank += (vv > gs || (vv == gs && j < g)) ? 1 : 0; }
    const float val = grank < 4 ? biased : -INFINITY;
    int rank = 0;
    for (int j = 0; j < 64; ++j) { const float vv = __shfl(val, j); rank += (vv > val || (vv == val && j < lane)) ? 1 : 0; }
    const bool selq = rank < TOPE;
    const float ssum = wave_sum(selq ? score : 0.f);
    if (selq) { ridx[m * TOPE + rank] = lane; rw[m * TOPE + rank] = score / ssum * ROUTED_SCALE; atomicAdd(&ecnt[lane], 1); }
  }
  xcd_barrier(bar);
  {
    int* eo = (int*)lds;
    __syncthreads();
    if (tid == 0) { int aa = 0; for (int e = 0; e < NE; ++e) { eo[e] = aa; aa += ecnt[e]; } eo[NE] = aa; }
    __syncthreads();
    if (bid == 0 && tid <= NE) eoff[tid] = eo[tid];
    for (int i = bid * NTHR + tid; i < NR * TOPE; i += G * NTHR) {
      const int e = ridx[i], p = eo[e] + atomicAdd(&ecur[e], 1);
      ltok[p] = i / TOPE; lw[p] = rw[i];
    }
  }
  xcd_barrier(bar);
  {
    float* xs = lds;
    float* gu = lds + 16 * D;
    float* hs = gu + 2 * 16 * DE;
    int* toks = (int*)(hs + 16 * DE);
    float* wts = (float*)(toks + 16);
    int* ipre = (int*)(wts + 16);
    __syncthreads();
    if (tid == 0) { int aa = 0; for (int e = 0; e < NE; ++e) { ipre[e] = aa; aa += (eoff[e + 1] - eoff[e] + 15) / 16; } ipre[NE] = aa; ipre[NE + 1] = aa + NR / 16; }
    __syncthreads();
    const int nitems = ipre[NE + 1];
    for (int it = bid; it < nitems; it += G) {
      int e = 0;
      while (ipre[e + 1] <= it) ++e;
      const int chunk = it - ipre[e];
      int base, cnt;
      if (e < NE) { base = eoff[e]; cnt = eoff[e + 1] - base; } else { base = 0; cnt = NR; }
      const int i0 = chunk * 16, nn = min(16, cnt - i0);
      __syncthreads();
      if (tid < 16) { if (tid < nn) { toks[tid] = e < NE ? ltok[base + i0 + tid] : i0 + tid; wts[tid] = e < NE ? lw[base + i0 + tid] : 1.0f; } else { toks[tid] = 0; wts[tid] = 0.f; } }
      __syncthreads();
      for (int i = tid; i < 16 * D; i += NTHR) { const int r = i >> 10, c = i & (D - 1); xs[i] = h1[(size_t)toks[r] * D + c]; }
      __syncthreads();
      const float* Wg = e < NE ? a.w_gate + (size_t)e * D * DE : a.ws_gate;
      const float* Wu = e < NE ? a.w_up + (size_t)e * D * DE : a.ws_up;
      const float* Wd = e < NE ? a.w_down + (size_t)e * DE * D : a.ws_down;
      {
        const int which = tid >> 8, col = tid & 255; const float* Wx = which ? Wu : Wg;
        float ga[16];
#pragma unroll
        for (int r = 0; r < 16; ++r) ga[r] = 0.f;
        for (int k = 0; k < D; ++k) {
          const float w = Wx[(size_t)k * DE + col];
#pragma unroll
          for (int r = 0; r < 16; ++r) ga[r] += xs[r * D + k] * w;
        }
#pragma unroll
        for (int r = 0; r < 16; ++r) gu[(which * 16 + r) * DE + col] = ga[r];
      }
      __syncthreads();
      for (int i = tid; i < 16 * DE; i += NTHR) { const float gg = gu[i], uu = gu[16 * DE + i]; hs[i] = gg * sigmoidf_(gg) * uu; }
      __syncthreads();
      for (int cb = 0; cb < 2; ++cb) {
        const int col = cb * NTHR + tid;
        float o[16];
#pragma unroll
        for (int r = 0; r < 16; ++r) o[r] = 0.f;
        for (int k = 0; k < DE; ++k) {
          const float w = Wd[(size_t)k * D + col];
#pragma unroll
          for (int r = 0; r < 16; ++r) o[r] += hs[r * DE + k] * w;
        }
#pragma unroll
        for (int r = 0; r < 16; ++r) if (r < nn) atomicAdd(&out[(size_t)toks[r] * D + col], o[r] * wts[r]);
      }
    }
  }
  xcd_barrier(bar);
  for (int m = gw; m < NR; m += NGW) {
    float v[16]; float s = 0.f;
#pragma unroll
    for (int i = 0; i < 16; ++i) { const int c = i * 64 + lane; v[i] = DN_ALPHA * h1[(size_t)m * D + c] + out[(size_t)m * D + c]; s += v[i]; }
    const float mu = wave_sum(s) * (1.0f / D);
    float q = 0.f;
#pragma unroll
    for (int i = 0; i < 16; ++i) { const float d = v[i] - mu; q += d * d; }
    const float rstd = rsqrtf(wave_sum(q) * (1.0f / D) + LN_EPS);
#pragma unroll
    for (int i = 0; i < 16; ++i) { const int c = i * 64 + lane; out[(size_t)m * D + c] = (v[i] - mu) * rstd * a.ln2_g[c] + a.ln2_b[c]; }
  }
}

extern "C" void kernel_launch(void* const* d_in, const int* in_sizes, int n_in, void* d_out, int out_size, void* d_ws, size_t ws_size, hipStream_t stream) {
  static int grid = 0;
  if (grid == 0) {
    int dev = 0, cus = 0, per_cu = 0;
    if (hipGetDevice(&dev) != hipSuccess || hipDeviceGetAttribute(&cus, hipDeviceAttributeMultiprocessorCount, dev) != hipSuccess) { fprintf(stderr, "kernel_launch: device query failed\n"); grid = -1; return; }
    if (hipFuncSetAttribute((const void*)mega_fwd, hipFuncAttributeMaxDynamicSharedMemorySize, LDS_BYTES) != hipSuccess) { fprintf(stderr, "kernel_launch: hipFuncSetAttribute failed\n"); grid = -1; return; }
    if (hipOccupancyMaxActiveBlocksPerMultiprocessor(&per_cu, (const void*)mega_fwd, NTHR, LDS_BYTES) != hipSuccess || per_cu < 1) { fprintf(stderr, "kernel_launch: occupancy query says %d\n", per_cu); }
    (void)hipGetLastError();
    grid = cus;
  }
  if (grid < 0) return;
  (void)in_sizes; (void)n_in; (void)out_size; (void)ws_size;
  if (hipMemsetAsync(d_ws, 0, CTL_BYTES, stream) != hipSuccess) { fprintf(stderr, "kernel_launch: memset failed\n"); return; }
  Args a{};
  const float** pp = (const float**)&a;
  for (int i = 0; i < 24; ++i) pp[i] = (const float*)d_in[i];
  a.out = (float*)d_out; a.ws = (unsigned char*)d_ws;
  for (int i = 0; i < 8; ++i) a.ropeinv[i] = (float)pow(500000.0, -2.0 * i / 16.0);
  hipLaunchKernelGGL(mega_fwd, dim3(grid), dim3(NTHR), LDS_BYTES, stream, a);
  const hipError_t le = hipPeekAtLastError();
  if (le != hipSuccess) fprintf(stderr, "kernel_launch: launch failed: %s\n", hipGetErrorName(le));
}
```

```cpp
#include <hip/hip_runtime.h>
#include <cstdint>
#include <cstdio>
#include <cmath>

constexpr int D = 1024, NB = 2, SEQ = 8192, NMETA = 16, TP = SEQ + NMETA;
constexpr int NR = NB * SEQ;
constexpr int NROWS = NR + NB * NMETA;
constexpr int CONV_CH = 512, CONV_W = 31, NH = 8, HD = 64, IH = 8, IDD = 64, TOPK = 256;
constexpr int IN_W = 3144;
constexpr int OFF_A = 0, OFF_G = 512, OFF_Q = 1024, OFF_K = 1536, OFF_V = 2048, OFF_QI = 2560, OFF_KI = 3072, OFF_WI = 3136;
constexpr int NE = 64, TOPE = 8, DE = 256;
constexpr float LN_EPS = 1e-5f;
constexpr float DN_ALPHA = 1.189207115002721f;
constexpr float ROUTED_SCALE = 2.5f;

__device__ __forceinline__ int row_of(int b, int t) { return t < NMETA ? NR + b * NMETA + t : b * SEQ + (t - NMETA); }
__device__ __forceinline__ void row_bt(int m, int& b, int& t) { if (m < NR) { b = m >> 13; t = (m & (SEQ - 1)) + NMETA; } else { b = (m - NR) >> 4; t = (m - NR) & 15; } }

__device__ __forceinline__ float wave_sum(float v) {
#pragma unroll
  for (int o = 32; o > 0; o >>= 1) v += __shfl_xor(v, o);
  return v;
}
__device__ __forceinline__ float sigmoidf_(float x) { return 1.0f / (1.0f + expf(-x)); }

#define XB_TMO      128
#define XB_XCNT(j)  (256  + 64 * (j))
#define XB_XSUB(j)  (1280 + 64 * (j))
#define XB_XGEN(j)  (2304 + 64 * (j))
#define XB_TOP      3328
#define XB_TOPGEN   3392
#define XCD_BAR_WORDS 3456
#define XB_SPIN_CAP (1u << 18)
#ifndef LAS
#define LAS __attribute__((address_space(3)))
#endif

__device__ __forceinline__ unsigned xb_ld(unsigned* p)              { return __hip_atomic_load(p, __ATOMIC_RELAXED, __HIP_MEMORY_SCOPE_AGENT); }
__device__ __forceinline__ unsigned xb_add(unsigned* p, unsigned v) { return __hip_atomic_fetch_add(p, v, __ATOMIC_RELAXED, __HIP_MEMORY_SCOPE_AGENT); }
__device__ __forceinline__ unsigned xb_xcc_id() { return (unsigned)__builtin_amdgcn_s_getreg((3 << 11) | 20) & 0xFu; }
#define XB_SPIN(cond, bar) do { unsigned _sp = 0; while (cond) { __builtin_amdgcn_s_sleep(1); \
    if ((++_sp & 255u) == 0u) { if (xb_ld(&(bar)[XB_TMO])) break; if (_sp > XB_SPIN_CAP) { atomicAdd(&(bar)[XB_TMO], 1u); break; } } } } while (0)

struct XcdBarrier {
    unsigned* bar; unsigned x;
    volatile LAS unsigned* st;
};

__device__ __forceinline__ XcdBarrier xcd_barrier_post(unsigned* bar, volatile LAS unsigned* st) {
    XcdBarrier b; b.bar = bar; b.x = xb_xcc_id(); b.st = st;
    if (threadIdx.x == 0) (void)xb_add(&bar[XB_XCNT(b.x)], 1u);
    return b;
}
__device__ __forceinline__ void xcd_barrier_complete(unsigned* bar, unsigned x, unsigned& nloc, unsigned& nx) {
    const unsigned G = gridDim.x * gridDim.y * gridDim.z;
    unsigned sum, cnt, mine, sp = 0u;
    for (;;) {
        sum = 0u; cnt = 0u; mine = 0u;
#pragma unroll
        for (unsigned j = 0; j < 16; ++j) { const unsigned c = xb_ld(&bar[XB_XCNT(j)]); sum += c; cnt += (c > 0u) ? 1u : 0u; mine = (j == x) ? c : mine; }
        if (sum == G) break;
        __builtin_amdgcn_s_sleep(1);
        if ((++sp & 255u) == 0u) { if (xb_ld(&bar[XB_TMO])) break; if (sp > XB_SPIN_CAP) { atomicAdd(&bar[XB_TMO], 1u); break; } }
    }
    nloc = mine > 0u ? mine : 1u; nx = cnt > 0u ? cnt : 1u;
}

__device__ __forceinline__ void xcd_barrier(const XcdBarrier& b) {
    asm volatile("s_waitcnt vmcnt(0)" ::: "memory");
    __syncthreads();
    if (threadIdx.x == 0) {
        unsigned* bar = b.bar;
        __builtin_amdgcn_s_waitcnt(0);
        unsigned nloc = b.st[0], nx = b.st[1];
        if (nloc == 0u) { xcd_barrier_complete(bar, b.x, nloc, nx); b.st[0] = nloc; b.st[1] = nx; }
        const unsigned old = xb_add(&bar[XB_XSUB(b.x)], 1u);
        const unsigned gen = old / nloc;
        if (old + 1u == (gen + 1u) * nloc) {
            __builtin_amdgcn_fence(__ATOMIC_RELEASE, "agent");
            asm volatile("s_waitcnt vmcnt(0)" ::: "memory");
            const unsigned og = xb_add(&bar[XB_TOP], 1u);
            const unsigned tg = og / nx;
            if (og + 1u == (tg + 1u) * nx) xb_add(&bar[XB_TOPGEN], 1u);
            else XB_SPIN(xb_ld(&bar[XB_TOPGEN]) == tg, bar);
            __builtin_amdgcn_fence(__ATOMIC_ACQUIRE, "agent");
            xb_add(&bar[XB_XGEN(b.x)], 1u);
            asm volatile("s_waitcnt vmcnt(0)" ::: "memory");
        } else {
            XB_SPIN(xb_ld(&bar[XB_XGEN(b.x)]) == gen, bar);
            __builtin_amdgcn_fence(__ATOMIC_ACQUIRE, "agent");
            asm volatile("s_waitcnt vmcnt(0)" ::: "memory");
        }
    }
    __syncthreads();
}


typedef unsigned short bf16_t;
__device__ __forceinline__ unsigned f2bf(float f) { unsigned u = __float_as_uint(f); return (u + 0x7fffu + ((u >> 16) & 1u)) >> 16; }
__device__ __forceinline__ unsigned pk2(float lo, float hi) { return f2bf(lo) | (f2bf(hi) << 16); }
__device__ __forceinline__ float bf2f(bf16_t v) { return __uint_as_float((unsigned)v << 16); }
namespace pg8 {
#define PG8_LAS __attribute__((address_space(3)))
typedef unsigned short bf16_t;
typedef short bf16x8 __attribute__((ext_vector_type(8)));
typedef float f32x4 __attribute__((ext_vector_type(4)));
typedef unsigned u32x4 __attribute__((ext_vector_type(4)));
constexpr int BM = 256, BK = 64, HALF = 128, HTB = HALF * BK * 2  , STAGE_BYTES = 8 * HTB, NXCD = 8, WGM = 8;

__host__ __device__ __forceinline__ int lds_byte(int r, int c) { const int st = (r >> 4) * 2 + (c >> 5), rr = r & 15, cc = c & 31, ob = rr * 64 + cc * 2; return st * 1024 + (ob ^ (((ob >> 9) & 1) << 5)); }
__host__ __device__ __forceinline__ void stage_rc(int b, int& R, int& C) { const int st = b / 1024, sb = b % 1024, swz = sb ^ (((sb >> 9) & 1) << 5); R = (st >> 1) * 16 + swz / 64; C = (st & 1) * 32 + (swz % 64) / 2; }
__host__ __device__ __forceinline__ int perm32(int rho) { const int n = rho >> 4, i = rho & 15; return 8 * (i >> 2) + 4 * n + (i & 3); }

struct Unit { int pm, pn; };
struct Gemm { const bf16_t* A; const bf16_t* Bt; int M, N, K; };

struct StaticOrder {
    int nM, nN, nwg, G, c;
    __host__ __device__ void init(int M, int N, int G_, int c_) { nM = M / BM; nN = N / BM; nwg = nM * nN; G = G_; c = c_; }
    __host__ __device__ bool next(int i, Unit& u) const {
        const long L = (long)i * G + c; if (L >= nwg) return false;
        int wgid = (int)L; { const int q = nwg / NXCD, r = nwg % NXCD, xcd = wgid % NXCD, off = wgid / NXCD; wgid = (xcd < r ? xcd * (q + 1) : r * (q + 1) + (xcd - r) * q) + off; }
        const int nig = WGM * nN, gid = wgid / nig, fm = gid * WGM, gsz = (nM - fm) < WGM ? (nM - fm) : WGM;
        u.pm = fm + ((wgid % nig) % gsz); u.pn = (wgid % nig) / gsz; return true;
    }
    __device__ __forceinline__ void a_ready(const Unit&) const {}
    __device__ __forceinline__ void done(const Unit&) const {}
};

__device__ __forceinline__ unsigned cvt_pk_bf16(float lo, float hi) { unsigned r; asm volatile("v_cvt_pk_bf16_f32 %0, %1, %2" : "=v"(r) : "v"(lo), "v"(hi)); return r; }
typedef float f32x2 __attribute__((ext_vector_type(2)));
__device__ __forceinline__ f32x2 gelu_pk(f32x2 v) {
    const f32x2 av = __builtin_elementwise_abs(v), d = av * 0.2316418882f + 1.0f;
    f32x2 t; t.x = __builtin_amdgcn_rcpf(d.x); t.y = __builtin_amdgcn_rcpf(d.y);
    f32x2 q = t * 0.5307027145f + (-0.7265760135f); q = q * t + 0.7107068705f; q = q * t + (-0.142248368f); q = q * t + 0.127414796f; q = q * t;
    const f32x2 s = (v * v) * (-0.72134752044f);
    f32x2 e; e.x = __builtin_amdgcn_exp2f(s.x); e.y = __builtin_amdgcn_exp2f(s.y);
    const f32x2 m = v * (q * e), r = v - m;
    f32x2 o; o.x = v.x < 0.f ? m.x : r.x; o.y = v.y < 0.f ? m.y : r.y; return o;
}

template <int ACT  > struct EpiBf16 {
    static constexpr bool PERM = true, AFTER_DRAIN = false; static_assert(ACT == 0 || ACT == 1, "EpiBf16: ACT is 0 (none) or 1 (gelu_pk)");
    bf16_t* O; int ldc; const float* bias; int split_cols; size_t split_stride; float scale0;
    __device__ __forceinline__ void operator()(const f32x4 (&acc)[2][2][4][2], const Unit& u, int wr, int wc, int fr, int fq) const {
        const int row0 = u.pm * BM + wr * 64 + fr; int colt = u.pn * BM; bf16_t* base = O;
        float sc = 1.f; if (split_cols) { const int t = colt / split_cols; base += (size_t)t * split_stride; colt -= t * split_cols; if (t == 0) sc = scale0; }
        const int col0 = colt + wc * 32 + 8 * fq, bcol0 = u.pn * BM + wc * 32 + 8 * fq;
        f32x4 bv[2][2];
#pragma unroll
        for (int bj = 0; bj < 2; ++bj)
#pragma unroll
            for (int n = 0; n < 2; ++n) bv[bj][n] = bias ? *(const f32x4*)(bias + bcol0 + bj * HALF + 4 * n) : (f32x4){0.f, 0.f, 0.f, 0.f};
#pragma unroll
        for (int ai = 0; ai < 2; ++ai)
#pragma unroll
            for (int m = 0; m < 4; ++m) { bf16_t* rowp = base + (size_t)(row0 + ai * HALF + m * 16) * ldc + col0;
#pragma unroll
                for (int bj = 0; bj < 2; ++bj) { f32x4 v0 = acc[ai][bj][m][0] + bv[bj][0], v1 = acc[ai][bj][m][1] + bv[bj][1];
                    if (ACT == 1) { f32x2 a = gelu_pk((f32x2){v0[0], v0[1]}), b = gelu_pk((f32x2){v0[2], v0[3]}), c = gelu_pk((f32x2){v1[0], v1[1]}), d = gelu_pk((f32x2){v1[2], v1[3]});
                        v0 = (f32x4){a.x, a.y, b.x, b.y}; v1 = (f32x4){c.x, c.y, d.x, d.y}; }
                    v0 = v0 * sc; v1 = v1 * sc; u32x4 w; w.x = cvt_pk_bf16(v0[0], v0[1]); w.y = cvt_pk_bf16(v0[2], v0[3]); w.z = cvt_pk_bf16(v1[0], v1[1]); w.w = cvt_pk_bf16(v1[2], v1[3]);
                    *(u32x4*)(rowp + bj * HALF) = w; } }
    }
};

struct PanelStats {
    unsigned* xbuf;
    unsigned* cnt;
    unsigned* tmo;
    int ntn; float eps;
    unsigned code;
    __device__ __forceinline__ bool run(const f32x4 (&v)[2][2][4][2], const Unit& u, int wr, int wc, int fr, int fq, PG8_LAS unsigned char* lds, int wid, int lane) const {
        typedef float f32x2v __attribute__((ext_vector_type(2)));
        PG8_LAS f32x2v* P = (PG8_LAS f32x2v*)lds;
        PG8_LAS f32x2v* S = (PG8_LAS f32x2v*)(lds + 8192);
        PG8_LAS unsigned* flag = (PG8_LAS unsigned*)(lds + 8192 + 2048);
#pragma unroll
        for (int ai = 0; ai < 2; ++ai)
#pragma unroll
            for (int m = 0; m < 4; ++m) {
                float s = 0.f;
#pragma unroll
                for (int bj = 0; bj < 2; ++bj)
#pragma unroll
                    for (int n = 0; n < 2; ++n) { const f32x4 x = v[ai][bj][m][n]; s += (x[0] + x[1]) + (x[2] + x[3]); }
                s += __shfl_xor(s, 16); s += __shfl_xor(s, 32);
                const float mw = s * (1.0f / 64.0f); float q = 0.f;
#pragma unroll
                for (int bj = 0; bj < 2; ++bj)
#pragma unroll
                    for (int n = 0; n < 2; ++n) { const f32x4 d = v[ai][bj][m][n] - mw; q += (d[0] * d[0] + d[1] * d[1]) + (d[2] * d[2] + d[3] * d[3]); }
                q += __shfl_xor(q, 16); q += __shfl_xor(q, 32);
                if (fq == 0) P[(ai * HALF + wr * 64 + m * 16 + fr) * 4 + wc] = (f32x2v){mw, q};
            }
        asm volatile("s_waitcnt lgkmcnt(0)" ::: "memory"); __builtin_amdgcn_s_barrier(); asm volatile("" ::: "memory");
#if defined(BROKEN_EXCHANGE_NO_WAIT)
#warning BROKEN CONTROL BUILD: the row-statistics exchange does not wait; results are wrong by design
        if (blockIdx.x >= 64) { const long long t0_ = clock64(); while (clock64() - t0_ < 60000) __builtin_amdgcn_s_sleep(8); }
#endif
        const int row = wid * 32 + (lane & 31);
        if (lane < 32) {
            const f32x2v a = P[row * 4 + 0], b = P[row * 4 + 1], c = P[row * 4 + 2], d = P[row * 4 + 3];
            const float mt = (a.x + b.x + c.x + d.x) * 0.25f;
            const float da = a.x - mt, db = b.x - mt, dc = c.x - mt, dd = d.x - mt;
            const float m2 = (a.y + b.y) + (c.y + d.y) + 64.0f * ((da * da + db * db) + (dc * dc + dd * dd));
            unsigned long long* slot = (unsigned long long*)xbuf + ((size_t)(u.pm * BM + row) * 4 + u.pn);
            __hip_atomic_store(slot, ((unsigned long long)__float_as_uint(m2) << 32) | __float_as_uint(mt), __ATOMIC_RELAXED, __HIP_MEMORY_SCOPE_AGENT);
        }
        asm volatile("s_waitcnt vmcnt(0)" ::: "memory");
        if (lane == 0) __hip_atomic_fetch_add(cnt + 64 * u.pm, 1u, __ATOMIC_RELAXED, __HIP_MEMORY_SCOPE_AGENT);
        if (wid == 0) {
            bool dead = false; const unsigned long long t0 = __builtin_amdgcn_s_memrealtime(); const unsigned want = 8u * (unsigned)ntn;
            for (;;) {
#if defined(BROKEN_EXCHANGE_NO_WAIT)
                break;
#endif
                if ((unsigned)__builtin_amdgcn_readfirstlane(__hip_atomic_load(cnt + 64 * u.pm, __ATOMIC_RELAXED, __HIP_MEMORY_SCOPE_AGENT)) >= want) break;
                if (__builtin_amdgcn_s_memrealtime() - t0 > 2000000ull) {
                    if (lane == 0) { unsigned expect = 0u; __hip_atomic_compare_exchange_strong(tmo + 1, &expect, code | (unsigned)(u.pm & 0xff), __ATOMIC_RELAXED, __ATOMIC_RELAXED, __HIP_MEMORY_SCOPE_AGENT);
                                     __hip_atomic_store(tmo, 1u, __ATOMIC_RELAXED, __HIP_MEMORY_SCOPE_AGENT); }
                    dead = true; break; }
                __builtin_amdgcn_s_sleep(2);
            }
            __builtin_amdgcn_fence(__ATOMIC_ACQUIRE, "agent");
            if (lane == 0) flag[0] = dead ? 1u : 0u;
        }
        asm volatile("s_waitcnt vmcnt(0) lgkmcnt(0)" ::: "memory"); __builtin_amdgcn_s_barrier(); asm volatile("" ::: "memory");
        const bool bad = flag[0] != 0u;
        if (lane < 32) {
            const unsigned long long* slot = (const unsigned long long*)xbuf + (size_t)(u.pm * BM + row) * 4; float mt[4], m2[4]; float ms = 0.f;
#pragma unroll
            for (int t = 0; t < 4; ++t) { if (t < ntn) { const unsigned long long w = __hip_atomic_load(slot + t, __ATOMIC_RELAXED, __HIP_MEMORY_SCOPE_AGENT); mt[t] = __uint_as_float((unsigned)w); m2[t] = __uint_as_float((unsigned)(w >> 32)); } else { mt[t] = 0.f; m2[t] = 0.f; } ms += mt[t]; }
            const float mean = ms / (float)ntn; float q = 0.f;
#pragma unroll
            for (int t = 0; t < 4; ++t) if (t < ntn) { const float dm = mt[t] - mean; q += m2[t] + 256.0f * dm * dm; }
            S[row] = (f32x2v){mean, 1.0f / sqrtf(q / (256.0f * (float)ntn) + eps)};
        }
        asm volatile("s_waitcnt lgkmcnt(0)" ::: "memory"); __builtin_amdgcn_s_barrier(); asm volatile("" ::: "memory");
        return bad;
    }
};
struct EpiLnRes {
    static constexpr bool PERM = false, AFTER_DRAIN = true;
    const float* base; float* out; int ldc; const float* bias; PanelStats st; unsigned poison;
    __device__ __forceinline__ void fused(f32x4 (&acc)[2][2][4][2], const Unit& u, int wr, int wc, int fr, int fq, PG8_LAS unsigned char* lds, int wid, int lane) const {
        typedef float f32x2v __attribute__((ext_vector_type(2)));
        const PG8_LAS f32x2v* S = (const PG8_LAS f32x2v*)(lds + 8192);
        const int col0 = u.pn * BM + wc * 32 + 4 * fq;
#pragma unroll
        for (int bj = 0; bj < 2; ++bj)
#pragma unroll
            for (int n = 0; n < 2; ++n) { const f32x4 bv = bias ? *(const f32x4*)(bias + col0 + bj * HALF + n * 16) : (f32x4){0.f, 0.f, 0.f, 0.f};
#pragma unroll
                for (int ai = 0; ai < 2; ++ai)
#pragma unroll
                    for (int m = 0; m < 4; ++m) acc[ai][bj][m][n] += bv; }
        f32x4 pre[4][2][2];
#pragma unroll
        for (int m = 0; m < 4; ++m) { const size_t off = (size_t)(u.pm * BM + wr * 64 + m * 16 + fr) * ldc + col0;
#pragma unroll
            for (int bj = 0; bj < 2; ++bj)
#pragma unroll
                for (int n = 0; n < 2; ++n) pre[m][bj][n] = *(const f32x4*)(base + off + bj * HALF + n * 16); }
        const bool bad = st.run(acc, u, wr, wc, fr, fq, lds, wid, lane) || poison != 0u;
        const float qnan = __builtin_nanf("");
#pragma unroll
        for (int ai = 0; ai < 2; ++ai)
#pragma unroll
            for (int m = 0; m < 4; ++m) { const int r = ai * HALF + wr * 64 + m * 16 + fr; const f32x2v sr = S[r]; const size_t off = (size_t)(u.pm * BM + r) * ldc + col0;
#pragma unroll
                for (int bj = 0; bj < 2; ++bj)
#pragma unroll
                    for (int n = 0; n < 2; ++n) { const f32x4 bs = ai == 0 ? pre[m][bj][n] : *(const f32x4*)(base + off + bj * HALF + n * 16); f32x4 o = bs + (acc[ai][bj][m][n] - sr.x) * sr.y;
                        if (bad) o = (f32x4){qnan, qnan, qnan, qnan}; *(f32x4*)(out + off + bj * HALF + n * 16) = o; }
                if (m & 1) asm volatile("" ::: "memory"); }
    }
};
struct EpiLnResLn {
    static constexpr bool PERM = false, AFTER_DRAIN = true;
    const float* base; float* out; bf16_t* xn; int ldc; const float* bias; PanelStats st1, st2; unsigned poison;
    __device__ __forceinline__ void fused(f32x4 (&acc)[2][2][4][2], const Unit& u, int wr, int wc, int fr, int fq, PG8_LAS unsigned char* lds, int wid, int lane) const {
        typedef float f32x2v __attribute__((ext_vector_type(2))); typedef unsigned u32x2v __attribute__((ext_vector_type(2)));
        const PG8_LAS f32x2v* S = (const PG8_LAS f32x2v*)(lds + 8192);
        const int col0 = u.pn * BM + wc * 32 + 4 * fq;
#pragma unroll
        for (int bj = 0; bj < 2; ++bj)
#pragma unroll
            for (int n = 0; n < 2; ++n) { const f32x4 bv = bias ? *(const f32x4*)(bias + col0 + bj * HALF + n * 16) : (f32x4){0.f, 0.f, 0.f, 0.f};
#pragma unroll
                for (int ai = 0; ai < 2; ++ai)
#pragma unroll
                    for (int m = 0; m < 4; ++m) acc[ai][bj][m][n] += bv; }
        bool bad = st1.run(acc, u, wr, wc, fr, fq, lds, wid, lane) || poison != 0u;
        const float qnan = __builtin_nanf("");
#pragma unroll
        for (int ai = 0; ai < 2; ++ai)
#pragma unroll
            for (int m = 0; m < 4; ++m) { const int r = ai * HALF + wr * 64 + m * 16 + fr; const f32x2v sr = S[r]; const size_t off = (size_t)(u.pm * BM + r) * ldc + col0;
#pragma unroll
                for (int bj = 0; bj < 2; ++bj)
#pragma unroll
                    for (int n = 0; n < 2; ++n) { const f32x4 bs = *(const f32x4*)(base + off + bj * HALF + n * 16); acc[ai][bj][m][n] = bs + (acc[ai][bj][m][n] - sr.x) * sr.y; }
                asm volatile("" : "+v"(acc[ai][0][m][0]), "+v"(acc[ai][0][m][1]), "+v"(acc[ai][1][m][0]), "+v"(acc[ai][1][m][1]));
                if (m & 1) asm volatile("" ::: "memory"); }
        const bool bad1 = bad;
        bad = st2.run(acc, u, wr, wc, fr, fq, lds, wid, lane) || bad;
#pragma unroll
        for (int ai = 0; ai < 2; ++ai)
#pragma unroll
            for (int m = 0; m < 4; ++m) { const int r = ai * HALF + wr * 64 + m * 16 + fr; const f32x2v sr = S[r]; const size_t off = (size_t)(u.pm * BM + r) * ldc + col0;
#pragma unroll
                for (int bj = 0; bj < 2; ++bj)
#pragma unroll
                    for (int n = 0; n < 2; ++n) { const f32x4 x1 = acc[ai][bj][m][n]; *(f32x4*)(out + off + bj * HALF + n * 16) = bad1 ? (f32x4){qnan, qnan, qnan, qnan} : x1;
                        const f32x4 o = (x1 - sr.x) * sr.y; u32x2v w; w.x = cvt_pk_bf16(o[0], o[1]); w.y = cvt_pk_bf16(o[2], o[3]);
                        if (bad) { w.x = 0x7fc07fc0u; w.y = 0x7fc07fc0u; } *(u32x2v*)(xn + off + bj * HALF + n * 16) = w; }
                asm volatile("" ::: "memory"); }
    }
};

template <class Epi, class Sched, bool ALIGN_EPI = false, bool SP2 = false>
__device__ __forceinline__ void gemm_phase(PG8_LAS unsigned char* lds, const Gemm g, const Sched& S, const Epi& E) {
    const int tid = threadIdx.x, wid = __builtin_amdgcn_readfirstlane(tid >> 6), lane = tid & 63, wr = wid >> 2, wc = wid & 3, fr = lane & 15, fq = lane >> 4;
    const int K = g.K, nt = K / BK;
    unsigned voffA[2], voffB[2];
#pragma unroll
    for (int i = 0; i < 2; ++i) { int R, C; stage_rc(tid * 16 + i * 8192, R, C); const int Rb = Epi::PERM ? ((R & ~31) + perm32(R & 31)) : R;
        voffA[i] = (unsigned)(R * K + C) * 2u; voffB[i] = (unsigned)(Rb * K + C) * 2u; }
    const size_t kstep = (size_t)(BK * 2);
    const size_t hstep = (size_t)HALF * K * 2;
    const size_t tstep = 2 * hstep;
    const unsigned ldsw = (unsigned)wid * 1024u;
    const int aoff = lds_byte(wr * 64 + fr, fq * 8), boff = lds_byte(wc * 32 + fr, fq * 8);
#define PG8_SA(b, h) (((b) * 2 + (h)) * HTB)
#define PG8_SB(b, h) ((4 + (b) * 2 + (h)) * HTB)
#define PG8_STAGE(bufoff, gbase, voff) do { _Pragma("unroll") for (int _i = 0; _i < 2; ++_i) \
        __builtin_amdgcn_global_load_lds((const unsigned*)((const char*)(gbase) + (voff)[_i]), (PG8_LAS unsigned*)(lds + (bufoff) + ldsw + _i * 8192), 16, 0, 0); } while (0)
#define PG8_LDA(dst, b, h) do { _Pragma("unroll") for (int m = 0; m < 4; ++m) _Pragma("unroll") for (int k = 0; k < 2; ++k) dst[m][k] = *(const PG8_LAS bf16x8*)(lds + PG8_SA(b, h) + aoff + m * 2048 + k * 1024); } while (0)
#define PG8_LDB(dst, b, h) do { _Pragma("unroll") for (int n = 0; n < 2; ++n) _Pragma("unroll") for (int k = 0; k < 2; ++k) dst[n][k] = *(const PG8_LAS bf16x8*)(lds + PG8_SB(b, h) + boff + n * 2048 + k * 1024); } while (0)
#define PG8_MMA(ai, bj, At, Bt) do { __builtin_amdgcn_s_setprio(1); _Pragma("unroll") for (int m = 0; m < 4; ++m) _Pragma("unroll") for (int n = 0; n < 2; ++n) _Pragma("unroll") for (int k = 0; k < 2; ++k) \
        acc[ai][bj][m][n] = __builtin_amdgcn_mfma_f32_16x16x32_bf16(Bt[n][k], At[m][k], acc[ai][bj][m][n], 0, 0, 0); __builtin_amdgcn_s_setprio(0); } while (0)
#define PG8_WAIT_V(n) asm volatile("s_waitcnt vmcnt(" #n ")" ::: "memory")
#define PG8_WAIT_L(n) asm volatile("s_waitcnt lgkmcnt(" #n ")" ::: "memory")
#define PG8_BAR __builtin_amdgcn_s_barrier()
#define PG8_SCHED __builtin_amdgcn_sched_barrier(0)
    Unit cur, nxt; int ui = 0;
    if (!S.next(0, cur)) return;
    f32x4 acc[2][2][4][2];
#pragma unroll
    for (int a = 0; a < 2; ++a)
#pragma unroll
        for (int b = 0; b < 2; ++b)
#pragma unroll
            for (int m = 0; m < 4; ++m)
#pragma unroll
                for (int n = 0; n < 2; ++n) acc[a][b][m][n] = (f32x4){0.f, 0.f, 0.f, 0.f};
    bf16x8 At[4][2], B0[2][2], B1[2][2];
    const char* cA = (const char*)g.A + (size_t)cur.pm * tstep; const char* cB = (const char*)g.Bt + (size_t)cur.pn * tstep;
    S.a_ready(cur);
    if constexpr (SP2) {
        PG8_STAGE(PG8_SB(0, 0), cB, voffB); PG8_STAGE(PG8_SB(0, 1), cB + hstep, voffB); PG8_STAGE(PG8_SA(0, 0), cA, voffA); PG8_STAGE(PG8_SA(0, 1), cA + hstep, voffA);
        if (wr == 1) PG8_BAR;
        PG8_WAIT_V(2); PG8_BAR;
        PG8_STAGE(PG8_SB(1, 0), cB + kstep, voffB); PG8_STAGE(PG8_SA(1, 0), cA + kstep, voffA); PG8_STAGE(PG8_SB(1, 1), cB + hstep + kstep, voffB);
        PG8_WAIT_V(6); PG8_BAR;
    } else {
        PG8_STAGE(PG8_SB(0, 0), cB, voffB); PG8_STAGE(PG8_SA(0, 0), cA, voffA); PG8_STAGE(PG8_SB(0, 1), cB + hstep, voffB); PG8_STAGE(PG8_SA(0, 1), cA + hstep, voffA);
        if (wr == 1) PG8_BAR;
        PG8_WAIT_V(4); PG8_BAR;
        PG8_STAGE(PG8_SB(1, 0), cB + kstep, voffB); PG8_STAGE(PG8_SA(1, 0), cA + kstep, voffA); PG8_STAGE(PG8_SB(1, 1), cB + hstep + kstep, voffB);
        PG8_WAIT_V(6); PG8_BAR;
    }
    for (;;) {
        const bool has_next = S.next(ui + 1, nxt);
        const char* nA = has_next ? (const char*)g.A + (size_t)nxt.pm * tstep : cA; const char* nB = has_next ? (const char*)g.Bt + (size_t)nxt.pn * tstep : cB;
        for (int t = 0; t < nt; t += 2) {
            const bool last = (t == nt - 2);
            const char* a1 = cA + (size_t)(t + 1) * kstep;
            const char* a2 = last ? nA : cA + (size_t)(t + 2) * kstep; const char* b2 = last ? nB : cB + (size_t)(t + 2) * kstep;
            const char* a3 = a2 + kstep; const char* b3 = b2 + kstep;
            if (last && has_next) S.a_ready(nxt);
            if constexpr (SP2) {
            PG8_LDB(B0, 0, 0); PG8_LDB(B1, 0, 1); PG8_SCHED; PG8_LDA(At, 0, 0); PG8_STAGE(PG8_SA(1, 1), a1 + hstep, voffA);
            PG8_WAIT_V(8); PG8_WAIT_L(0); PG8_BAR; PG8_MMA(0, 0, At, B0); PG8_MMA(0, 1, At, B1); PG8_BAR; PG8_SCHED;
            PG8_LDA(At, 0, 1); PG8_STAGE(PG8_SB(0, 0), b2, voffB); PG8_STAGE(PG8_SB(0, 1), b2 + hstep, voffB); PG8_STAGE(PG8_SA(0, 0), a2, voffA);
            PG8_WAIT_V(8); PG8_WAIT_L(0); PG8_BAR; PG8_MMA(1, 0, At, B0); PG8_MMA(1, 1, At, B1); PG8_BAR; PG8_SCHED;
            PG8_LDB(B0, 1, 0); PG8_LDB(B1, 1, 1); PG8_SCHED; PG8_LDA(At, 1, 0); PG8_STAGE(PG8_SA(0, 1), a2 + hstep, voffA);
            PG8_WAIT_V(8); PG8_WAIT_L(0); PG8_BAR; PG8_MMA(0, 0, At, B0); PG8_MMA(0, 1, At, B1); PG8_BAR; PG8_SCHED;
            PG8_LDA(At, 1, 1); PG8_STAGE(PG8_SB(1, 0), b3, voffB); PG8_STAGE(PG8_SB(1, 1), b3 + hstep, voffB); PG8_STAGE(PG8_SA(1, 0), a3, voffA);
            PG8_WAIT_V(8); PG8_WAIT_L(0); PG8_BAR; PG8_MMA(1, 0, At, B0); PG8_MMA(1, 1, At, B1); PG8_BAR; PG8_SCHED;
            } else {
            PG8_LDB(B0, 0, 0); PG8_SCHED; PG8_LDA(At, 0, 0); PG8_STAGE(PG8_SA(1, 1), a1 + hstep, voffA);
            PG8_WAIT_L(8); PG8_BAR; PG8_WAIT_L(0); PG8_MMA(0, 0, At, B0); PG8_BAR; PG8_SCHED;
            PG8_LDB(B1, 0, 1); PG8_STAGE(PG8_SB(0, 0), b2, voffB);
            PG8_BAR; PG8_WAIT_L(0); PG8_MMA(0, 1, At, B1); PG8_BAR;
            PG8_LDA(At, 0, 1); PG8_STAGE(PG8_SA(0, 0), a2, voffA);
            PG8_BAR; PG8_WAIT_L(0); PG8_MMA(1, 0, At, B0); PG8_BAR; PG8_SCHED;
            PG8_STAGE(PG8_SB(0, 1), b2 + hstep, voffB);
            PG8_WAIT_V(6); PG8_BAR; PG8_MMA(1, 1, At, B1); PG8_BAR;
            PG8_LDB(B0, 1, 0); PG8_SCHED; PG8_LDA(At, 1, 0); PG8_STAGE(PG8_SA(0, 1), a2 + hstep, voffA);
            PG8_WAIT_L(8); PG8_BAR; PG8_WAIT_L(0); PG8_MMA(0, 0, At, B0); PG8_BAR; PG8_SCHED;
            PG8_LDB(B1, 1, 1); PG8_STAGE(PG8_SB(1, 0), b3, voffB);
            PG8_BAR; PG8_WAIT_L(0); PG8_MMA(0, 1, At, B1); PG8_BAR;
            PG8_LDA(At, 1, 1); PG8_STAGE(PG8_SA(1, 0), a3, voffA);
            PG8_BAR; PG8_WAIT_L(0); PG8_MMA(1, 0, At, B0); PG8_BAR; PG8_SCHED;
            PG8_STAGE(PG8_SB(1, 1), b3 + hstep, voffB);
            PG8_WAIT_V(6); PG8_BAR; PG8_MMA(1, 1, At, B1); PG8_BAR;
            }
        }
        if constexpr (ALIGN_EPI) { if (wr == 0) PG8_BAR; }
        if constexpr (!Epi::AFTER_DRAIN) { E(acc, cur, wr, wc, fr, fq); S.done(cur); }
        if (!has_next) break;
#pragma unroll
        for (int a = 0; a < 2; ++a)
#pragma unroll
            for (int b = 0; b < 2; ++b)
#pragma unroll
                for (int m = 0; m < 4; ++m)
#pragma unroll
                    for (int n = 0; n < 2; ++n) acc[a][b][m][n] = (f32x4){0.f, 0.f, 0.f, 0.f};
        cur = nxt; cA = nA; cB = nB; ++ui;
        if constexpr (ALIGN_EPI) { if (wr == 1) PG8_BAR; }
    }
    PG8_WAIT_V(0);
    if constexpr (!ALIGN_EPI) { if (wr == 0) PG8_BAR; }
    PG8_BAR;
    if constexpr (Epi::AFTER_DRAIN) { E.fused(acc, cur, wr, wc, fr, fq, lds, wid, lane); S.done(cur); }
#undef PG8_SA
#undef PG8_SB
#undef PG8_STAGE
#undef PG8_LDA
#undef PG8_LDB
#undef PG8_MMA
#undef PG8_WAIT_V
#undef PG8_WAIT_L
#undef PG8_BAR
#undef PG8_SCHED
}
}
typedef _Float16 f16;
__device__ __forceinline__ unsigned short f2h(float f) { const f16 h = (f16)f; return __builtin_bit_cast(unsigned short, h); }
__device__ __forceinline__ float h2f(unsigned short u) { return (float)__builtin_bit_cast(f16, u); }
__device__ __forceinline__ float bflo(unsigned p) { return __uint_as_float(p << 16); }
__device__ __forceinline__ float bfhi(unsigned p) { return __uint_as_float(p & 0xffff0000u); }
constexpr float C2 = 0.125f * 1.4426950408889634f;
constexpr int KIW = 72;

struct EpiF32 {
  static constexpr bool PERM = false, AFTER_DRAIN = false;
  float* C; int ldc, Mreal, Nreal;
  __device__ __forceinline__ void operator()(const pg8::f32x4 (&acc)[2][2][4][2], const pg8::Unit& u, int wr, int wc, int fr, int fq) const {
#pragma unroll
    for (int ai = 0; ai < 2; ++ai)
#pragma unroll
      for (int m = 0; m < 4; ++m) {
        const int r = u.pm * 256 + ai * 128 + wr * 64 + m * 16 + fr;
        if (r >= Mreal) continue;
#pragma unroll
        for (int bj = 0; bj < 2; ++bj)
#pragma unroll
          for (int n = 0; n < 2; ++n) {
            const int c = u.pn * 256 + bj * 128 + wc * 32 + n * 16 + 4 * fq;
            if (c < Nreal) *(pg8::f32x4*)(C + (size_t)r * ldc + c) = acc[ai][bj][m][n];
          }
      }
  }
};

struct EpiInProj {
  static constexpr bool PERM = false, AFTER_DRAIN = false;
  bf16_t* ub; bf16_t* qkvq; size_t kstride; float* kiw; const float* ropetab;
  __device__ __forceinline__ void operator()(const pg8::f32x4 (&acc)[2][2][4][2], const pg8::Unit& u, int wr, int wc, int fr, int fq) const {
    const int pn = u.pn;
#pragma unroll
    for (int ai = 0; ai < 2; ++ai)
#pragma unroll
      for (int m = 0; m < 4; ++m) {
        const int r = u.pm * 256 + ai * 128 + wr * 64 + m * 16 + fr;
        const bool rok = r < NROWS;
        int t = r < NR ? (r & (SEQ - 1)) + NMETA : ((r - NR) & 15);
        if (!rok) t = 0;
        if (pn < 4) {
#pragma unroll
          for (int n = 0; n < 2; ++n) {
            const pg8::f32x4 av = acc[ai][0][m][n], gv = acc[ai][1][m][n];
            float o[4];
#pragma unroll
            for (int j = 0; j < 4; ++j) o[j] = av[j] / (1.0f + __expf(-gv[j]));
            const int col = pn * 128 + wc * 32 + n * 16 + 4 * fq;
            if (rok) *(uint2*)(ub + (size_t)r * 512 + col) = make_uint2(pk2(o[0], o[1]), pk2(o[2], o[3]));
          }
        } else if (pn < 12) {
          const int kind = (pn - 4) >> 1, cbase = ((pn - 4) & 1) * 256;
#pragma unroll
          for (int bj = 0; bj < 2; ++bj)
#pragma unroll
            for (int n = 0; n < 2; ++n) {
              pg8::f32x4 v = acc[ai][bj][m][n];
              if (n == 0 && kind != 2 && (wc & 1) == 0) {
                const pg8::f32x4 cs = *(const pg8::f32x4*)(ropetab + t * 16 + 4 * (fq & 1)), sn = *(const pg8::f32x4*)(ropetab + t * 16 + 8 + 4 * (fq & 1));
#pragma unroll
                for (int j = 0; j < 4; ++j) { const float p = __shfl_xor(v[j], 32); v[j] = fq < 2 ? v[j] * cs[j] - p * sn[j] : v[j] * cs[j] + p * sn[j]; }
              }
              const int col = cbase + bj * 128 + wc * 32 + n * 16 + 4 * fq;
              bf16_t* dst = qkvq + (size_t)kind * kstride + (size_t)r * 512 + col;
              if (kind == 3) {
                if (rok) *(uint2*)dst = make_uint2((unsigned)f2h(v[0]) | ((unsigned)f2h(v[1]) << 16), (unsigned)f2h(v[2]) | ((unsigned)f2h(v[3]) << 16));
              } else {
                if (kind == 0) v = v * C2;
                if (rok) *(uint2*)dst = make_uint2(pk2(v[0], v[1]), pk2(v[2], v[3]));
              }
            }
        } else {
#pragma unroll
          for (int n = 0; n < 2; ++n) {
            const int col = wc * 32 + n * 16 + 4 * fq;
            if (rok && col < KIW) *(pg8::f32x4*)(kiw + (size_t)r * KIW + col) = acc[ai][0][m][n];
          }
        }
      }
  }
};

__device__ __forceinline__ void transpose_item(const float* __restrict__ W, int K, int N, bf16_t* __restrict__ WT, int ldt, float* scr, int k0, int n0, int drow0, int lane) {
#pragma unroll 8
  for (int i = 0; i < 32; ++i) { const int kk = 2 * i + (lane >> 5), n = n0 + (lane & 31); scr[kk * 33 + (lane & 31)] = n < N ? W[(size_t)(k0 + kk) * N + n] : 0.f; }
  asm volatile("s_waitcnt lgkmcnt(0)" ::: "memory");
  const int c = lane & 7;
#pragma unroll
  for (int j = 0; j < 4; ++j) { const int n = (lane >> 3) + 8 * j; const float* p = scr + (8 * c) * 33 + n;
    uint4 o; o.x = pk2(p[0 * 33], p[1 * 33]); o.y = pk2(p[2 * 33], p[3 * 33]); o.z = pk2(p[4 * 33], p[5 * 33]); o.w = pk2(p[6 * 33], p[7 * 33]);
    *(uint4*)(WT + (size_t)(drow0 + n) * ldt + k0 + 8 * c) = o; }
  asm volatile("s_waitcnt lgkmcnt(0)" ::: "memory");
}
__device__ __forceinline__ int winT_row(int c) {
  if (c < 512) return (c >> 7) * 256 + (c & 127);
  if (c < 1024) return ((c - 512) >> 7) * 256 + 128 + ((c - 512) & 127);
  return c;
}

struct XUnit { int pm, pn, e; };
template <class Epi, class Sched, bool GATHER>
__device__ __forceinline__ void gemm_phase_x(PG8_LAS unsigned char* lds, const bf16_t* Abase, unsigned apitch, int K, const Sched& S, const Epi& E) {
  using namespace pg8;
  const int tid = threadIdx.x, wid = __builtin_amdgcn_readfirstlane(tid >> 6), lane = tid & 63, wr = wid >> 2, wc = wid & 3, fr = lane & 15, fq = lane >> 4;
  const int nt = K / BK;
  unsigned voffB[2], vAc[2][2], vAn[2][2]; int Rl[2]; unsigned cOff[2];
#pragma unroll
  for (int i = 0; i < 2; ++i) { int R, C; stage_rc(tid * 16 + i * 8192, R, C); Rl[i] = R; cOff[i] = (unsigned)C * 2u; voffB[i] = (unsigned)(R * K + C) * 2u; }
  const size_t kstep = (size_t)(BK * 2), hstepB = (size_t)HALF * K * 2;
  const unsigned ldsw = (unsigned)wid * 1024u;
  const int aoff = lds_byte(wr * 64 + fr, fq * 8), boff = lds_byte(wc * 32 + fr, fq * 8);
#define X_SA(b, h) (((b) * 2 + (h)) * HTB)
#define X_SB(b, h) ((4 + (b) * 2 + (h)) * HTB)
#define X_STAGE(bufoff, gbase, voff) do { _Pragma("unroll") for (int _i = 0; _i < 2; ++_i) \
        __builtin_amdgcn_global_load_lds((const unsigned*)((const char*)(gbase) + (voff)[_i]), (PG8_LAS unsigned*)(lds + (bufoff) + ldsw + _i * 8192), 16, 0, 0); } while (0)
#define X_LDA(dst, b, h) do { _Pragma("unroll") for (int m = 0; m < 4; ++m) _Pragma("unroll") for (int k = 0; k < 2; ++k) dst[m][k] = *(const PG8_LAS bf16x8*)(lds + X_SA(b, h) + aoff + m * 2048 + k * 1024); } while (0)
#define X_LDB(dst, b, h) do { _Pragma("unroll") for (int n = 0; n < 2; ++n) _Pragma("unroll") for (int k = 0; k < 2; ++k) dst[n][k] = *(const PG8_LAS bf16x8*)(lds + X_SB(b, h) + boff + n * 2048 + k * 1024); } while (0)
#define X_MMA(ai, bj, At, Bt) do { __builtin_amdgcn_s_setprio(1); _Pragma("unroll") for (int m = 0; m < 4; ++m) _Pragma("unroll") for (int n = 0; n < 2; ++n) _Pragma("unroll") for (int k = 0; k < 2; ++k) \
        acc[ai][bj][m][n] = __builtin_amdgcn_mfma_f32_16x16x32_bf16(Bt[n][k], At[m][k], acc[ai][bj][m][n], 0, 0, 0); __builtin_amdgcn_s_setprio(0); } while (0)
#define X_WAIT_V(n) asm volatile("s_waitcnt vmcnt(" #n ")" ::: "memory")
#define X_WAIT_L(n) asm volatile("s_waitcnt lgkmcnt(" #n ")" ::: "memory")
#define X_BAR __builtin_amdgcn_s_barrier()
#define X_SCHED __builtin_amdgcn_sched_barrier(0)
#define X_SETV(dst, u) do { if constexpr (GATHER) { const int* rw_ = S.rows(u); _Pragma("unroll") for (int h = 0; h < 2; ++h) _Pragma("unroll") for (int i = 0; i < 2; ++i) dst[h][i] = (unsigned)rw_[h * HALF + Rl[i]] * apitch + cOff[i]; } \
        else { _Pragma("unroll") for (int h = 0; h < 2; ++h) _Pragma("unroll") for (int i = 0; i < 2; ++i) dst[h][i] = (unsigned)(h * HALF + Rl[i]) * apitch + cOff[i]; } } while (0)
  XUnit cur, nxt; int ui = 0;
  if (!S.next(0, cur)) return;
  f32x4 acc[2][2][4][2];
#pragma unroll
  for (int a = 0; a < 2; ++a)
#pragma unroll
    for (int b = 0; b < 2; ++b)
#pragma unroll
      for (int m = 0; m < 4; ++m)
#pragma unroll
        for (int n = 0; n < 2; ++n) acc[a][b][m][n] = (f32x4){0.f, 0.f, 0.f, 0.f};
  bf16x8 At[4][2], B0[2][2], B1[2][2];
  const char* cA = GATHER ? (const char*)Abase : (const char*)S.a_ptr(cur); const char* cB = (const char*)S.b_ptr(cur);
  X_SETV(vAc, cur);
  X_STAGE(X_SB(0, 0), cB, voffB); X_STAGE(X_SB(0, 1), cB + hstepB, voffB); X_STAGE(X_SA(0, 0), cA, vAc[0]); X_STAGE(X_SA(0, 1), cA, vAc[1]);
  if (wr == 1) X_BAR;
  X_WAIT_V(2); X_BAR;
  X_STAGE(X_SB(1, 0), cB + kstep, voffB); X_STAGE(X_SA(1, 0), cA + kstep, vAc[0]); X_STAGE(X_SB(1, 1), cB + hstepB + kstep, voffB);
  X_WAIT_V(6); X_BAR;
  for (;;) {
    const bool has_next = S.next(ui + 1, nxt);
    const char* nA = has_next ? (GATHER ? (const char*)Abase : (const char*)S.a_ptr(nxt)) : cA; const char* nB = has_next ? (const char*)S.b_ptr(nxt) : cB;
    if (has_next) { X_SETV(vAn, nxt); } else {
#pragma unroll
      for (int h = 0; h < 2; ++h)
#pragma unroll
        for (int i = 0; i < 2; ++i) vAn[h][i] = vAc[h][i]; }
    for (int t = 0; t < nt; t += 2) {
      const bool last = (t == nt - 2);
      const char* a1 = cA + (size_t)(t + 1) * kstep;
      const char* a2 = last ? nA : cA + (size_t)(t + 2) * kstep; const char* b2 = last ? nB : cB + (size_t)(t + 2) * kstep;
      const char* a3 = a2 + kstep; const char* b3 = b2 + kstep;
      unsigned v0[2], v1[2];
#pragma unroll
      for (int i = 0; i < 2; ++i) { v0[i] = last ? vAn[0][i] : vAc[0][i]; v1[i] = last ? vAn[1][i] : vAc[1][i]; }
      X_LDB(B0, 0, 0); X_LDB(B1, 0, 1); X_SCHED; X_LDA(At, 0, 0); X_STAGE(X_SA(1, 1), a1, vAc[1]);
      X_WAIT_V(8); X_WAIT_L(0); X_BAR; X_MMA(0, 0, At, B0); X_MMA(0, 1, At, B1); X_BAR; X_SCHED;
      X_LDA(At, 0, 1); X_STAGE(X_SB(0, 0), b2, voffB); X_STAGE(X_SB(0, 1), b2 + hstepB, voffB); X_STAGE(X_SA(0, 0), a2, v0);
      X_WAIT_V(8); X_WAIT_L(0); X_BAR; X_MMA(1, 0, At, B0); X_MMA(1, 1, At, B1); X_BAR; X_SCHED;
      X_LDB(B0, 1, 0); X_LDB(B1, 1, 1); X_SCHED; X_LDA(At, 1, 0); X_STAGE(X_SA(0, 1), a2, v1);
      X_WAIT_V(8); X_WAIT_L(0); X_BAR; X_MMA(0, 0, At, B0); X_MMA(0, 1, At, B1); X_BAR; X_SCHED;
      X_LDA(At, 1, 1); X_STAGE(X_SB(1, 0), b3, voffB); X_STAGE(X_SB(1, 1), b3 + hstepB, voffB); X_STAGE(X_SA(1, 0), a3, v0);
      X_WAIT_V(8); X_WAIT_L(0); X_BAR; X_MMA(1, 0, At, B0); X_MMA(1, 1, At, B1); X_BAR; X_SCHED;
    }
    if (wr == 0) X_BAR;
    E(acc, cur, wr, wc, fr, fq);
    if (!has_next) break;
#pragma unroll
    for (int a = 0; a < 2; ++a)
#pragma unroll
      for (int b = 0; b < 2; ++b)
#pragma unroll
        for (int m = 0; m < 4; ++m)
#pragma unroll
          for (int n = 0; n < 2; ++n) acc[a][b][m][n] = (f32x4){0.f, 0.f, 0.f, 0.f};
    cur = nxt; cA = nA; cB = nB; ++ui;
#pragma unroll
    for (int h = 0; h < 2; ++h)
#pragma unroll
      for (int i = 0; i < 2; ++i) vAc[h][i] = vAn[h][i];
    if (wr == 1) X_BAR;
  }
  X_WAIT_V(0);
  X_BAR;
#undef X_SA
#undef X_SB
#undef X_STAGE
#undef X_LDA
#undef X_LDB
#undef X_MMA
#undef X_WAIT_V
#undef X_WAIT_L
#undef X_BAR
#undef X_SCHED
#undef X_SETV
}

constexpr int MOE_MAXT = 131072 / 256 + 64;
struct MoeSched {
  const int* tstart;
  int NN, G, c;
  const bf16_t* Bw; size_t bstride_e; int K;
  const bf16_t* Aw;
  const int* tokmap;
  __device__ __forceinline__ bool next(int i, XUnit& u) const {
    const int L = i * G + c, total = tstart[65] * NN; if (L >= total) return false;
    int e = 0;
#pragma unroll 1
    while (tstart[e + 1] * NN <= L) ++e;
    const int ne = tstart[e + 1] - tstart[e], r = L - tstart[e] * NN;
    u.e = e; u.pn = r / ne; u.pm = tstart[e] + r % ne; return true;
  }
  __device__ __forceinline__ const bf16_t* b_ptr(const XUnit& u) const { return Bw + (size_t)u.e * bstride_e + (size_t)u.pn * 256 * K; }
  __device__ __forceinline__ const bf16_t* a_ptr(const XUnit& u) const { return Aw + (size_t)u.pm * 256 * K; }
  __device__ __forceinline__ const int* rows(const XUnit& u) const { return tokmap + u.pm * 256; }
};
struct EpiGateUp {
  bf16_t* hdn;
  __device__ __forceinline__ void operator()(const pg8::f32x4 (&acc)[2][2][4][2], const XUnit& u, int wr, int wc, int fr, int fq) const {
#pragma unroll
    for (int ai = 0; ai < 2; ++ai)
#pragma unroll
      for (int m = 0; m < 4; ++m) {
        const size_t slot = (size_t)u.pm * 256 + ai * 128 + wr * 64 + m * 16 + fr;
#pragma unroll
        for (int n = 0; n < 2; ++n) {
          const pg8::f32x4 g = acc[ai][0][m][n], up = acc[ai][1][m][n]; float o[4];
#pragma unroll
          for (int j = 0; j < 4; ++j) o[j] = g[j] / (1.0f + __expf(-g[j])) * up[j];
          *(uint2*)(hdn + slot * DE + u.pn * 128 + wc * 32 + n * 16 + 4 * fq) = make_uint2(pk2(o[0], o[1]), pk2(o[2], o[3]));
        }
      }
  }
};
struct EpiDown {
  float* out; const int* tokmap; const float* wslot;
  __device__ __forceinline__ void operator()(const pg8::f32x4 (&acc)[2][2][4][2], const XUnit& u, int wr, int wc, int fr, int fq) const {
#pragma unroll
    for (int ai = 0; ai < 2; ++ai)
#pragma unroll
      for (int m = 0; m < 4; ++m) {
        const int slot = u.pm * 256 + ai * 128 + wr * 64 + m * 16 + fr;
        const float w = wslot[slot];
        if (w != 0.f) {
          float* orow = out + (size_t)tokmap[slot] * D + u.pn * 256 + wc * 32 + 4 * fq;
#pragma unroll
          for (int bj = 0; bj < 2; ++bj)
#pragma unroll
            for (int n = 0; n < 2; ++n)
#pragma unroll
              for (int j = 0; j < 4; ++j) atomicAdd(orow + bj * 128 + n * 16 + j, acc[ai][bj][m][n][j] * w);
        }
      }
  }
};

constexpr int NTHR = 512, NWAVES = 8;
constexpr int LDS_BYTES = 147456;
constexpr int MISC_OFF = 131072 + 8192;
constexpr size_t CTL_BYTES = 65536;

struct Args {
  const float *x, *meta, *ln_emb_g, *ln_emb_b, *w_in, *conv_w, *conv_b, *lnc_g, *lnc_b, *lnk_g, *lnk_b, *w_out, *ln1_g, *ln1_b, *w_router, *r_bias,
              *w_gate, *w_up, *w_down, *ws_gate, *ws_up, *ws_down, *ln2_g, *ln2_b;
  float* out; unsigned char* ws;
  float ropeinv[8];
};
__device__ __forceinline__ unsigned fkey(float f) { unsigned u = __float_as_uint(f); return (u & 0x80000000u) ? ~u : (u | 0x80000000u); }

__global__ void __launch_bounds__(NTHR, 2) mega_fwd(Args a) {
  extern __shared__ __attribute__((aligned(16))) unsigned char lds_raw[];
  float* lds = (float*)lds_raw;
  const int tid = threadIdx.x, lane = tid & 63, wave = tid >> 6, G = gridDim.x, bid = blockIdx.x;
  const int gw = bid * NWAVES + wave, NGW = G * NWAVES;
  unsigned char* ws = a.ws;
  size_t off = CTL_BYTES;
  auto carve = [&](size_t bytes) { unsigned char* p = ws + off; off += (bytes + 255) & ~(size_t)255; return p; };
  unsigned* barw = (unsigned*)ws;
  int* ecnt = (int*)(ws + 16384); int* ecur = ecnt + 64; int* eoff = (int*)(ws + 32768);
  float* ropetab = (float*)carve((size_t)TP * 16 * 4);
  float2* st0 = (float2*)carve((size_t)NROWS * 8);
  unsigned short* sel = (unsigned short*)carve((size_t)NR * TOPK * 2);
  int* selcnt = (int*)carve((size_t)NR * 4);
  int* ridx = (int*)carve((size_t)NR * TOPE * 4);  float* rw = (float*)carve((size_t)NR * TOPE * 4);
  constexpr int NSLOT = (MOE_MAXT + 64) * 256;
  int* tokmap = (int*)carve((size_t)NSLOT * 4);  float* wslot = (float*)carve((size_t)NSLOT * 4);
  bf16_t* WinT = (bf16_t*)carve((size_t)3328 * D * 2);
  bf16_t* WoutT = (bf16_t*)carve((size_t)D * D * 2);
  unsigned char* regionE = ws + off;
  constexpr size_t WGU_E = (size_t)512 * D, WD_E = (size_t)D * DE;
  (void)carve((size_t)(NE + 1) * (WGU_E + WD_E) * 2);
  bf16_t* h0b = (bf16_t*)regionE;
  bf16_t* WguT = (bf16_t*)regionE; bf16_t* WdT = WguT + (size_t)(NE + 1) * WGU_E;
  unsigned short* kiF = (unsigned short*)carve((size_t)NROWS * 64 * 2);
  unsigned short* qlin = (unsigned short*)carve((size_t)NR * 64 * 2);
  float* wq = (float*)carve((size_t)NR * 8 * 4);
  bf16_t* h1b = (bf16_t*)carve((size_t)NR * D * 2);
  unsigned char* regionP = ws + off;
  bf16_t* ub = (bf16_t*)carve((size_t)NROWS * 512 * 2);
  constexpr size_t KSTRIDE = (size_t)NROWS * 512;
  bf16_t* qb = (bf16_t*)carve(KSTRIDE * 2 * 4);
  bf16_t* kb = qb + KSTRIDE; bf16_t* vb = qb + 2 * KSTRIDE; unsigned short* qih = qb + 3 * KSTRIDE;
  float* kiw = (float*)carve((size_t)NROWS * KIW * 4);
  bf16_t* mixb = h0b; float* tmp = (float*)regionP; bf16_t* hdn = (bf16_t*)regionP;
  float* out = a.out;

  volatile LAS unsigned* misc = (volatile LAS unsigned*)((LAS unsigned char*)lds_raw + MISC_OFF);
  if (tid < 16) misc[tid] = 0u;
  __syncthreads();
  XcdBarrier bar = xcd_barrier_post(barw, misc);

  {
    float4* o4 = (float4*)out;
    for (size_t i = (size_t)bid * NTHR + tid; i < (size_t)NR * D / 4; i += (size_t)G * NTHR) o4[i] = make_float4(0.f, 0.f, 0.f, 0.f);
    for (int i = bid * NTHR + tid; i < TP * 8; i += G * NTHR) {
      const int t = i >> 3, j = i & 7; float sn, cs; sincosf((float)t * a.ropeinv[j], &sn, &cs);
      ropetab[t * 16 + j] = cs; ropetab[t * 16 + 8 + j] = sn;
    }
    for (int m = gw; m < NROWS; m += NGW) {
      const float* src = m < NR ? a.x + (size_t)m * D : a.meta + (size_t)((m - NR) & 15) * D;
      float v[16]; float s = 0.f;
#pragma unroll
      for (int i = 0; i < 16; ++i) { v[i] = src[i * 64 + lane]; s += v[i]; }
      const float mu = wave_sum(s) * (1.0f / D);
      float q = 0.f;
#pragma unroll
      for (int i = 0; i < 16; ++i) { const float d = v[i] - mu; q += d * d; }
      const float rstd = rsqrtf(wave_sum(q) * (1.0f / D) + LN_EPS);
#pragma unroll
      for (int i = 0; i < 16; ++i) { const int c = i * 64 + lane; h0b[(size_t)m * D + c] = (bf16_t)f2bf((v[i] - mu) * rstd * a.ln_emb_g[c] + a.ln_emb_b[c]); }
      if (lane == 0) st0[m] = make_float2(mu, rstd);
    }
    {
      float* scr = lds + wave * 2304;
      constexpr int NB_IN = (IN_W + 31) / 32, I_IN = (D / 64) * NB_IN, I_OUT = (D / 64) * (D / 32);
      for (int it = gw; it < I_IN + I_OUT; it += NGW) {
        if (it < I_IN) { const int kb_ = it / NB_IN, nb = it % NB_IN; transpose_item(a.w_in, D, IN_W, WinT, D, scr, 64 * kb_, 32 * nb, winT_row(32 * nb), lane); }
        else { const int r = it - I_IN, kb_ = r / (D / 32), nb = r % (D / 32); transpose_item(a.w_out, D, D, WoutT, D, scr, 64 * kb_, 32 * nb, 32 * nb, lane); }
      }
    }
  }
  xcd_barrier(bar);
  {
    pg8::Gemm g{h0b, WinT, 16640, 3328, D}; pg8::StaticOrder S; S.init(16640, 3328, G, bid);
    EpiInProj E{ub, qb, KSTRIDE, kiw, ropetab};
    pg8::gemm_phase<EpiInProj, pg8::StaticOrder, true, true>((PG8_LAS unsigned char*)lds_raw, g, S, E);
  }
  xcd_barrier(bar);
  for (int m = gw; m < NROWS; m += NGW) {
    const int t = m < NR ? (m & (SEQ - 1)) + NMETA : ((m - NR) & 15);
    const float xk = kiw[(size_t)m * KIW + lane];
    const float mu = wave_sum(xk) * (1.0f / IDD), dv = xk - mu;
    const float rstd = rsqrtf(wave_sum(dv * dv) * (1.0f / IDD) + LN_EPS);
    float y = dv * rstd * a.lnk_g[lane] + a.lnk_b[lane];
    const float p = __shfl_xor(y, 8);
    if (lane < 16) { const float cs = ropetab[t * 16 + (lane & 7)], sn = ropetab[t * 16 + 8 + (lane & 7)]; y = lane < 8 ? y * cs - p * sn : y * cs + p * sn; }
    kiF[(size_t)m * 64 + lane] = f2h(y);
    if (m < NR) {
      float wl = 0.f;
      if (lane < 8) { wl = kiw[(size_t)m * KIW + 64 + lane] * (0.35355339059327373f * 0.125f * 0.5f); wq[(size_t)m * 8 + lane] = wl; }
      float ql = 0.f;
#pragma unroll
      for (int h = 0; h < IH; ++h) ql += __shfl(wl, h) * h2f(qih[(size_t)m * 512 + h * 64 + lane]);
      qlin[(size_t)m * 64 + lane] = f2h(ql);
    }
  }
  for (int tile = bid; tile < NR / 32; tile += G) {
    const int m0 = tile * 32, b = m0 >> 13, s0 = m0 & (SEQ - 1);
    bf16_t* ubuf = (bf16_t*)lds_raw;
    float* res = (float*)(lds_raw + 65536);
    __syncthreads();
    for (int i = tid; i < 62 * 64; i += NTHR) {
      const int rr = i >> 6, cc = i & 63, s = s0 - 30 + rr, t = s + NMETA;
      uint4 v = make_uint4(0u, 0u, 0u, 0u);
      if (t >= 0) { const int row = t < NMETA ? NR + b * NMETA + t : b * SEQ + s; v = *(const uint4*)(ub + (size_t)row * 512 + cc * 8); }
      *(uint4*)(ubuf + rr * 512 + cc * 8) = v;
    }
    __syncthreads();
    {
      const int hf = tid >> 8, cp = tid & 255;
      float cw0[CONV_W], cw1[CONV_W];
#pragma unroll
      for (int w = 0; w < CONV_W; ++w) { const float2 c2 = *(const float2*)(a.conv_w + w * CONV_CH + 2 * cp); cw0[w] = c2.x; cw1[w] = c2.y; }
      const float2 cb = *(const float2*)(a.conv_b + 2 * cp);
#pragma unroll 1
      for (int rr = 0; rr < 16; ++rr) {
        const int r = hf * 16 + rr; float a0 = cb.x, a1 = cb.y;
#pragma unroll
        for (int w = 0; w < CONV_W; ++w) { const unsigned pr = *(const unsigned*)(ubuf + (r + w) * 512 + 2 * cp); a0 += cw0[w] * bflo(pr); a1 += cw1[w] * bfhi(pr); }
        *(float2*)(res + r * 512 + 2 * cp) = make_float2(a0, a1);
      }
    }
    __syncthreads();
#pragma unroll 1
    for (int rr = 0; rr < 4; ++rr) {
      const int r = wave + 8 * rr; float v[8]; float s = 0.f;
#pragma unroll
      for (int j = 0; j < 8; ++j) { v[j] = res[r * 512 + j * 64 + lane]; s += v[j]; }
      const float mu = wave_sum(s) * (1.0f / CONV_CH); float q = 0.f;
#pragma unroll
      for (int j = 0; j < 8; ++j) { v[j] -= mu; q += v[j] * v[j]; }
      const float rstd = rsqrtf(wave_sum(q) * (1.0f / CONV_CH) + LN_EPS);
#pragma unroll
      for (int j = 0; j < 8; ++j) { const int c = j * 64 + lane; const float y = v[j] * rstd * a.lnc_g[c] + a.lnc_b[c]; mixb[(size_t)(m0 + r) * D + c] = (bf16_t)f2bf(y / (1.0f + __expf(-y))); }
    }
  }
  xcd_barrier(bar);
  for (int m = bid; m < NR; m += G) {
    float* qs = lds;
    float* wsm = lds + 512;
    float* qls = lds + 576;
    unsigned* keys = (unsigned*)(lds + 1024);
    int* cnts = (int*)(lds + 1024 + 8320);
    int* scan_a = cnts + 16; int* scan_b = scan_a + 512;
    const int b = m >> 13, t = (m & (SEQ - 1)) + NMETA, n = t + 1;
    __syncthreads();
    qs[tid] = h2f(qih[(size_t)m * 512 + tid]);
    if (tid < IH) wsm[tid] = wq[(size_t)m * 8 + tid];
    if (tid < 64) qls[tid] = h2f(qlin[(size_t)m * 64 + tid]);
    __syncthreads();
    for (int c = tid; c < n; c += NTHR) {
      const unsigned short* kr = kiF + (size_t)row_of(b, c) * 64;
      float kv[IDD];
#pragma unroll
      for (int i = 0; i < IDD; i += 8) { const uint4 v = *(const uint4*)(kr + i);
        kv[i] = h2f((unsigned short)(v.x & 0xffff)); kv[i + 1] = h2f((unsigned short)(v.x >> 16)); kv[i + 2] = h2f((unsigned short)(v.y & 0xffff)); kv[i + 3] = h2f((unsigned short)(v.y >> 16));
        kv[i + 4] = h2f((unsigned short)(v.z & 0xffff)); kv[i + 5] = h2f((unsigned short)(v.z >> 16)); kv[i + 6] = h2f((unsigned short)(v.w & 0xffff)); kv[i + 7] = h2f((unsigned short)(v.w >> 16)); }
      float sc = 0.f;
#pragma unroll
      for (int i = 0; i < IDD; ++i) sc += qls[i] * kv[i];
#pragma unroll 1
      for (int h = 0; h < IH; ++h) {
        float s = 0.f;
#pragma unroll
        for (int i = 0; i < IDD; ++i) s += qs[h * IDD + i] * kv[i];
        sc += wsm[h] * fabsf(s);
      }
      keys[c] = fkey(sc);
    }
    __syncthreads();
    unsigned short* o = sel + (size_t)m * TOPK;
    if (n <= TOPK) {
      if (tid < TOPK) o[tid] = (unsigned short)(tid < n ? tid : 0);
      if (tid == 0) selcnt[m] = n;
    } else {
      unsigned lo = 0u;
      for (int bit = 31; bit >= 0; --bit) {
        const unsigned cand = lo | (1u << bit);
        int c0 = 0;
        for (int c = tid; c < n; c += NTHR) c0 += (keys[c] >= cand) ? 1 : 0;
        c0 = (int)wave_sum((float)c0);
        __syncthreads();
        if (lane == 0) cnts[wave] = c0;
        __syncthreads();
        int tot = 0;
        for (int i = 0; i < 8; ++i) tot += cnts[i];
        if (tot >= TOPK) lo = cand;
      }
      const unsigned T = lo;
      const int chunk = (n + NTHR - 1) / NTHR, c_lo = min(n, tid * chunk), c_hi = min(n, c_lo + chunk);
      int ngt = 0, neq = 0;
      for (int c = c_lo; c < c_hi; ++c) { const unsigned k = keys[c]; ngt += (k > T); neq += (k == T); }
      __syncthreads();
      scan_a[tid] = ngt; scan_b[tid] = neq;
      __syncthreads();
      if (tid == 0) { int aa = 0, e = 0; for (int i = 0; i < NTHR; ++i) { const int xg = scan_a[i], y = scan_b[i]; scan_a[i] = aa; scan_b[i] = e; aa += xg; e += y; } cnts[8] = aa; }
      __syncthreads();
      const int total_gt = cnts[8], need_eq = TOPK - total_gt;
      int pg = scan_a[tid], pe = scan_b[tid];
      for (int c = c_lo; c < c_hi; ++c) {
        const unsigned k = keys[c];
        if (k > T) { o[pg + min(pe, need_eq)] = (unsigned short)c; ++pg; }
        else if (k == T) { if (pe < need_eq) o[pg + pe] = (unsigned short)c; ++pe; }
      }
      if (tid == 0) selcnt[m] = TOPK;
    }
  }
  xcd_barrier(bar);
  for (int it = bid; it * 2 < NR; it += G) {
    const int half = tid >> 8, vt = tid & 255;
    int m = it * 2 + half; const bool live = m < NR; if (!live) m = NR - 1;
    float* qs = lds + half * 4096;
    float* lg = qs + 512;
    int* rows = (int*)(qs + 512 + 2048);
    const int b = m >> 13, cnt = selcnt[m];
    __syncthreads();
    for (int i = vt; i < NH * HD; i += 256) qs[i] = bf2f(qb[(size_t)m * 512 + i]);
    rows[vt] = vt < cnt ? row_of(b, (int)sel[(size_t)m * TOPK + vt]) : 0;
    __syncthreads();
    if (vt < cnt) {
      const bf16_t* kr = kb + (size_t)rows[vt] * 512;
      for (int h = 0; h < NH; ++h) {
        float s = 0.f;
        for (int i = 0; i < HD; i += 8) { const uint4 v = *(const uint4*)(kr + h * HD + i); const float* q = qs + h * HD + i;
          s += q[0] * bflo(v.x) + q[1] * bfhi(v.x) + q[2] * bflo(v.y) + q[3] * bfhi(v.y) + q[4] * bflo(v.z) + q[5] * bfhi(v.z) + q[6] * bflo(v.w) + q[7] * bfhi(v.w); }
        lg[h * TOPK + vt] = s;
      }
    } else {
      for (int h = 0; h < NH; ++h) lg[h * TOPK + vt] = -INFINITY;
    }
    __syncthreads();
    {
      const int h = vt >> 5, l = vt & 31;
      float mx = -INFINITY;
      for (int j = l; j < TOPK; j += 32) mx = fmaxf(mx, lg[h * TOPK + j]);
      for (int o = 16; o > 0; o >>= 1) mx = fmaxf(mx, __shfl_xor(mx, o));
      float sm = 0.f;
      for (int j = l; j < TOPK; j += 32) { const float e = exp2f(lg[h * TOPK + j] - mx); lg[h * TOPK + j] = e; sm += e; }
      for (int o = 16; o > 0; o >>= 1) sm += __shfl_xor(sm, o);
      const float inv = 1.0f / sm;
      for (int j = l; j < TOPK; j += 32) lg[h * TOPK + j] *= inv;
    }
    __syncthreads();
    for (int o = vt; o < NH * HD; o += 256) {
      const int h = o >> 6; float acc = 0.f;
      for (int j = 0; j < cnt; ++j) acc += lg[h * TOPK + j] * bf2f(vb[(size_t)rows[j] * 512 + o]);
      if (live) mixb[(size_t)m * D + CONV_CH + o] = (bf16_t)f2bf(acc);
    }
  }
  xcd_barrier(bar);
  {
    pg8::Gemm g{mixb, WoutT, NR, D, D}; pg8::StaticOrder S; S.init(NR, D, G, bid);
    EpiF32 E{tmp, D, NR, D};
    pg8::gemm_phase<EpiF32, pg8::StaticOrder, true, true>((PG8_LAS unsigned char*)lds_raw, g, S, E);
  }
  xcd_barrier(bar);
  {
    float* scr = lds + wave * 2304;
    for (int it = gw; it < (NE + 1) * 384; it += NGW) {
      const int e = it / 384, r = it % 384, which = r >> 7, q = r & 127;
      if (which < 2) {
        const float* W = e < NE ? (which ? a.w_up : a.w_gate) + (size_t)e * D * DE : (which ? a.ws_up : a.ws_gate);
        const int kb_ = q >> 3, nb = q & 7, n0 = 32 * nb;
        transpose_item(W, D, DE, WguT + (size_t)e * WGU_E, D, scr, 64 * kb_, n0, (n0 >> 7) * 256 + which * 128 + (n0 & 127), lane);
      } else {
        const float* W = e < NE ? a.w_down + (size_t)e * DE * D : a.ws_down;
        const int kb_ = q >> 5, nb = q & 31;
        transpose_item(W, DE, D, WdT + (size_t)e * WD_E, DE, scr, 64 * kb_, 32 * nb, 32 * nb, lane);
      }
    }
  }
  for (int m = gw; m < NR; m += NGW) {
    const float2 st = st0[m];
    float v[16]; float s = 0.f;
#pragma unroll
    for (int i = 0; i < 16; ++i) { const int c = i * 64 + lane; const float hh = (a.x[(size_t)m * D + c] - st.x) * st.y * a.ln_emb_g[c] + a.ln_emb_b[c]; v[i] = DN_ALPHA * hh + tmp[(size_t)m * D + c]; s += v[i]; }
    const float mu = wave_sum(s) * (1.0f / D);
    float q = 0.f;
#pragma unroll
    for (int i = 0; i < 16; ++i) { const float d = v[i] - mu; q += d * d; }
    const float rstd = rsqrtf(wave_sum(q) * (1.0f / D) + LN_EPS);
#pragma unroll
    for (int i = 0; i < 16; ++i) { const int c = i * 64 + lane; v[i] = (v[i] - mu) * rstd * a.ln1_g[c] + a.ln1_b[c]; h1b[(size_t)m * D + c] = (bf16_t)f2bf(v[i]); }
    float lgt = 0.f;
#pragma unroll
    for (int i = 0; i < 16; ++i)
      for (int j = 0; j < 64; ++j) lgt += __shfl(v[i], j) * a.w_router[(i * 64 + j) * NE + lane];
    const float score = sigmoidf_(lgt), biased = score + a.r_bias[lane];
    float m1 = -INFINITY, m2 = -INFINITY;
    for (int j = 0; j < 8; ++j) { const float vv = __shfl(biased, (lane & ~7) + j); if (vv > m1) { m2 = m1; m1 = vv; } else if (vv > m2) m2 = vv; }
    const float gs = m1 + m2; const int g = lane >> 3;
    int grank = 0;
    for (int j = 0; j < 8; ++j) { const float vv = __shfl(gs, j * 8); grank += (vv > gs || (vv == gs && j < g)) ? 1 : 0; }
    const float val = grank < 4 ? biased : -INFINITY;
    int rank = 0;
    for (int j = 0; j < 64; ++j) { const float vv = __shfl(val, j); rank += (vv > val || (vv == val && j < lane)) ? 1 : 0; }
    const bool selq = rank < TOPE;
    const float ssum = wave_sum(selq ? score : 0.f);
    if (selq) { ridx[m * TOPE + rank] = lane; rw[m * TOPE + rank] = score / ssum * ROUTED_SCALE; atomicAdd(&ecnt[lane], 1); }
  }
  xcd_barrier(bar);
  int* tst = (int*)(lds_raw + MISC_OFF + 256);
  {
    __syncthreads();
    if (tid == 0) { int aa = 0; for (int e = 0; e < NE; ++e) { tst[e] = aa; aa += (ecnt[e] + 255) >> 8; } tst[NE] = aa; tst[NE + 1] = aa + NR / 256; }
    __syncthreads();
    for (int i = bid * NTHR + tid; i < NR * TOPE; i += G * NTHR) {
      const int e = ridx[i], p = tst[e] * 256 + atomicAdd(&ecur[e], 1);
      tokmap[p] = i / TOPE; wslot[p] = rw[i];
    }
    for (int e = bid; e < NE; e += G) {
      const int lo = tst[e] * 256 + ecnt[e], hi = tst[e + 1] * 256;
      for (int p = lo + tid; p < hi; p += NTHR) { tokmap[p] = 0; wslot[p] = 0.f; }
    }
    const int sb = tst[NE] * 256;
    for (int i = bid * NTHR + tid; i < NR; i += G * NTHR) { tokmap[sb + i] = i; wslot[sb + i] = 1.0f; }
  }
  xcd_barrier(bar);
  {
    MoeSched S{tst, 2, G, bid, WguT, WGU_E, D, nullptr, tokmap};
    EpiGateUp E{hdn};
    gemm_phase_x<EpiGateUp, MoeSched, true>((PG8_LAS unsigned char*)lds_raw, h1b, (unsigned)(D * 2), D, S, E);
  }
  xcd_barrier(bar);
  {
    MoeSched S{tst, 4, G, bid, WdT, WD_E, DE, hdn, nullptr};
    EpiDown E{out, tokmap, wslot};
    gemm_phase_x<EpiDown, MoeSched, false>((PG8_LAS unsigned char*)lds_raw, nullptr, (unsigned)(DE * 2), DE, S, E);
  }
  xcd_barrier(bar);
  for (int m = gw; m < NR; m += NGW) {
    float v[16]; float s = 0.f;
#pragma unroll
    for (int i = 0; i < 16; ++i) { const int c = i * 64 + lane; v[i] = DN_ALPHA * bf2f(h1b[(size_t)m * D + c]) + out[(size_t)m * D + c]; s += v[i]; }
    const float mu = wave_sum(s) * (1.0f / D);
    float q = 0.f;
#pragma unroll
    for (int i = 0; i < 16; ++i) { const float d = v[i] - mu; q += d * d; }
    const float rstd = rsqrtf(wave_sum(q) * (1.0f / D) + LN_EPS);
#pragma unroll
    for (int i = 0; i < 16; ++i) { const int c = i * 64 + lane; out[(size_t)m * D + c] = (v[i] - mu) * rstd * a.ln2_g[c] + a.ln2_b[c]; }
  }
}

extern "C" void kernel_launch(void* const* d_in, const int* in_sizes, int n_in, void* d_out, int out_size, void* d_ws, size_t ws_size, hipStream_t stream) {
  static int grid = 0;
  if (grid == 0) {
    int dev = 0, cus = 0, per_cu = 0;
    if (hipGetDevice(&dev) != hipSuccess || hipDeviceGetAttribute(&cus, hipDeviceAttributeMultiprocessorCount, dev) != hipSuccess) { fprintf(stderr, "kernel_launch: device query failed\n"); grid = -1; return; }
    if (hipFuncSetAttribute((const void*)mega_fwd, hipFuncAttributeMaxDynamicSharedMemorySize, LDS_BYTES) != hipSuccess) { fprintf(stderr, "kernel_launch: hipFuncSetAttribute failed\n"); grid = -1; return; }
    if (hipOccupancyMaxActiveBlocksPerMultiprocessor(&per_cu, (const void*)mega_fwd, NTHR, LDS_BYTES) != hipSuccess || per_cu < 1) { fprintf(stderr, "kernel_launch: occupancy query says %d\n", per_cu); }
    (void)hipGetLastError();
    grid = cus;
  }
  if (grid < 0) return;
  (void)in_sizes; (void)n_in; (void)out_size; (void)ws_size;
  if (hipMemsetAsync(d_ws, 0, CTL_BYTES, stream) != hipSuccess) { fprintf(stderr, "kernel_launch: memset failed\n"); return; }
  Args a{};
  const float** pp = (const float**)&a;
  for (int i = 0; i < 24; ++i) pp[i] = (const float*)d_in[i];
  a.out = (float*)d_out; a.ws = (unsigned char*)d_ws;
  for (int i = 0; i < 8; ++i) a.ropeinv[i] = (float)pow(500000.0, -2.0 * i / 16.0);
  hipLaunchKernelGGL(mega_fwd, dim3(grid), dim3(NTHR), LDS_BYTES, stream, a);
  const hipError_t le = hipPeekAtLastError();
  if (le != hipSuccess) fprintf(stderr, "kernel_launch: launch failed: %s\n", hipGetErrorName(le));
}
```

```cpp
#include <hip/hip_runtime.h>
#include <hip/hip_bf16.h>
#include <cstdint>
#include <cstdio>
#include <cmath>

constexpr int D = 1024, NB = 2, SEQ = 8192, NMETA = 16, TP = SEQ + NMETA;
constexpr int NR = NB * SEQ;
constexpr int NROWS = NR + NB * NMETA;
constexpr int CONV_CH = 512, CONV_W = 31, NH = 8, HD = 64, IH = 8, IDD = 64, TOPK = 256;
constexpr int IN_W = 3144;
constexpr int OFF_A = 0, OFF_G = 512, OFF_Q = 1024, OFF_K = 1536, OFF_V = 2048, OFF_QI = 2560, OFF_KI = 3072, OFF_WI = 3136;
constexpr int NE = 64, TOPE = 8, DE = 256;
constexpr float LN_EPS = 1e-5f;
constexpr float DN_ALPHA = 1.189207115002721f;
constexpr float ROUTED_SCALE = 2.5f;

__device__ __forceinline__ int row_of(int b, int t) { return t < NMETA ? NR + b * NMETA + t : b * SEQ + (t - NMETA); }
__device__ __forceinline__ void row_bt(int m, int& b, int& t) { if (m < NR) { b = m >> 13; t = (m & (SEQ - 1)) + NMETA; } else { b = (m - NR) >> 4; t = (m - NR) & 15; } }

__device__ __forceinline__ float wave_sum(float v) {
#pragma unroll
  for (int o = 32; o > 0; o >>= 1) v += __shfl_xor(v, o);
  return v;
}
__device__ __forceinline__ float sigmoidf_(float x) { return 1.0f / (1.0f + expf(-x)); }

#define XB_TMO      128
#define XB_XCNT(j)  (256  + 64 * (j))
#define XB_XSUB(j)  (1280 + 64 * (j))
#define XB_XGEN(j)  (2304 + 64 * (j))
#define XB_TOP      3328
#define XB_TOPGEN   3392
#define XCD_BAR_WORDS 3456
#define XB_SPIN_CAP (1u << 18)
#ifndef LAS
#define LAS __attribute__((address_space(3)))
#endif

__device__ __forceinline__ unsigned xb_ld(unsigned* p)              { return __hip_atomic_load(p, __ATOMIC_RELAXED, __HIP_MEMORY_SCOPE_AGENT); }
__device__ __forceinline__ unsigned xb_add(unsigned* p, unsigned v) { return __hip_atomic_fetch_add(p, v, __ATOMIC_RELAXED, __HIP_MEMORY_SCOPE_AGENT); }
__device__ __forceinline__ unsigned xb_xcc_id() { return (unsigned)__builtin_amdgcn_s_getreg((3 << 11) | 20) & 0xFu; }
#define XB_SPIN(cond, bar) do { unsigned _sp = 0; while (cond) { __builtin_amdgcn_s_sleep(1); \
    if ((++_sp & 255u) == 0u) { if (xb_ld(&(bar)[XB_TMO])) break; if (_sp > XB_SPIN_CAP) { atomicAdd(&(bar)[XB_TMO], 1u); break; } } } } while (0)

struct XcdBarrier {
    unsigned* bar; unsigned x;
    volatile LAS unsigned* st;
};

__device__ __forceinline__ XcdBarrier xcd_barrier_post(unsigned* bar, volatile LAS unsigned* st) {
    XcdBarrier b; b.bar = bar; b.x = xb_xcc_id(); b.st = st;
    if (threadIdx.x == 0) (void)xb_add(&bar[XB_XCNT(b.x)], 1u);
    return b;
}
__device__ __forceinline__ void xcd_barrier_complete(unsigned* bar, unsigned x, unsigned& nloc, unsigned& nx) {
    const unsigned G = gridDim.x * gridDim.y * gridDim.z;
    unsigned sum, cnt, mine, sp = 0u;
    for (;;) {
        sum = 0u; cnt = 0u; mine = 0u;
#pragma unroll
        for (unsigned j = 0; j < 16; ++j) { const unsigned c = xb_ld(&bar[XB_XCNT(j)]); sum += c; cnt += (c > 0u) ? 1u : 0u; mine = (j == x) ? c : mine; }
        if (sum == G) break;
        __builtin_amdgcn_s_sleep(1);
        if ((++sp & 255u) == 0u) { if (xb_ld(&bar[XB_TMO])) break; if (sp > XB_SPIN_CAP) { atomicAdd(&bar[XB_TMO], 1u); break; } }
    }
    nloc = mine > 0u ? mine : 1u; nx = cnt > 0u ? cnt : 1u;
}

__device__ __forceinline__ void xcd_barrier(const XcdBarrier& b) {
    asm volatile("s_waitcnt vmcnt(0)" ::: "memory");
    __syncthreads();
    if (threadIdx.x == 0) {
        unsigned* bar = b.bar;
        __builtin_amdgcn_s_waitcnt(0);
        unsigned nloc = b.st[0], nx = b.st[1];
        if (nloc == 0u) { xcd_barrier_complete(bar, b.x, nloc, nx); b.st[0] = nloc; b.st[1] = nx; }
        const unsigned old = xb_add(&bar[XB_XSUB(b.x)], 1u);
        const unsigned gen = old / nloc;
        if (old + 1u == (gen + 1u) * nloc) {
            __builtin_amdgcn_fence(__ATOMIC_RELEASE, "agent");
            asm volatile("s_waitcnt vmcnt(0)" ::: "memory");
            const unsigned og = xb_add(&bar[XB_TOP], 1u);
            const unsigned tg = og / nx;
            if (og + 1u == (tg + 1u) * nx) xb_add(&bar[XB_TOPGEN], 1u);
            else XB_SPIN(xb_ld(&bar[XB_TOPGEN]) == tg, bar);
            __builtin_amdgcn_fence(__ATOMIC_ACQUIRE, "agent");
            xb_add(&bar[XB_XGEN(b.x)], 1u);
            asm volatile("s_waitcnt vmcnt(0)" ::: "memory");
        } else {
            XB_SPIN(xb_ld(&bar[XB_XGEN(b.x)]) == gen, bar);
            __builtin_amdgcn_fence(__ATOMIC_ACQUIRE, "agent");
            asm volatile("s_waitcnt vmcnt(0)" ::: "memory");
        }
    }
    __syncthreads();
}


typedef unsigned short bf16_t;
__device__ __forceinline__ unsigned f2bf(float f) { unsigned u = __float_as_uint(f); return (u + 0x7fffu + ((u >> 16) & 1u)) >> 16; }
__device__ __forceinline__ unsigned pk2(float lo, float hi) { return f2bf(lo) | (f2bf(hi) << 16); }
__device__ __forceinline__ float bf2f(bf16_t v) { return __uint_as_float((unsigned)v << 16); }

namespace pg8 {
#define PG8_LAS __attribute__((address_space(3)))
typedef unsigned short bf16_t;
typedef short bf16x8 __attribute__((ext_vector_type(8)));
typedef float f32x4 __attribute__((ext_vector_type(4)));
typedef unsigned u32x4 __attribute__((ext_vector_type(4)));
constexpr int BM = 256, BK = 64, HALF = 128, HTB = HALF * BK * 2  , STAGE_BYTES = 8 * HTB, NXCD = 8, WGM = 8;

__host__ __device__ __forceinline__ int lds_byte(int r, int c) { const int st = (r >> 4) * 2 + (c >> 5), rr = r & 15, cc = c & 31, ob = rr * 64 + cc * 2; return st * 1024 + (ob ^ (((ob >> 9) & 1) << 5)); }
__host__ __device__ __forceinline__ void stage_rc(int b, int& R, int& C) { const int st = b / 1024, sb = b % 1024, swz = sb ^ (((sb >> 9) & 1) << 5); R = (st >> 1) * 16 + swz / 64; C = (st & 1) * 32 + (swz % 64) / 2; }
__host__ __device__ __forceinline__ int perm32(int rho) { const int n = rho >> 4, i = rho & 15; return 8 * (i >> 2) + 4 * n + (i & 3); }

struct Unit { int pm, pn; };
struct Gemm { const bf16_t* A; const bf16_t* Bt; int M, N, K; };

struct StaticOrder {
    int nM, nN, nwg, G, c;
    __host__ __device__ void init(int M, int N, int G_, int c_) { nM = M / BM; nN = N / BM; nwg = nM * nN; G = G_; c = c_; }
    __host__ __device__ bool next(int i, Unit& u) const {
        const long L = (long)i * G + c; if (L >= nwg) return false;
        int wgid = (int)L; { const int q = nwg / NXCD, r = nwg % NXCD, xcd = wgid % NXCD, off = wgid / NXCD; wgid = (xcd < r ? xcd * (q + 1) : r * (q + 1) + (xcd - r) * q) + off; }
        const int nig = WGM * nN, gid = wgid / nig, fm = gid * WGM, gsz = (nM - fm) < WGM ? (nM - fm) : WGM;
        u.pm = fm + ((wgid % nig) % gsz); u.pn = (wgid % nig) / gsz; return true;
    }
    __device__ __forceinline__ void a_ready(const Unit&) const {}
    __device__ __forceinline__ void done(const Unit&) const {}
};

__device__ __forceinline__ unsigned cvt_pk_bf16(float lo, float hi) { unsigned r; asm volatile("v_cvt_pk_bf16_f32 %0, %1, %2" : "=v"(r) : "v"(lo), "v"(hi)); return r; }
typedef float f32x2 __attribute__((ext_vector_type(2)));
__device__ __forceinline__ f32x2 gelu_pk(f32x2 v) {
    const f32x2 av = __builtin_elementwise_abs(v), d = av * 0.2316418882f + 1.0f;
    f32x2 t; t.x = __builtin_amdgcn_rcpf(d.x); t.y = __builtin_amdgcn_rcpf(d.y);
    f32x2 q = t * 0.5307027145f + (-0.7265760135f); q = q * t + 0.7107068705f; q = q * t + (-0.142248368f); q = q * t + 0.127414796f; q = q * t;
    const f32x2 s = (v * v) * (-0.72134752044f);
    f32x2 e; e.x = __builtin_amdgcn_exp2f(s.x); e.y = __builtin_amdgcn_exp2f(s.y);
    const f32x2 m = v * (q * e), r = v - m;
    f32x2 o; o.x = v.x < 0.f ? m.x : r.x; o.y = v.y < 0.f ? m.y : r.y; return o;
}

template <int ACT  > struct EpiBf16 {
    static constexpr bool PERM = true, AFTER_DRAIN = false; static_assert(ACT == 0 || ACT == 1, "EpiBf16: ACT is 0 (none) or 1 (gelu_pk)");
    bf16_t* O; int ldc; const float* bias; int split_cols; size_t split_stride; float scale0;
    __device__ __forceinline__ void operator()(const f32x4 (&acc)[2][2][4][2], const Unit& u, int wr, int wc, int fr, int fq) const {
        const int row0 = u.pm * BM + wr * 64 + fr; int colt = u.pn * BM; bf16_t* base = O;
        float sc = 1.f; if (split_cols) { const int t = colt / split_cols; base += (size_t)t * split_stride; colt -= t * split_cols; if (t == 0) sc = scale0; }
        const int col0 = colt + wc * 32 + 8 * fq, bcol0 = u.pn * BM + wc * 32 + 8 * fq;
        f32x4 bv[2][2];
#pragma unroll
        for (int bj = 0; bj < 2; ++bj)
#pragma unroll
            for (int n = 0; n < 2; ++n) bv[bj][n] = bias ? *(const f32x4*)(bias + bcol0 + bj * HALF + 4 * n) : (f32x4){0.f, 0.f, 0.f, 0.f};
#pragma unroll
        for (int ai = 0; ai < 2; ++ai)
#pragma unroll
            for (int m = 0; m < 4; ++m) { bf16_t* rowp = base + (size_t)(row0 + ai * HALF + m * 16) * ldc + col0;
#pragma unroll
                for (int bj = 0; bj < 2; ++bj) { f32x4 v0 = acc[ai][bj][m][0] + bv[bj][0], v1 = acc[ai][bj][m][1] + bv[bj][1];
                    if (ACT == 1) { f32x2 a = gelu_pk((f32x2){v0[0], v0[1]}), b = gelu_pk((f32x2){v0[2], v0[3]}), c = gelu_pk((f32x2){v1[0], v1[1]}), d = gelu_pk((f32x2){v1[2], v1[3]});
                        v0 = (f32x4){a.x, a.y, b.x, b.y}; v1 = (f32x4){c.x, c.y, d.x, d.y}; }
                    v0 = v0 * sc; v1 = v1 * sc; u32x4 w; w.x = cvt_pk_bf16(v0[0], v0[1]); w.y = cvt_pk_bf16(v0[2], v0[3]); w.z = cvt_pk_bf16(v1[0], v1[1]); w.w = cvt_pk_bf16(v1[2], v1[3]);
                    *(u32x4*)(rowp + bj * HALF) = w; } }
    }
};

struct PanelStats {
    unsigned* xbuf;
    unsigned* cnt;
    unsigned* tmo;
    int ntn; float eps;
    unsigned code;
    __device__ __forceinline__ bool run(const f32x4 (&v)[2][2][4][2], const Unit& u, int wr, int wc, int fr, int fq, PG8_LAS unsigned char* lds, int wid, int lane) const {
        typedef float f32x2v __attribute__((ext_vector_type(2)));
        PG8_LAS f32x2v* P = (PG8_LAS f32x2v*)lds;
        PG8_LAS f32x2v* S = (PG8_LAS f32x2v*)(lds + 8192);
        PG8_LAS unsigned* flag = (PG8_LAS unsigned*)(lds + 8192 + 2048);
#pragma unroll
        for (int ai = 0; ai < 2; ++ai)
#pragma unroll
            for (int m = 0; m < 4; ++m) {
                float s = 0.f;
#pragma unroll
                for (int bj = 0; bj < 2; ++bj)
#pragma unroll
                    for (int n = 0; n < 2; ++n) { const f32x4 x = v[ai][bj][m][n]; s += (x[0] + x[1]) + (x[2] + x[3]); }
                s += __shfl_xor(s, 16); s += __shfl_xor(s, 32);
                const float mw = s * (1.0f / 64.0f); float q = 0.f;
#pragma unroll
                for (int bj = 0; bj < 2; ++bj)
#pragma unroll
                    for (int n = 0; n < 2; ++n) { const f32x4 d = v[ai][bj][m][n] - mw; q += (d[0] * d[0] + d[1] * d[1]) + (d[2] * d[2] + d[3] * d[3]); }
                q += __shfl_xor(q, 16); q += __shfl_xor(q, 32);
                if (fq == 0) P[(ai * HALF + wr * 64 + m * 16 + fr) * 4 + wc] = (f32x2v){mw, q};
            }
        asm volatile("s_waitcnt lgkmcnt(0)" ::: "memory"); __builtin_amdgcn_s_barrier(); asm volatile("" ::: "memory");
#if defined(BROKEN_EXCHANGE_NO_WAIT)
#warning BROKEN CONTROL BUILD: the row-statistics exchange does not wait; results are wrong by design
        if (blockIdx.x >= 64) { const long long t0_ = clock64(); while (clock64() - t0_ < 60000) __builtin_amdgcn_s_sleep(8); }
#endif
        const int row = wid * 32 + (lane & 31);
        if (lane < 32) {
            const f32x2v a = P[row * 4 + 0], b = P[row * 4 + 1], c = P[row * 4 + 2], d = P[row * 4 + 3];
            const float mt = (a.x + b.x + c.x + d.x) * 0.25f;
            const float da = a.x - mt, db = b.x - mt, dc = c.x - mt, dd = d.x - mt;
            const float m2 = (a.y + b.y) + (c.y + d.y) + 64.0f * ((da * da + db * db) + (dc * dc + dd * dd));
            unsigned long long* slot = (unsigned long long*)xbuf + ((size_t)(u.pm * BM + row) * 4 + u.pn);
            __hip_atomic_store(slot, ((unsigned long long)__float_as_uint(m2) << 32) | __float_as_uint(mt), __ATOMIC_RELAXED, __HIP_MEMORY_SCOPE_AGENT);
        }
        asm volatile("s_waitcnt vmcnt(0)" ::: "memory");
        if (lane == 0) __hip_atomic_fetch_add(cnt + 64 * u.pm, 1u, __ATOMIC_RELAXED, __HIP_MEMORY_SCOPE_AGENT);
        if (wid == 0) {
            bool dead = false; const unsigned long long t0 = __builtin_amdgcn_s_memrealtime(); const unsigned want = 8u * (unsigned)ntn;
            for (;;) {
#if defined(BROKEN_EXCHANGE_NO_WAIT)
                break;
#endif
                if ((unsigned)__builtin_amdgcn_readfirstlane(__hip_atomic_load(cnt + 64 * u.pm, __ATOMIC_RELAXED, __HIP_MEMORY_SCOPE_AGENT)) >= want) break;
                if (__builtin_amdgcn_s_memrealtime() - t0 > 2000000ull) {
                    if (lane == 0) { unsigned expect = 0u; __hip_atomic_compare_exchange_strong(tmo + 1, &expect, code | (unsigned)(u.pm & 0xff), __ATOMIC_RELAXED, __ATOMIC_RELAXED, __HIP_MEMORY_SCOPE_AGENT);
                                     __hip_atomic_store(tmo, 1u, __ATOMIC_RELAXED, __HIP_MEMORY_SCOPE_AGENT); }
                    dead = true; break; }
                __builtin_amdgcn_s_sleep(2);
            }
            __builtin_amdgcn_fence(__ATOMIC_ACQUIRE, "agent");
            if (lane == 0) flag[0] = dead ? 1u : 0u;
        }
        asm volatile("s_waitcnt vmcnt(0) lgkmcnt(0)" ::: "memory"); __builtin_amdgcn_s_barrier(); asm volatile("" ::: "memory");
        const bool bad = flag[0] != 0u;
        if (lane < 32) {
            const unsigned long long* slot = (const unsigned long long*)xbuf + (size_t)(u.pm * BM + row) * 4; float mt[4], m2[4]; float ms = 0.f;
#pragma unroll
            for (int t = 0; t < 4; ++t) { if (t < ntn) { const unsigned long long w = __hip_atomic_load(slot + t, __ATOMIC_RELAXED, __HIP_MEMORY_SCOPE_AGENT); mt[t] = __uint_as_float((unsigned)w); m2[t] = __uint_as_float((unsigned)(w >> 32)); } else { mt[t] = 0.f; m2[t] = 0.f; } ms += mt[t]; }
            const float mean = ms / (float)ntn; float q = 0.f;
#pragma unroll
            for (int t = 0; t < 4; ++t) if (t < ntn) { const float dm = mt[t] - mean; q += m2[t] + 256.0f * dm * dm; }
            S[row] = (f32x2v){mean, 1.0f / sqrtf(q / (256.0f * (float)ntn) + eps)};
        }
        asm volatile("s_waitcnt lgkmcnt(0)" ::: "memory"); __builtin_amdgcn_s_barrier(); asm volatile("" ::: "memory");
        return bad;
    }
};
struct EpiLnRes {
    static constexpr bool PERM = false, AFTER_DRAIN = true;
    const float* base; float* out; int ldc; const float* bias; PanelStats st; unsigned poison;
    __device__ __forceinline__ void fused(f32x4 (&acc)[2][2][4][2], const Unit& u, int wr, int wc, int fr, int fq, PG8_LAS unsigned char* lds, int wid, int lane) const {
        typedef float f32x2v __attribute__((ext_vector_type(2)));
        const PG8_LAS f32x2v* S = (const PG8_LAS f32x2v*)(lds + 8192);
        const int col0 = u.pn * BM + wc * 32 + 4 * fq;
#pragma unroll
        for (int bj = 0; bj < 2; ++bj)
#pragma unroll
            for (int n = 0; n < 2; ++n) { const f32x4 bv = bias ? *(const f32x4*)(bias + col0 + bj * HALF + n * 16) : (f32x4){0.f, 0.f, 0.f, 0.f};
#pragma unroll
                for (int ai = 0; ai < 2; ++ai)
#pragma unroll
                    for (int m = 0; m < 4; ++m) acc[ai][bj][m][n] += bv; }
        f32x4 pre[4][2][2];
#pragma unroll
        for (int m = 0; m < 4; ++m) { const size_t off = (size_t)(u.pm * BM + wr * 64 + m * 16 + fr) * ldc + col0;
#pragma unroll
            for (int bj = 0; bj < 2; ++bj)
#pragma unroll
                for (int n = 0; n < 2; ++n) pre[m][bj][n] = *(const f32x4*)(base + off + bj * HALF + n * 16); }
        const bool bad = st.run(acc, u, wr, wc, fr, fq, lds, wid, lane) || poison != 0u;
        const float qnan = __builtin_nanf("");
#pragma unroll
        for (int ai = 0; ai < 2; ++ai)
#pragma unroll
            for (int m = 0; m < 4; ++m) { const int r = ai * HALF + wr * 64 + m * 16 + fr; const f32x2v sr = S[r]; const size_t off = (size_t)(u.pm * BM + r) * ldc + col0;
#pragma unroll
                for (int bj = 0; bj < 2; ++bj)
#pragma unroll
                    for (int n = 0; n < 2; ++n) { const f32x4 bs = ai == 0 ? pre[m][bj][n] : *(const f32x4*)(base + off + bj * HALF + n * 16); f32x4 o = bs + (acc[ai][bj][m][n] - sr.x) * sr.y;
                        if (bad) o = (f32x4){qnan, qnan, qnan, qnan}; *(f32x4*)(out + off + bj * HALF + n * 16) = o; }
                if (m & 1) asm volatile("" ::: "memory"); }
    }
};
struct EpiLnResLn {
    static constexpr bool PERM = false, AFTER_DRAIN = true;
    const float* base; float* out; bf16_t* xn; int ldc; const float* bias; PanelStats st1, st2; unsigned poison;
    __device__ __forceinline__ void fused(f32x4 (&acc)[2][2][4][2], const Unit& u, int wr, int wc, int fr, int fq, PG8_LAS unsigned char* lds, int wid, int lane) const {
        typedef float f32x2v __attribute__((ext_vector_type(2))); typedef unsigned u32x2v __attribute__((ext_vector_type(2)));
        const PG8_LAS f32x2v* S = (const PG8_LAS f32x2v*)(lds + 8192);
        const int col0 = u.pn * BM + wc * 32 + 4 * fq;
#pragma unroll
        for (int bj = 0; bj < 2; ++bj)
#pragma unroll
            for (int n = 0; n < 2; ++n) { const f32x4 bv = bias ? *(const f32x4*)(bias + col0 + bj * HALF + n * 16) : (f32x4){0.f, 0.f, 0.f, 0.f};
#pragma unroll
                for (int ai = 0; ai < 2; ++ai)
#pragma unroll
                    for (int m = 0; m < 4; ++m) acc[ai][bj][m][n] += bv; }
        bool bad = st1.run(acc, u, wr, wc, fr, fq, lds, wid, lane) || poison != 0u;
        const float qnan = __builtin_nanf("");
#pragma unroll
        for (int ai = 0; ai < 2; ++ai)
#pragma unroll
            for (int m = 0; m < 4; ++m) { const int r = ai * HALF + wr * 64 + m * 16 + fr; const f32x2v sr = S[r]; const size_t off = (size_t)(u.pm * BM + r) * ldc + col0;
#pragma unroll
                for (int bj = 0; bj < 2; ++bj)
#pragma unroll
                    for (int n = 0; n < 2; ++n) { const f32x4 bs = *(const f32x4*)(base + off + bj * HALF + n * 16); acc[ai][bj][m][n] = bs + (acc[ai][bj][m][n] - sr.x) * sr.y; }
                asm volatile("" : "+v"(acc[ai][0][m][0]), "+v"(acc[ai][0][m][1]), "+v"(acc[ai][1][m][0]), "+v"(acc[ai][1][m][1]));
                if (m & 1) asm volatile("" ::: "memory"); }
        const bool bad1 = bad;
        bad = st2.run(acc, u, wr, wc, fr, fq, lds, wid, lane) || bad;
#pragma unroll
        for (int ai = 0; ai < 2; ++ai)
#pragma unroll
            for (int m = 0; m < 4; ++m) { const int r = ai * HALF + wr * 64 + m * 16 + fr; const f32x2v sr = S[r]; const size_t off = (size_t)(u.pm * BM + r) * ldc + col0;
#pragma unroll
                for (int bj = 0; bj < 2; ++bj)
#pragma unroll
                    for (int n = 0; n < 2; ++n) { const f32x4 x1 = acc[ai][bj][m][n]; *(f32x4*)(out + off + bj * HALF + n * 16) = bad1 ? (f32x4){qnan, qnan, qnan, qnan} : x1;
                        const f32x4 o = (x1 - sr.x) * sr.y; u32x2v w; w.x = cvt_pk_bf16(o[0], o[1]); w.y = cvt_pk_bf16(o[2], o[3]);
                        if (bad) { w.x = 0x7fc07fc0u; w.y = 0x7fc07fc0u; } *(u32x2v*)(xn + off + bj * HALF + n * 16) = w; }
                asm volatile("" ::: "memory"); }
    }
};

template <class Epi, class Sched, bool ALIGN_EPI = false, bool SP2 = false>
__device__ __forceinline__ void gemm_phase(PG8_LAS unsigned char* lds, const Gemm g, const Sched& S, const Epi& E) {
    int tid = threadIdx.x; asm volatile("" : "+v"(tid));
    const int wid = __builtin_amdgcn_readfirstlane(tid >> 6), lane = tid & 63, wr = wid >> 2, wc = wid & 3, fr = lane & 15, fq = lane >> 4;
    const int K = g.K, nt = K / BK;
    unsigned voffA[2], voffB[2];
#pragma unroll
    for (int i = 0; i < 2; ++i) { int R, C; stage_rc(tid * 16 + i * 8192, R, C); const int Rb = Epi::PERM ? ((R & ~31) + perm32(R & 31)) : R;
        voffA[i] = (unsigned)(R * K + C) * 2u; voffB[i] = (unsigned)(Rb * K + C) * 2u; }
    const size_t kstep = (size_t)(BK * 2);
    const size_t hstep = (size_t)HALF * K * 2;
    const size_t tstep = 2 * hstep;
    const unsigned ldsw = (unsigned)wid * 1024u;
    const int aoff = lds_byte(wr * 64 + fr, fq * 8), boff = lds_byte(wc * 32 + fr, fq * 8);
#define PG8_SA(b, h) (((b) * 2 + (h)) * HTB)
#define PG8_SB(b, h) ((4 + (b) * 2 + (h)) * HTB)
#define PG8_STAGE(bufoff, gbase, voff) do { _Pragma("unroll") for (int _i = 0; _i < 2; ++_i) \
        __builtin_amdgcn_global_load_lds((const unsigned*)((const char*)(gbase) + (voff)[_i]), (PG8_LAS unsigned*)(lds + (bufoff) + ldsw + _i * 8192), 16, 0, 0); } while (0)
#define PG8_LDA(dst, b, h) do { _Pragma("unroll") for (int m = 0; m < 4; ++m) _Pragma("unroll") for (int k = 0; k < 2; ++k) dst[m][k] = *(const PG8_LAS bf16x8*)(lds + PG8_SA(b, h) + aoff + m * 2048 + k * 1024); } while (0)
#define PG8_LDB(dst, b, h) do { _Pragma("unroll") for (int n = 0; n < 2; ++n) _Pragma("unroll") for (int k = 0; k < 2; ++k) dst[n][k] = *(const PG8_LAS bf16x8*)(lds + PG8_SB(b, h) + boff + n * 2048 + k * 1024); } while (0)
#define PG8_MMA(ai, bj, At, Bt) do { __builtin_amdgcn_s_setprio(1); _Pragma("unroll") for (int m = 0; m < 4; ++m) _Pragma("unroll") for (int n = 0; n < 2; ++n) _Pragma("unroll") for (int k = 0; k < 2; ++k) \
        acc[ai][bj][m][n] = __builtin_amdgcn_mfma_f32_16x16x32_bf16(Bt[n][k], At[m][k], acc[ai][bj][m][n], 0, 0, 0); __builtin_amdgcn_s_setprio(0); } while (0)
#define PG8_WAIT_V(n) asm volatile("s_waitcnt vmcnt(" #n ")" ::: "memory")
#define PG8_WAIT_L(n) asm volatile("s_waitcnt lgkmcnt(" #n ")" ::: "memory")
#define PG8_BAR __builtin_amdgcn_s_barrier()
#define PG8_SCHED __builtin_amdgcn_sched_barrier(0)
    Unit cur, nxt; int ui = 0;
    if (!S.next(0, cur)) return;
    f32x4 acc[2][2][4][2];
#pragma unroll
    for (int a = 0; a < 2; ++a)
#pragma unroll
        for (int b = 0; b < 2; ++b)
#pragma unroll
            for (int m = 0; m < 4; ++m)
#pragma unroll
                for (int n = 0; n < 2; ++n) acc[a][b][m][n] = (f32x4){0.f, 0.f, 0.f, 0.f};
    bf16x8 At[4][2], B0[2][2], B1[2][2];
    const char* cA = (const char*)g.A + (size_t)cur.pm * tstep; const char* cB = (const char*)g.Bt + (size_t)cur.pn * tstep;
    S.a_ready(cur);
    if constexpr (SP2) {
        PG8_STAGE(PG8_SB(0, 0), cB, voffB); PG8_STAGE(PG8_SB(0, 1), cB + hstep, voffB); PG8_STAGE(PG8_SA(0, 0), cA, voffA); PG8_STAGE(PG8_SA(0, 1), cA + hstep, voffA);
        if (wr == 1) PG8_BAR;
        PG8_WAIT_V(2); PG8_BAR;
        PG8_STAGE(PG8_SB(1, 0), cB + kstep, voffB); PG8_STAGE(PG8_SA(1, 0), cA + kstep, voffA); PG8_STAGE(PG8_SB(1, 1), cB + hstep + kstep, voffB);
        PG8_WAIT_V(6); PG8_BAR;
    } else {
        PG8_STAGE(PG8_SB(0, 0), cB, voffB); PG8_STAGE(PG8_SA(0, 0), cA, voffA); PG8_STAGE(PG8_SB(0, 1), cB + hstep, voffB); PG8_STAGE(PG8_SA(0, 1), cA + hstep, voffA);
        if (wr == 1) PG8_BAR;
        PG8_WAIT_V(4); PG8_BAR;
        PG8_STAGE(PG8_SB(1, 0), cB + kstep, voffB); PG8_STAGE(PG8_SA(1, 0), cA + kstep, voffA); PG8_STAGE(PG8_SB(1, 1), cB + hstep + kstep, voffB);
        PG8_WAIT_V(6); PG8_BAR;
    }
    for (;;) {
        const bool has_next = S.next(ui + 1, nxt);
        const char* nA = has_next ? (const char*)g.A + (size_t)nxt.pm * tstep : cA; const char* nB = has_next ? (const char*)g.Bt + (size_t)nxt.pn * tstep : cB;
        for (int t = 0; t < nt; t += 2) {
            const bool last = (t == nt - 2);
            const char* a1 = cA + (size_t)(t + 1) * kstep;
            const char* a2 = last ? nA : cA + (size_t)(t + 2) * kstep; const char* b2 = last ? nB : cB + (size_t)(t + 2) * kstep;
            const char* a3 = a2 + kstep; const char* b3 = b2 + kstep;
            if (last && has_next) S.a_ready(nxt);
            if constexpr (SP2) {
            PG8_LDB(B0, 0, 0); PG8_LDB(B1, 0, 1); PG8_SCHED; PG8_LDA(At, 0, 0); PG8_STAGE(PG8_SA(1, 1), a1 + hstep, voffA);
            PG8_WAIT_V(8); PG8_WAIT_L(0); PG8_BAR; PG8_MMA(0, 0, At, B0); PG8_MMA(0, 1, At, B1); PG8_BAR; PG8_SCHED;
            PG8_LDA(At, 0, 1); PG8_STAGE(PG8_SB(0, 0), b2, voffB); PG8_STAGE(PG8_SB(0, 1), b2 + hstep, voffB); PG8_STAGE(PG8_SA(0, 0), a2, voffA);
            PG8_WAIT_V(8); PG8_WAIT_L(0); PG8_BAR; PG8_MMA(1, 0, At, B0); PG8_MMA(1, 1, At, B1); PG8_BAR; PG8_SCHED;
            PG8_LDB(B0, 1, 0); PG8_LDB(B1, 1, 1); PG8_SCHED; PG8_LDA(At, 1, 0); PG8_STAGE(PG8_SA(0, 1), a2 + hstep, voffA);
            PG8_WAIT_V(8); PG8_WAIT_L(0); PG8_BAR; PG8_MMA(0, 0, At, B0); PG8_MMA(0, 1, At, B1); PG8_BAR; PG8_SCHED;
            PG8_LDA(At, 1, 1); PG8_STAGE(PG8_SB(1, 0), b3, voffB); PG8_STAGE(PG8_SB(1, 1), b3 + hstep, voffB); PG8_STAGE(PG8_SA(1, 0), a3, voffA);
            PG8_WAIT_V(8); PG8_WAIT_L(0); PG8_BAR; PG8_MMA(1, 0, At, B0); PG8_MMA(1, 1, At, B1); PG8_BAR; PG8_SCHED;
            } else {
            PG8_LDB(B0, 0, 0); PG8_SCHED; PG8_LDA(At, 0, 0); PG8_STAGE(PG8_SA(1, 1), a1 + hstep, voffA);
            PG8_WAIT_L(8); PG8_BAR; PG8_WAIT_L(0); PG8_MMA(0, 0, At, B0); PG8_BAR; PG8_SCHED;
            PG8_LDB(B1, 0, 1); PG8_STAGE(PG8_SB(0, 0), b2, voffB);
            PG8_BAR; PG8_WAIT_L(0); PG8_MMA(0, 1, At, B1); PG8_BAR;
            PG8_LDA(At, 0, 1); PG8_STAGE(PG8_SA(0, 0), a2, voffA);
            PG8_BAR; PG8_WAIT_L(0); PG8_MMA(1, 0, At, B0); PG8_BAR; PG8_SCHED;
            PG8_STAGE(PG8_SB(0, 1), b2 + hstep, voffB);
            PG8_WAIT_V(6); PG8_BAR; PG8_MMA(1, 1, At, B1); PG8_BAR;
            PG8_LDB(B0, 1, 0); PG8_SCHED; PG8_LDA(At, 1, 0); PG8_STAGE(PG8_SA(0, 1), a2 + hstep, voffA);
            PG8_WAIT_L(8); PG8_BAR; PG8_WAIT_L(0); PG8_MMA(0, 0, At, B0); PG8_BAR; PG8_SCHED;
            PG8_LDB(B1, 1, 1); PG8_STAGE(PG8_SB(1, 0), b3, voffB);
            PG8_BAR; PG8_WAIT_L(0); PG8_MMA(0, 1, At, B1); PG8_BAR;
            PG8_LDA(At, 1, 1); PG8_STAGE(PG8_SA(1, 0), a3, voffA);
            PG8_BAR; PG8_WAIT_L(0); PG8_MMA(1, 0, At, B0); PG8_BAR; PG8_SCHED;
            PG8_STAGE(PG8_SB(1, 1), b3 + hstep, voffB);
            PG8_WAIT_V(6); PG8_BAR; PG8_MMA(1, 1, At, B1); PG8_BAR;
            }
        }
        if constexpr (ALIGN_EPI) { if (wr == 0) PG8_BAR; }
        if constexpr (!Epi::AFTER_DRAIN) { E(acc, cur, wr, wc, fr, fq); S.done(cur); }
        if (!has_next) break;
#pragma unroll
        for (int a = 0; a < 2; ++a)
#pragma unroll
            for (int b = 0; b < 2; ++b)
#pragma unroll
                for (int m = 0; m < 4; ++m)
#pragma unroll
                    for (int n = 0; n < 2; ++n) acc[a][b][m][n] = (f32x4){0.f, 0.f, 0.f, 0.f};
        cur = nxt; cA = nA; cB = nB; ++ui;
        if constexpr (ALIGN_EPI) { if (wr == 1) PG8_BAR; }
    }
    PG8_WAIT_V(0);
    if constexpr (!ALIGN_EPI) { if (wr == 0) PG8_BAR; }
    PG8_BAR;
    if constexpr (Epi::AFTER_DRAIN) { E.fused(acc, cur, wr, wc, fr, fq, lds, wid, lane); S.done(cur); }
#undef PG8_SA
#undef PG8_SB
#undef PG8_STAGE
#undef PG8_LDA
#undef PG8_LDB
#undef PG8_MMA
#undef PG8_WAIT_V
#undef PG8_WAIT_L
#undef PG8_BAR
#undef PG8_SCHED
}
}
namespace attn_body {
using bf16=__hip_bfloat16;
using bf16x8=__attribute__((ext_vector_type(8)))short;
using s16x4=__attribute__((ext_vector_type(4)))short;
using f32x16=__attribute__((ext_vector_type(16)))float;
using u32x4=__attribute__((ext_vector_type(4)))unsigned;
constexpr int BATCH=2,NHEAD=8,SEQ=8192,D=64,DM=NHEAD*D,DMO=1024,KVROWS=8320,KVOFF=112,MASKPW=264;
constexpr int NW=8,QBLK=32,QB=QBLK*NW,KVBLK=64,NQB=SEQ/QB;
constexpr int ATTN_UNIT_ROWS=QB;
__device__ __forceinline__ int crow(int r,int hi){return (r&3)+8*(r>>2)+4*hi;}
#define SBAR() __builtin_amdgcn_sched_barrier(0)
__device__ __forceinline__ void cmask(f32x16&p0,f32x16&p1,int jb,int qrel,int hi){
  const float NEG=-INFINITY; int kb=64*jb+4*hi;
  #pragma unroll
  for(int r=0;r<16;++r){int kv=kb+(r&3)+8*(r>>2); if(kv>qrel)p0[r]=NEG; if(kv+32>qrel)p1[r]=NEG;}
}

constexpr int NSLOT=3, SLOTB=8192;
constexpr int LDS_K=0, LDS_V=NSLOT*SLOTB, LDS_WS=2*NSLOT*SLOTB, LDS_OST=LDS_WS+NW*64*4, LDS_BYTES=LDS_OST+NW*4096;
constexpr float C2=0.125f*1.4426950408889634f;
__device__ __forceinline__ void glds16(const void*gsrc,unsigned lds_dst){unsigned keep;
  asm volatile("s_mov_b32 %0, m0\n\ts_mov_b32 m0, %2\n\ts_nop 0\n\tglobal_load_lds_dwordx4 %1, off\n\ts_mov_b32 m0, %0":"=&s"(keep):"v"(gsrc),"s"(lds_dst):"memory");}
__device__ __forceinline__ float max3f(float a,float b,float c){float r;asm("v_max3_f32 %0, %1, %2, %3":"=v"(r):"v"(a),"v"(b),"v"(c));return r;}
__device__ __forceinline__ float max2f(float a,float b){float r;asm("v_max_f32_e32 %0, %1, %2":"=v"(r):"v"(a),"v"(b));return r;}
__device__ __forceinline__ float fadd_s(float a,float b){float r;asm("v_add_f32_e32 %0, %1, %2":"=v"(r):"v"(a),"v"(b));return r;}
__device__ __forceinline__ float fsub_s(float a,float b){float r;asm("v_sub_f32_e32 %0, %1, %2":"=v"(r):"v"(a),"v"(b));return r;}
typedef float f32x2_t __attribute__((ext_vector_type(2))); typedef __bf16 bf16x2_t __attribute__((ext_vector_type(2)));
__device__ __forceinline__ unsigned cvtpk_s(float lo,float hi){f32x2_t v={lo,hi};bf16x2_t b=__builtin_convertvector(v,bf16x2_t);return __builtin_bit_cast(unsigned,b);}
#define WAIT_BAR(N) asm volatile("s_waitcnt vmcnt(" #N ") lgkmcnt(0)\n\ts_barrier":"+v"(mwn)::"memory")

__device__ __forceinline__ void qkt(f32x16&p0,f32x16&p1,const char*Kslot,const bf16x8*qr,const f32x16&negm,int r32,int hi){
  const char*kb=Kslot+hi*1024+r32*16;
  #pragma unroll
  for(int d0=0;d0<4;++d0){
    const bf16x8 b0=*reinterpret_cast<const bf16x8*>(kb+d0*2048);
    const bf16x8 b1=*reinterpret_cast<const bf16x8*>(kb+d0*2048+512);
    if(d0==0){p0=__builtin_amdgcn_mfma_f32_32x32x16_bf16(b0,qr[0],negm,0,0,0);p1=__builtin_amdgcn_mfma_f32_32x32x16_bf16(b1,qr[0],negm,0,0,0);}
    else{p0=__builtin_amdgcn_mfma_f32_32x32x16_bf16(b0,qr[d0],p0,0,0,0);p1=__builtin_amdgcn_mfma_f32_32x32x16_bf16(b1,qr[d0],p1,0,0,0);}}
}
typedef __attribute__((address_space(3))) const char* lds_cptr;
typedef short v4i16_t __attribute__((ext_vector_type(4)));
__device__ __forceinline__ void kload8(bf16x8*kf,lds_cptr kp){
  kf[0]=*(const __attribute__((address_space(3))) bf16x8*)(kp);      kf[1]=*(const __attribute__((address_space(3))) bf16x8*)(kp+512);
  kf[2]=*(const __attribute__((address_space(3))) bf16x8*)(kp+2048); kf[3]=*(const __attribute__((address_space(3))) bf16x8*)(kp+2560);
  kf[4]=*(const __attribute__((address_space(3))) bf16x8*)(kp+4096); kf[5]=*(const __attribute__((address_space(3))) bf16x8*)(kp+4608);
  kf[6]=*(const __attribute__((address_space(3))) bf16x8*)(kp+6144); kf[7]=*(const __attribute__((address_space(3))) bf16x8*)(kp+6656);
}
__device__ __forceinline__ void kload2(bf16x8*kf,lds_cptr kp,int j){ kf[2*j]=*(const __attribute__((address_space(3))) bf16x8*)(kp+j*2048); kf[2*j+1]=*(const __attribute__((address_space(3))) bf16x8*)(kp+j*2048+512); }
__device__ __forceinline__ s16x4 vtr(lds_cptr p){ return __builtin_bit_cast(s16x4,__builtin_amdgcn_ds_read_tr16_b64_v4i16((__attribute__((address_space(3))) v4i16_t*)p)); }
__device__ __forceinline__ float rowmax(const f32x16&p0,const f32x16&p1){
  float a=max3f(p0[0],p0[1],p1[0]),b=max3f(p0[2],p0[3],p1[1]);a=max3f(a,p1[2],p1[3]);
  #pragma unroll
  for(int r=4;r<16;r+=4){a=max3f(a,p0[r],p0[r+1]);b=max3f(b,p0[r+2],p0[r+3]);a=max3f(a,p1[r],p1[r+1]);b=max3f(b,p1[r+2],p1[r+3]);}
  const float m=max2f(a,b);
  auto rr=__builtin_amdgcn_permlane32_swap(__float_as_uint(m),__float_as_uint(m),false,false);
  return max2f(__uint_as_float(rr[0]),__uint_as_float(rr[1]));
}
__device__ __forceinline__ void pv(f32x16*o,int vb,bf16x8 pa0,bf16x8 pa1,bf16x8 pa2,bf16x8 pa3){
  #pragma unroll
  for(int d0=0;d0<2;++d0){s16x4 lo[4],hi[4];
    #pragma unroll
    for(int ks=0;ks<4;++ks){
      asm volatile("ds_read_b64_tr_b16 %0,%1 offset:%c2":"=&v"(lo[ks]):"v"(vb),"i"(d0*4096+ks*1024):"memory");
      asm volatile("ds_read_b64_tr_b16 %0,%1 offset:%c2":"=&v"(hi[ks]):"v"(vb),"i"(d0*4096+ks*1024+512):"memory");}
    asm volatile("s_waitcnt lgkmcnt(0)":::"memory");SBAR();
    #define PK(k) (bf16x8){lo[k][0],lo[k][1],lo[k][2],lo[k][3],hi[k][0],hi[k][1],hi[k][2],hi[k][3]}
    o[d0]=__builtin_amdgcn_mfma_f32_32x32x16_bf16(pa0,PK(0),o[d0],0,0,0);
    o[d0]=__builtin_amdgcn_mfma_f32_32x32x16_bf16(pa1,PK(1),o[d0],0,0,0);
    o[d0]=__builtin_amdgcn_mfma_f32_32x32x16_bf16(pa2,PK(2),o[d0],0,0,0);
    o[d0]=__builtin_amdgcn_mfma_f32_32x32x16_bf16(pa3,PK(3),o[d0],0,0,0);
    #undef PK
  }
}

#ifndef ATTN_STORE16
#define ATTN_STORE16(p,v) (*(u32x4*)(p)=(v))
#endif
template<int THRL> __device__ __forceinline__ void attn_unit(int b,int h,int qb,const bf16*Q,const bf16*__restrict__ K,const bf16*__restrict__ V,bf16*O,const unsigned*__restrict__ MK,char*shm){
  const int tid=threadIdx.x,lane=tid&63,r32=lane&31,hi=lane>>5; const int wid=__builtin_amdgcn_readfirstlane(tid>>6);
  const long rowbase=(long)b*SEQ, kvbase=(long)b*KVROWS; const int q0=qb*QB;
  const bf16*Qw=Q+(rowbase+q0+wid*QBLK)*DM+h*D;
  const bf16*Kh=K+kvbase*DM+h*D,*Vh=V+kvbase*DM+h*D;
  const unsigned lds0=(unsigned)(uintptr_t)shm;
  float*wsf=(float*)(shm+LDS_WS)+wid*64;
  const bf16*ksrc=Kh+(long)lane*DM+wid*8;
  const bf16*vsrc=Vh+(long)(16*(wid&3)+(lane>>2))*DM+(wid>>2)*32+(lane&3)*8;
  const unsigned kdst=lds0+LDS_K+wid*1024, vdst=lds0+LDS_V+wid*1024;
  #define DMA_K(t,slot) glds16(ksrc+(long)(t)*KVBLK*DM,(unsigned)__builtin_amdgcn_readfirstlane(kdst+(slot)))
  #define DMA_V(t,slot) glds16(vsrc+(long)(t)*KVBLK*DM,(unsigned)__builtin_amdgcn_readfirstlane(vdst+(slot)))
  const int vb0=(int)(lds0+LDS_V)+((lane>>4)&1)*32+(lane&3)*8+(4*hi+((lane&15)>>2))*64;
  const char*Kbase=shm+LDS_K; bf16x8 kf[8];
  const lds_cptr shm3=(lds_cptr)shm; const lds_cptr kp0=shm3+LDS_K+hi*1024+r32*16; const lds_cptr vp0=shm3+LDS_V+((lane>>4)&1)*32+(lane&3)*8+(4*hi+((lane&15)>>2))*64;
  const int NT=(q0+QB+128)/KVBLK;
  const unsigned moff=(unsigned)(((rowbase+q0+wid*QBLK+r32)*(long)MASKPW)*4);
  typedef unsigned u32x2_t __attribute__((ext_vector_type(2)));
  u32x2_t mwn,mwc;
  #define MLOAD(t) asm volatile("global_load_dwordx2 %0, %1, %2":"=v"(mwn):"v"(moff+8u*(unsigned)(t)),"s"(MK):"memory")
  #define MROT() do{ mwc.x=mwn.x>>(4*hi); mwc.y=mwn.y>>(4*hi); }while(0)
  MLOAD(0);
  DMA_K(0,0);DMA_V(0,0);DMA_K(1,SLOTB);
  bf16x8 qr[4];
  #pragma unroll
  for(int d0=0;d0<4;++d0)qr[d0]=*reinterpret_cast<const bf16x8*>(&Qw[(long)r32*DM+d0*16+hi*8]);
  float mhat=0.f,l_reg=0.f;f32x16 o[2];o[0]=f32x16{};o[1]=f32x16{};f32x16 negm=f32x16{};asm volatile("":"+v"(negm));
  const int qrel=wid*QBLK+r32;
  #define CMASK(P0,P1,t) do{}while(0)
  bool resc=false;
  #define START(P0,P1) do{ const float rm=rowmax(P0,P1); resc=false; \
    { const float dl=rm; mhat=fadd_s(mhat,dl); \
      _Pragma("unroll") for(int r=0;r<16;++r){P0[r]=fsub_s(P0[r],dl);P1[r]=fsub_s(P1[r],dl);} \
      _Pragma("unroll") for(int r=0;r<16;++r)negm[r]=-mhat; asm volatile("":"+v"(negm)); } \
    _Pragma("unroll") for(int r=0;r<16;++r)P0[r]=__builtin_amdgcn_exp2f(P0[r]); }while(0)
  #define RESC() do{ if(resc){ asm volatile("s_waitcnt lgkmcnt(0)":::"memory"); \
      _Pragma("unroll") for(int d_=0;d_<2;++d_) _Pragma("unroll") for(int r=0;r<16;++r)o[d_][r]*=wsf[crow(r,hi)]; } }while(0)
  f32x16 pA0,pA1,pB0,pB1;
  int sl_prev=0,sl_cur=0,sl_next=SLOTB;
  #define ROT() do{sl_prev=sl_cur;sl_cur=sl_next;sl_next=(sl_next==(NSLOT-1)*SLOTB)?0:sl_next+SLOTB;}while(0)
  DMA_K(2,2*SLOTB);
  WAIT_BAR(3); MROT();
  qkt(pA0,pA1,Kbase,qr,negm,r32,hi);asm volatile("s_nop 15\n\ts_nop 7":"+v"(pA0),"+v"(pA1));CMASK(pA0,pA1,0);
  START(pA0,pA1);
  _Pragma("unroll") for(int r=0;r<16;++r)pA1[r]=__builtin_amdgcn_exp2f(pA1[r]);
  WAIT_BAR(0);
  DMA_K(3,0);DMA_V(1,SLOTB);
  ROT();
  kload8(kf,kp0+sl_cur);
  WAIT_BAR(2);
  s16x4 vlo[8],vhi[8]; u32x4 pw0,pw1,pw2,pw3;
  #define PKW(P,B) cvtpk_s(P[B],P[B+1])
  #define PAF(k) __builtin_bit_cast(bf16x8,pw##k)
  #define VFR(i) (bf16x8){vlo[i][0],vlo[i][1],vlo[i][2],vlo[i][3],vhi[i][0],vhi[i][1],vhi[i][2],vhi[i][3]}
  #define PIN(x) asm volatile("":"+v"(x))
  #define MX3(a,b,c) __builtin_fmaxf(__builtin_fmaxf((a),(b)),(c))
  #define MK(P,W,r) P[r]=__uint_as_float(__float_as_uint(P[r])&(unsigned)__builtin_amdgcn_sbfe((int)(W),((r)&3)+8*((r)>>2),1))
  #define GAPA(MF,M0,M1,M2,M3,A0,A1,A2,A3,W0,W1,PW) do{ MF; M0; M1; M2; M3; sacc+=A0; sacc+=A1; sacc+=A2; sacc+=A3; PIN(sacc); W0; W1; PIN(PW); SBAR(); }while(0)
  #define EX(v) __builtin_amdgcn_exp2f(v)
  #define GAPB(MF,X,B) do{ MF; X[B]=EX(X[B]); X[B+1]=EX(X[B+1]); X[B+2]=EX(X[B+2]); X[B+3]=EX(X[B+3]); PIN(X); SBAR(); }while(0)
  #define VRD(i) do{ vlo[i]=vtr(vp_+(((i)>>2)*4096+((i)&3)*1024)); vhi[i]=vtr(vp_+(((i)>>2)*4096+((i)&3)*1024+512)); }while(0)
  #define KRD(G,j) do{ if(G){ kload2(kf,kp0+sl_next,j); SBAR(); } }while(0)
  #define STEP(C0,C1,P0,P1,t,GK,GV,GL) do{ SBAR(); \
    MLOAD(t); \
    const lds_cptr vp_=vp0+sl_prev; \
    VRD(0); SBAR(); MK(P0,mwc.x,0); MK(P0,mwc.x,1); float sacc=(P0[0]+P0[1]); \
    GAPA(C0=__builtin_amdgcn_mfma_f32_32x32x16_bf16(kf[0],qr[0],negm,0,0,0), MK(P0,mwc.x,2),MK(P0,mwc.x,3),MK(P0,mwc.x,4),MK(P0,mwc.x,5),     P0[2],P0[3],P0[4],P0[5],     pw0[0]=PKW(P0,0), pw0[1]=PKW(P0,2), pw0); \
    VRD(4); SBAR(); GAPA(C1=__builtin_amdgcn_mfma_f32_32x32x16_bf16(kf[1],qr[0],negm,0,0,0), MK(P0,mwc.x,6),MK(P0,mwc.x,7),MK(P0,mwc.x,8),MK(P0,mwc.x,9),     P0[6],P0[7],P0[8],P0[9],     pw0[2]=PKW(P0,4), pw0[3]=PKW(P0,6), pw0); \
    VRD(1); SBAR(); GAPA(C0=__builtin_amdgcn_mfma_f32_32x32x16_bf16(kf[2],qr[1],C0,0,0,0),   MK(P0,mwc.x,10),MK(P0,mwc.x,11),MK(P0,mwc.x,12),MK(P0,mwc.x,13), P0[10],P0[11],P0[12],P0[13], pw1[0]=PKW(P0,8), pw1[1]=PKW(P0,10), pw1); \
    VRD(5); SBAR(); GAPA(C1=__builtin_amdgcn_mfma_f32_32x32x16_bf16(kf[3],qr[1],C1,0,0,0),   MK(P0,mwc.x,14),MK(P0,mwc.x,15),MK(P1,mwc.y,0),MK(P1,mwc.y,1),   P0[14],P0[15],P1[0],P1[1],   pw1[2]=PKW(P0,12),pw1[3]=PKW(P0,14), pw1); \
    VRD(2); SBAR(); GAPA(C0=__builtin_amdgcn_mfma_f32_32x32x16_bf16(kf[4],qr[2],C0,0,0,0),   MK(P1,mwc.y,2),MK(P1,mwc.y,3),MK(P1,mwc.y,4),MK(P1,mwc.y,5),     P1[2],P1[3],P1[4],P1[5],     pw2[0]=PKW(P1,0), pw2[1]=PKW(P1,2), pw2); \
    VRD(6); SBAR(); GAPA(C1=__builtin_amdgcn_mfma_f32_32x32x16_bf16(kf[5],qr[2],C1,0,0,0),   MK(P1,mwc.y,6),MK(P1,mwc.y,7),MK(P1,mwc.y,8),MK(P1,mwc.y,9),     P1[6],P1[7],P1[8],P1[9],     pw2[2]=PKW(P1,4), pw2[3]=PKW(P1,6), pw2); \
    VRD(3); SBAR(); GAPA(C0=__builtin_amdgcn_mfma_f32_32x32x16_bf16(kf[6],qr[3],C0,0,0,0),   MK(P1,mwc.y,10),MK(P1,mwc.y,11),MK(P1,mwc.y,12),MK(P1,mwc.y,13), P1[10],P1[11],P1[12],P1[13], pw3[0]=PKW(P1,8), pw3[1]=PKW(P1,10), pw3); \
    VRD(7); SBAR(); GAPA(C1=__builtin_amdgcn_mfma_f32_32x32x16_bf16(kf[7],qr[3],C1,0,0,0),   MK(P1,mwc.y,14),MK(P1,mwc.y,15),(void)0,(void)0,                P1[14],P1[15],0.f,0.f,       pw3[2]=PKW(P1,12),pw3[3]=PKW(P1,14), pw3); \
    l_reg+=sacc; \
    if(GK){DMA_K((t)+3,sl_cur);} if(GV){DMA_V((t)+1,sl_next);} \
    CMASK(C0,C1,t); \
    { float a=MX3(C0[0],C0[1],C1[0]),b=MX3(C0[2],C0[3],C1[1]); a=MX3(a,C1[2],C1[3]); \
      _Pragma("unroll") for(int r=4;r<16;r+=4){a=MX3(a,C0[r],C0[r+1]);b=MX3(b,C0[r+2],C0[r+3]);a=MX3(a,C1[r],C1[r+1]);b=MX3(b,C1[r+2],C1[r+3]);} \
      float rm=__builtin_fmaxf(a,b); { auto rr=__builtin_amdgcn_permlane32_swap(__float_as_uint(rm),__float_as_uint(rm),false,false); rm=__builtin_fmaxf(__uint_as_float(rr[0]),__uint_as_float(rr[1])); } \
      resc=false; \
      if(__builtin_expect(__any(rm>(float)THRL),0)){ const float dl=__builtin_fmaxf(rm,0.f); mhat+=dl; \
        _Pragma("unroll") for(int r=0;r<16;++r){C0[r]-=dl;C1[r]-=dl;} \
        _Pragma("unroll") for(int r=0;r<16;++r)negm[r]=-mhat; asm volatile("":"+v"(negm)); \
        const float f=__builtin_amdgcn_exp2f(-dl); l_reg*=f; if(hi==0)wsf[r32]=f; resc=true; } } \
    SBAR(); \
    GAPB(o[0]=__builtin_amdgcn_mfma_f32_32x32x16_bf16(PAF(0),VFR(0),o[0],0,0,0), C0,0); \
    GAPB(o[1]=__builtin_amdgcn_mfma_f32_32x32x16_bf16(PAF(0),VFR(4),o[1],0,0,0), C0,4); \
    KRD(GL,0); GAPB(o[0]=__builtin_amdgcn_mfma_f32_32x32x16_bf16(PAF(1),VFR(1),o[0],0,0,0), C0,8); \
    KRD(GL,1); GAPB(o[1]=__builtin_amdgcn_mfma_f32_32x32x16_bf16(PAF(1),VFR(5),o[1],0,0,0), C0,12); \
    KRD(GL,2); GAPB(o[0]=__builtin_amdgcn_mfma_f32_32x32x16_bf16(PAF(2),VFR(2),o[0],0,0,0), C1,0); \
    KRD(GL,3); GAPB(o[1]=__builtin_amdgcn_mfma_f32_32x32x16_bf16(PAF(2),VFR(6),o[1],0,0,0), C1,4); \
    GAPB(o[0]=__builtin_amdgcn_mfma_f32_32x32x16_bf16(PAF(3),VFR(3),o[0],0,0,0), C1,8); \
    GAPB(o[1]=__builtin_amdgcn_mfma_f32_32x32x16_bf16(PAF(3),VFR(7),o[1],0,0,0), C1,12); \
    }while(0)
  int t=1;
  #undef CMASK
  #define CMASK(P0,P1,t) do{}while(0)
  for(;t+5<NT;t+=2){
    STEP(pB0,pB1,pA0,pA1,t,true,true,true);     WAIT_BAR(2); MROT(); RESC(); ROT();
    STEP(pA0,pA1,pB0,pB1,t+1,true,true,true);   WAIT_BAR(2); MROT(); RESC(); ROT();
  }
  #undef CMASK
  #define CMASK(P0,P1,t) do{}while(0)
  #define ENDW(tt) do{ if((tt)+3<NT){WAIT_BAR(2);} else if((tt)+2<NT){WAIT_BAR(1);} else {WAIT_BAR(0);} }while(0)
  for(;t+1<NT;t+=2){
    STEP(pB0,pB1,pA0,pA1,t,(t+3<NT),(t+1<NT),(t+1<NT));       ENDW(t);   MROT(); RESC(); ROT();
    STEP(pA0,pA1,pB0,pB1,t+1,(t+4<NT),(t+2<NT),(t+2<NT));     ENDW(t+1); MROT(); RESC(); ROT();
  }
  STEP(pB0,pB1,pA0,pA1,NT-1,false,false,false); RESC();
  asm volatile("s_waitcnt vmcnt(0)":"+v"(mwn)::"memory"); MROT();
  { _Pragma("unroll") for(int r=0;r<16;++r){ MK(pB0,mwc.x,r); MK(pB1,mwc.y,r); } }
  { float sacc=pB0[0]+pB0[1]; _Pragma("unroll") for(int r=2;r<16;++r)sacc+=pB0[r]; _Pragma("unroll") for(int r=0;r<16;++r)sacc+=pB1[r]; l_reg+=sacc;
    pw0=(u32x4){PKW(pB0,0),PKW(pB0,2),PKW(pB0,4),PKW(pB0,6)};pw1=(u32x4){PKW(pB0,8),PKW(pB0,10),PKW(pB0,12),PKW(pB0,14)};pw2=(u32x4){PKW(pB1,0),PKW(pB1,2),PKW(pB1,4),PKW(pB1,6)};pw3=(u32x4){PKW(pB1,8),PKW(pB1,10),PKW(pB1,12),PKW(pB1,14)};
    SBAR(); pv(o,vb0+sl_cur,PAF(0),PAF(1),PAF(2),PAF(3)); }
  #undef PKW
  #undef PAF
  #undef VFR
  #undef PIN
  #undef MX3
  #undef GAPA
  #undef MK
  #undef GAPB
  #undef EX
  #undef VRD
  #undef KRD
  #undef STEP
  #undef ENDW
  {auto rr=__builtin_amdgcn_permlane32_swap(__float_as_uint(l_reg),__float_as_uint(l_reg),false,false);l_reg=__uint_as_float(rr[0])+__uint_as_float(rr[1]);}
  if(hi==0)wsf[32+r32]=l_reg;asm volatile("s_waitcnt lgkmcnt(0)":::"memory");
  float rli[16];
  #pragma unroll
  for(int r=0;r<16;++r)rli[r]=__builtin_amdgcn_rcpf(wsf[32+crow(r,hi)]);
  bf16*Ow=O+(rowbase+q0+wid*QBLK)*DMO+h*D;
  { bf16*stg=(bf16*)(shm+LDS_OST)+wid*2048;
    #pragma unroll
    for(int r=0;r<16;++r){const int orow=crow(r,hi);
      #pragma unroll
      for(int d0=0;d0<2;++d0)stg[orow*64+d0*32+r32]=__float2bfloat16(o[d0][r]*rli[r]);}
    asm volatile("s_waitcnt lgkmcnt(0)":::"memory");
    #pragma unroll
    for(int i=0;i<4;++i){const int row=i*8+(lane>>3),ch=lane&7; const u32x4 v=*(const u32x4*)(stg+row*64+ch*8); ATTN_STORE16(Ow+(long)row*DMO+ch*8,v);} }
  asm volatile("s_waitcnt lgkmcnt(0)\n\ts_barrier":::"memory");
  #undef MLOAD
  #undef MROT
  #undef DMA_K
  #undef DMA_V
  #undef CMASK
  #undef START
  #undef RESC
  #undef ROT
}
constexpr int ATTN_LDS_BYTES=LDS_BYTES;
struct AttnTensors { const bf16* Q; const bf16* K; const bf16* V; bf16* O; const unsigned* MK; };
struct AttnUnit { int bh; int qb; };
struct StaticOrder {
  int vcu, grid;
  __device__ __forceinline__ explicit StaticOrder(int grid_,int block):vcu((grid_%8==0)?(block%8)*(grid_/8)+block/8:block),grid(grid_){}
  __device__ __forceinline__ bool next(int i,AttnUnit&u)const{ const int L=i*grid+vcu; if(L>=512)return false; const int pr=L>>1;
    if(grid==256){ if(i>=2)return false; const int s=vcu&15; u.bh=vcu>>4; u.qb=(i==0)?s:31-s; return true; }
    u.bh=L>>5; u.qb=L&31; (void)pr; return true; }
  __device__ __forceinline__ void a_ready(const AttnUnit&)const{}
  __device__ __forceinline__ void done(const AttnUnit&)const{}
};
template<class Sched,int THRL=8> __device__ __forceinline__ void attn_phase(char*lds,const AttnTensors&T,const Sched&S){
  AttnUnit u;
  for(int i=0;S.next(i,u);++i){ S.a_ready(u); attn_unit<THRL>(u.bh/NHEAD,u.bh%NHEAD,u.qb,T.Q,T.K,T.V,T.O,T.MK,lds); S.done(u); }
}
#undef SBAR
#undef WAIT_BAR
}

typedef _Float16 f16;
__device__ __forceinline__ unsigned short f2h(float f) { const f16 h = (f16)f; return __builtin_bit_cast(unsigned short, h); }
__device__ __forceinline__ float h2f(unsigned short u) { return (float)__builtin_bit_cast(f16, u); }
__device__ __forceinline__ float bflo(unsigned p) { return __uint_as_float(p << 16); }
__device__ __forceinline__ float bfhi(unsigned p) { return __uint_as_float(p & 0xffff0000u); }
constexpr float C2 = 0.125f * 1.4426950408889634f;
constexpr int KIW = 72;
constexpr int KVROWS = 8320, KVOFF = 112;

struct EpiF32 {
  static constexpr bool PERM = false, AFTER_DRAIN = false;
  float* C; int ldc, Mreal, Nreal;
  __device__ __forceinline__ void operator()(const pg8::f32x4 (&acc)[2][2][4][2], const pg8::Unit& u, int wr, int wc, int fr, int fq) const {
#pragma unroll
    for (int ai = 0; ai < 2; ++ai)
#pragma unroll
      for (int m = 0; m < 4; ++m) {
        const int r = u.pm * 256 + ai * 128 + wr * 64 + m * 16 + fr;
        if (r >= Mreal) continue;
#pragma unroll
        for (int bj = 0; bj < 2; ++bj)
#pragma unroll
          for (int n = 0; n < 2; ++n) {
            const int c = u.pn * 256 + bj * 128 + wc * 32 + n * 16 + 4 * fq;
            if (c < Nreal) *(pg8::f32x4*)(C + (size_t)r * ldc + c) = acc[ai][bj][m][n];
          }
      }
  }
};

struct EpiInProj {
  static constexpr bool PERM = false, AFTER_DRAIN = false;
  bf16_t* ub; bf16_t* qkvq; size_t kstride; float* kiw; const float* ropetab;
  __device__ __forceinline__ void operator()(const pg8::f32x4 (&acc)[2][2][4][2], const pg8::Unit& u, int wr, int wc, int fr, int fq) const {
    const int pn = u.pn;
#pragma unroll
    for (int ai = 0; ai < 2; ++ai)
#pragma unroll
      for (int m = 0; m < 4; ++m) {
        const int r = u.pm * 256 + ai * 128 + wr * 64 + m * 16 + fr;
        const bool rok = r < NROWS;
        int t = r < NR ? (r & (SEQ - 1)) + NMETA : ((r - NR) & 15);
        if (!rok) t = 0;
        if (pn < 4) {
#pragma unroll
          for (int n = 0; n < 2; ++n) {
            const pg8::f32x4 av = acc[ai][0][m][n], gv = acc[ai][1][m][n];
            float o[4];
#pragma unroll
            for (int j = 0; j < 4; ++j) o[j] = av[j] / (1.0f + __expf(-gv[j]));
            const int col = pn * 128 + wc * 32 + n * 16 + 4 * fq;
            if (rok) *(uint2*)(ub + (size_t)r * 512 + col) = make_uint2(pk2(o[0], o[1]), pk2(o[2], o[3]));
          }
        } else if (pn < 12) {
          const int kind = (pn - 4) >> 1, cbase = ((pn - 4) & 1) * 256;
#pragma unroll
          for (int bj = 0; bj < 2; ++bj)
#pragma unroll
            for (int n = 0; n < 2; ++n) {
              pg8::f32x4 v = acc[ai][bj][m][n];
              if (n == 0 && kind != 2 && (wc & 1) == 0) {
                const pg8::f32x4 cs = *(const pg8::f32x4*)(ropetab + t * 16 + 4 * (fq & 1)), sn = *(const pg8::f32x4*)(ropetab + t * 16 + 8 + 4 * (fq & 1));
#pragma unroll
                for (int j = 0; j < 4; ++j) { const float p = __shfl_xor(v[j], 32); v[j] = fq < 2 ? v[j] * cs[j] - p * sn[j] : v[j] * cs[j] + p * sn[j]; }
              }
              const int col = cbase + bj * 128 + wc * 32 + n * 16 + 4 * fq;
              const int bb = r < NR ? (r >> 13) : ((r - NR) >> 4);
              const size_t drow = (kind == 1 || kind == 2) ? (size_t)bb * KVROWS + KVOFF + t : (size_t)r;
              bf16_t* dst = qkvq + (size_t)kind * kstride + drow * 512 + col;
              if (kind == 3) {
                if (rok) *(uint2*)dst = make_uint2((unsigned)f2h(v[0]) | ((unsigned)f2h(v[1]) << 16), (unsigned)f2h(v[2]) | ((unsigned)f2h(v[3]) << 16));
              } else {
                if (kind == 0) v = v * C2;
                if (rok) *(uint2*)dst = make_uint2(pk2(v[0], v[1]), pk2(v[2], v[3]));
              }
            }
        } else {
#pragma unroll
          for (int n = 0; n < 2; ++n) {
            const int col = wc * 32 + n * 16 + 4 * fq;
            if (rok && col < KIW) *(pg8::f32x4*)(kiw + (size_t)r * KIW + col) = acc[ai][0][m][n];
          }
        }
      }
  }
};

__device__ __forceinline__ void transpose_item(const float* __restrict__ W, int K, int N, bf16_t* __restrict__ WT, int ldt, float* scr, int k0, int n0, int drow0, int lane) {
#pragma unroll 8
  for (int i = 0; i < 32; ++i) { const int kk = 2 * i + (lane >> 5), n = n0 + (lane & 31); scr[kk * 33 + (lane & 31)] = n < N ? W[(size_t)(k0 + kk) * N + n] : 0.f; }
  asm volatile("s_waitcnt lgkmcnt(0)" ::: "memory");
  const int c = lane & 7;
#pragma unroll
  for (int j = 0; j < 4; ++j) { const int n = (lane >> 3) + 8 * j; const float* p = scr + (8 * c) * 33 + n;
    uint4 o; o.x = pk2(p[0 * 33], p[1 * 33]); o.y = pk2(p[2 * 33], p[3 * 33]); o.z = pk2(p[4 * 33], p[5 * 33]); o.w = pk2(p[6 * 33], p[7 * 33]);
    *(uint4*)(WT + (size_t)(drow0 + n) * ldt + k0 + 8 * c) = o; }
  asm volatile("s_waitcnt lgkmcnt(0)" ::: "memory");
}
__device__ __forceinline__ int winT_row(int c) {
  if (c < 512) return (c >> 7) * 256 + (c & 127);
  if (c < 1024) return ((c - 512) >> 7) * 256 + 128 + ((c - 512) & 127);
  return c;
}

struct XUnit { int pm, pn, e; };
template <class Epi, class Sched, bool GATHER>
__device__ __forceinline__ void gemm_phase_x(PG8_LAS unsigned char* lds, const bf16_t* Abase, unsigned apitch, int K, const Sched& S, const Epi& E) {
  using namespace pg8;
  int tid = threadIdx.x; asm volatile("" : "+v"(tid));
  const int wid = __builtin_amdgcn_readfirstlane(tid >> 6), lane = tid & 63, wr = wid >> 2, wc = wid & 3, fr = lane & 15, fq = lane >> 4;
  const int nt = K / BK;
  unsigned voffB[2], vAc[2][2], vAn[2][2]; int Rl[2]; unsigned cOff[2];
#pragma unroll
  for (int i = 0; i < 2; ++i) { int R, C; stage_rc(tid * 16 + i * 8192, R, C); Rl[i] = R; cOff[i] = (unsigned)C * 2u; voffB[i] = (unsigned)(R * K + C) * 2u; }
  const size_t kstep = (size_t)(BK * 2), hstepB = (size_t)HALF * K * 2;
  const unsigned ldsw = (unsigned)wid * 1024u;
  const int aoff = lds_byte(wr * 64 + fr, fq * 8), boff = lds_byte(wc * 32 + fr, fq * 8);
#define X_SA(b, h) (((b) * 2 + (h)) * HTB)
#define X_SB(b, h) ((4 + (b) * 2 + (h)) * HTB)
#define X_STAGE(bufoff, gbase, voff) do { _Pragma("unroll") for (int _i = 0; _i < 2; ++_i) \
        __builtin_amdgcn_global_load_lds((const unsigned*)((const char*)(gbase) + (voff)[_i]), (PG8_LAS unsigned*)(lds + (bufoff) + ldsw + _i * 8192), 16, 0, 0); } while (0)
#define X_LDA(dst, b, h) do { _Pragma("unroll") for (int m = 0; m < 4; ++m) _Pragma("unroll") for (int k = 0; k < 2; ++k) dst[m][k] = *(const PG8_LAS bf16x8*)(lds + X_SA(b, h) + aoff + m * 2048 + k * 1024); } while (0)
#define X_LDB(dst, b, h) do { _Pragma("unroll") for (int n = 0; n < 2; ++n) _Pragma("unroll") for (int k = 0; k < 2; ++k) dst[n][k] = *(const PG8_LAS bf16x8*)(lds + X_SB(b, h) + boff + n * 2048 + k * 1024); } while (0)
#define X_MMA(ai, bj, At, Bt) do { __builtin_amdgcn_s_setprio(1); _Pragma("unroll") for (int m = 0; m < 4; ++m) _Pragma("unroll") for (int n = 0; n < 2; ++n) _Pragma("unroll") for (int k = 0; k < 2; ++k) \
        acc[ai][bj][m][n] = __builtin_amdgcn_mfma_f32_16x16x32_bf16(Bt[n][k], At[m][k], acc[ai][bj][m][n], 0, 0, 0); __builtin_amdgcn_s_setprio(0); } while (0)
#define X_WAIT_V(n) asm volatile("s_waitcnt vmcnt(" #n ")" ::: "memory")
#define X_WAIT_L(n) asm volatile("s_waitcnt lgkmcnt(" #n ")" ::: "memory")
#define X_BAR __builtin_amdgcn_s_barrier()
#define X_SCHED __builtin_amdgcn_sched_barrier(0)
#define X_SETV(dst, u) do { if constexpr (GATHER) { const int* rw_ = S.rows(u); _Pragma("unroll") for (int h = 0; h < 2; ++h) _Pragma("unroll") for (int i = 0; i < 2; ++i) dst[h][i] = (unsigned)rw_[h * HALF + Rl[i]] * apitch + cOff[i]; } \
        else { _Pragma("unroll") for (int h = 0; h < 2; ++h) _Pragma("unroll") for (int i = 0; i < 2; ++i) dst[h][i] = (unsigned)(h * HALF + Rl[i]) * apitch + cOff[i]; } } while (0)
  XUnit cur, nxt; int ui = 0;
  if (!S.next(0, cur)) return;
  f32x4 acc[2][2][4][2];
#pragma unroll
  for (int a = 0; a < 2; ++a)
#pragma unroll
    for (int b = 0; b < 2; ++b)
#pragma unroll
      for (int m = 0; m < 4; ++m)
#pragma unroll
        for (int n = 0; n < 2; ++n) acc[a][b][m][n] = (f32x4){0.f, 0.f, 0.f, 0.f};
  bf16x8 At[4][2], B0[2][2], B1[2][2];
  const char* cA = GATHER ? (const char*)Abase : (const char*)S.a_ptr(cur); const char* cB = (const char*)S.b_ptr(cur);
  X_SETV(vAc, cur);
  X_STAGE(X_SB(0, 0), cB, voffB); X_STAGE(X_SB(0, 1), cB + hstepB, voffB); X_STAGE(X_SA(0, 0), cA, vAc[0]); X_STAGE(X_SA(0, 1), cA, vAc[1]);
  if (wr == 1) X_BAR;
  X_WAIT_V(2); X_BAR;
  X_STAGE(X_SB(1, 0), cB + kstep, voffB); X_STAGE(X_SA(1, 0), cA + kstep, vAc[0]); X_STAGE(X_SB(1, 1), cB + hstepB + kstep, voffB);
  X_WAIT_V(6); X_BAR;
  for (;;) {
    const bool has_next = S.next(ui + 1, nxt);
    const char* nA = has_next ? (GATHER ? (const char*)Abase : (const char*)S.a_ptr(nxt)) : cA; const char* nB = has_next ? (const char*)S.b_ptr(nxt) : cB;
    if (has_next) { X_SETV(vAn, nxt); } else {
#pragma unroll
      for (int h = 0; h < 2; ++h)
#pragma unroll
        for (int i = 0; i < 2; ++i) vAn[h][i] = vAc[h][i]; }
    for (int t = 0; t < nt; t += 2) {
      const bool last = (t == nt - 2);
      const char* a1 = cA + (size_t)(t + 1) * kstep;
      const char* a2 = last ? nA : cA + (size_t)(t + 2) * kstep; const char* b2 = last ? nB : cB + (size_t)(t + 2) * kstep;
      const char* a3 = a2 + kstep; const char* b3 = b2 + kstep;
      unsigned v0[2], v1[2];
#pragma unroll
      for (int i = 0; i < 2; ++i) { v0[i] = last ? vAn[0][i] : vAc[0][i]; v1[i] = last ? vAn[1][i] : vAc[1][i]; }
      X_LDB(B0, 0, 0); X_LDB(B1, 0, 1); X_SCHED; X_LDA(At, 0, 0); X_STAGE(X_SA(1, 1), a1, vAc[1]);
      X_WAIT_V(8); X_WAIT_L(0); X_BAR; X_MMA(0, 0, At, B0); X_MMA(0, 1, At, B1); X_BAR; X_SCHED;
      X_LDA(At, 0, 1); X_STAGE(X_SB(0, 0), b2, voffB); X_STAGE(X_SB(0, 1), b2 + hstepB, voffB); X_STAGE(X_SA(0, 0), a2, v0);
      X_WAIT_V(8); X_WAIT_L(0); X_BAR; X_MMA(1, 0, At, B0); X_MMA(1, 1, At, B1); X_BAR; X_SCHED;
      X_LDB(B0, 1, 0); X_LDB(B1, 1, 1); X_SCHED; X_LDA(At, 1, 0); X_STAGE(X_SA(0, 1), a2, v1);
      X_WAIT_V(8); X_WAIT_L(0); X_BAR; X_MMA(0, 0, At, B0); X_MMA(0, 1, At, B1); X_BAR; X_SCHED;
      X_LDA(At, 1, 1); X_STAGE(X_SB(1, 0), b3, voffB); X_STAGE(X_SB(1, 1), b3 + hstepB, voffB); X_STAGE(X_SA(1, 0), a3, v0);
      X_WAIT_V(8); X_WAIT_L(0); X_BAR; X_MMA(1, 0, At, B0); X_MMA(1, 1, At, B1); X_BAR; X_SCHED;
    }
    if (wr == 0) X_BAR;
    E(acc, cur, wr, wc, fr, fq);
    if (!has_next) break;
#pragma unroll
    for (int a = 0; a < 2; ++a)
#pragma unroll
      for (int b = 0; b < 2; ++b)
#pragma unroll
        for (int m = 0; m < 4; ++m)
#pragma unroll
          for (int n = 0; n < 2; ++n) acc[a][b][m][n] = (f32x4){0.f, 0.f, 0.f, 0.f};
    cur = nxt; cA = nA; cB = nB; ++ui;
#pragma unroll
    for (int h = 0; h < 2; ++h)
#pragma unroll
      for (int i = 0; i < 2; ++i) vAc[h][i] = vAn[h][i];
    if (wr == 1) X_BAR;
  }
  X_WAIT_V(0);
  X_BAR;
#undef X_SA
#undef X_SB
#undef X_STAGE
#undef X_LDA
#undef X_LDB
#undef X_MMA
#undef X_WAIT_V
#undef X_WAIT_L
#undef X_BAR
#undef X_SCHED
#undef X_SETV
}

constexpr int MOE_MAXT = 131072 / 256 + 64;
struct MoeSched {
  const int* tstart;
  int NN, G, c;
  const bf16_t* Bw; size_t bstride_e; int K;
  const bf16_t* Aw;
  const int* tokmap;
  __device__ __forceinline__ bool next(int i, XUnit& u) const {
    const int L = i * G + c, total = tstart[65] * NN; if (L >= total) return false;
    int e = 0;
#pragma unroll 1
    while (tstart[e + 1] * NN <= L) ++e;
    const int ne = tstart[e + 1] - tstart[e], r = L - tstart[e] * NN;
    u.e = e; u.pn = r / ne; u.pm = tstart[e] + r % ne; return true;
  }
  __device__ __forceinline__ const bf16_t* b_ptr(const XUnit& u) const { return Bw + (size_t)u.e * bstride_e + (size_t)u.pn * 256 * K; }
  __device__ __forceinline__ const bf16_t* a_ptr(const XUnit& u) const { return Aw + (size_t)u.pm * 256 * K; }
  __device__ __forceinline__ const int* rows(const XUnit& u) const { return tokmap + u.pm * 256; }
};
struct EpiGateUp {
  bf16_t* hdn;
  __device__ __forceinline__ void operator()(const pg8::f32x4 (&acc)[2][2][4][2], const XUnit& u, int wr, int wc, int fr, int fq) const {
#pragma unroll
    for (int ai = 0; ai < 2; ++ai)
#pragma unroll
      for (int m = 0; m < 4; ++m) {
        const size_t slot = (size_t)u.pm * 256 + ai * 128 + wr * 64 + m * 16 + fr;
#pragma unroll
        for (int n = 0; n < 2; ++n) {
          const pg8::f32x4 g = acc[ai][0][m][n], up = acc[ai][1][m][n]; float o[4];
#pragma unroll
          for (int j = 0; j < 4; ++j) o[j] = g[j] / (1.0f + __expf(-g[j])) * up[j];
          *(uint2*)(hdn + slot * DE + u.pn * 128 + wc * 32 + n * 16 + 4 * fq) = make_uint2(pk2(o[0], o[1]), pk2(o[2], o[3]));
        }
      }
  }
};
struct EpiDown {
  float* out; const int* tokmap; const float* wslot;
  __device__ __forceinline__ void operator()(const pg8::f32x4 (&acc)[2][2][4][2], const XUnit& u, int wr, int wc, int fr, int fq) const {
#pragma unroll
    for (int ai = 0; ai < 2; ++ai)
#pragma unroll
      for (int m = 0; m < 4; ++m) {
        const int slot = u.pm * 256 + ai * 128 + wr * 64 + m * 16 + fr;
        const float w = wslot[slot];
        if (w != 0.f) {
          float* orow = out + (size_t)tokmap[slot] * D + u.pn * 256 + wc * 32 + 4 * fq;
#pragma unroll
          for (int bj = 0; bj < 2; ++bj)
#pragma unroll
            for (int n = 0; n < 2; ++n)
#pragma unroll
              for (int j = 0; j < 4; ++j) atomicAdd(orow + bj * 128 + n * 16 + j, acc[ai][bj][m][n][j] * w);
        }
      }
  }
};

typedef _Float16 f16x8 __attribute__((ext_vector_type(8)));
typedef unsigned short u16x2 __attribute__((ext_vector_type(2)));
constexpr int MPW = 264;
__device__ __forceinline__ void pk_cnt_gt(unsigned& acc, unsigned x, unsigned tm1, unsigned ones) {
  unsigned d;
  asm("v_pk_sub_u16 %0, %2, %3 clamp\n\tv_pk_min_u16 %0, %0, %4\n\tv_pk_add_u16 %1, %1, %0" : "=&v"(d), "+v"(acc) : "v"(x), "v"(tm1), "s"(ones));
}

constexpr int NTHR = 512, NWAVES = 8;
constexpr int LDS_BYTES = 147456;
constexpr int MISC_OFF = 131072 + 8192;
constexpr size_t CTL_BYTES = 65536;

struct Args {
  const float *x, *meta, *ln_emb_g, *ln_emb_b, *w_in, *conv_w, *conv_b, *lnc_g, *lnc_b, *lnk_g, *lnk_b, *w_out, *ln1_g, *ln1_b, *w_router, *r_bias,
              *w_gate, *w_up, *w_down, *ws_gate, *ws_up, *ws_down, *ln2_g, *ln2_b;
  float* out; unsigned char* ws;
  float ropeinv[8];
};

constexpr size_t wl_al(size_t x) { return (x + 255) & ~(size_t)255; }
struct WL {
  static constexpr int NSLOT = (MOE_MAXT + 64) * 256;
  static constexpr size_t WGU_E = (size_t)512 * D, WD_E = (size_t)D * DE;
  static constexpr size_t KSTRIDE = (size_t)16640 * 512;
  static constexpr size_t o_ropetab = 65536;
  static constexpr size_t o_st0 = o_ropetab + wl_al((size_t)TP * 16 * 4);
  static constexpr size_t o_maskb = o_st0 + wl_al((size_t)NROWS * 8);
  static constexpr size_t o_ridx = o_maskb + wl_al((size_t)NR * MPW * 4);
  static constexpr size_t o_rw = o_ridx + wl_al((size_t)NR * TOPE * 4);
  static constexpr size_t o_tokmap = o_rw + wl_al((size_t)NR * TOPE * 4);
  static constexpr size_t o_wslot = o_tokmap + wl_al((size_t)NSLOT * 4);
  static constexpr size_t o_WinT = o_wslot + wl_al((size_t)NSLOT * 4);
  static constexpr size_t o_WoutT = o_WinT + wl_al((size_t)3328 * D * 2);
  static constexpr size_t o_regionE = o_WoutT + wl_al((size_t)D * D * 2);
  static constexpr size_t o_kiF = o_regionE + wl_al((size_t)(NE + 1) * (WGU_E + WD_E) * 2);
  static constexpr size_t o_qlin = o_kiF + wl_al((size_t)NROWS * 64 * 2);
  static constexpr size_t o_wq = o_qlin + wl_al((size_t)NR * 64 * 2);
  static constexpr size_t o_h1b = o_wq + wl_al((size_t)NR * 8 * 4);
  static constexpr size_t o_ub = o_h1b + wl_al((size_t)NR * D * 2);
  static constexpr size_t o_qb = o_ub + wl_al((size_t)NROWS * 512 * 2);
  static constexpr size_t o_kiw = o_qb + wl_al(KSTRIDE * 2 * 4);
  static constexpr size_t o_end = o_kiw + wl_al((size_t)NROWS * KIW * 4);
};
static_assert(WL::o_end <= (size_t)289000000, "workspace budget");
static_assert((size_t)WL::NSLOT * 256 * 2 <= WL::o_end - WL::o_ub && (size_t)NR * D * 4 <= WL::o_end - WL::o_ub, "overlays fit");
__device__ __forceinline__ unsigned fkey(float f) { unsigned u = __float_as_uint(f); return (u & 0x80000000u) ? ~u : (u | 0x80000000u); }

__global__ void __launch_bounds__(NTHR, 2) mega_fwd(Args a) {
  extern __shared__ __attribute__((aligned(16))) unsigned char lds_raw[];
  float* lds = (float*)lds_raw;
  const int G = gridDim.x, bid = blockIdx.x, NGW = G * NWAVES;
#define tst ((int*)(lds_raw + MISC_OFF + 256))
#define PHASE_IDS int tid = threadIdx.x; asm volatile("" : "+v"(tid)); const int lane = tid & 63, wave = tid >> 6, gw = bid * NWAVES + wave; (void)lane; (void)wave; (void)gw;
#define WSP(T, O) ((T*)(a.ws + (O)))
#define barw    WSP(unsigned, 0)
#define ecnt    WSP(int, 16384)
#define ecur    WSP(int, 16384 + 256)
#define ropetab WSP(float, WL::o_ropetab)
#define st0     WSP(float2, WL::o_st0)
#define maskb   WSP(unsigned, WL::o_maskb)
#define ridx    WSP(int, WL::o_ridx)
#define rw      WSP(float, WL::o_rw)
#define tokmap  WSP(int, WL::o_tokmap)
#define wslot   WSP(float, WL::o_wslot)
#define WinT    WSP(bf16_t, WL::o_WinT)
#define WoutT   WSP(bf16_t, WL::o_WoutT)
#define h0b     WSP(bf16_t, WL::o_regionE)
#define mixb    WSP(bf16_t, WL::o_regionE)
#define WguT    WSP(bf16_t, WL::o_regionE)
#define WdT     WSP(bf16_t, WL::o_regionE + (size_t)(NE + 1) * WL::WGU_E * 2)
#define kiF     WSP(unsigned short, WL::o_kiF)
#define qlin    WSP(unsigned short, WL::o_qlin)
#define wq      WSP(float, WL::o_wq)
#define h1b     WSP(bf16_t, WL::o_h1b)
#define ub      WSP(bf16_t, WL::o_ub)
#define qb      WSP(bf16_t, WL::o_qb)
#define kb      WSP(bf16_t, WL::o_qb + WL::KSTRIDE * 2)
#define vb      WSP(bf16_t, WL::o_qb + WL::KSTRIDE * 4)
#define qih     WSP(unsigned short, WL::o_qb + WL::KSTRIDE * 6)
#define kiw     WSP(float, WL::o_kiw)
#define tmp     WSP(float, WL::o_ub)
#define hdn     WSP(bf16_t, WL::o_ub)
  constexpr size_t WGU_E = WL::WGU_E, WD_E = WL::WD_E, KSTRIDE = WL::KSTRIDE;
  float* const out = a.out;

  volatile LAS unsigned* misc = (volatile LAS unsigned*)((LAS unsigned char*)lds_raw + MISC_OFF);
  if (threadIdx.x < 16) misc[threadIdx.x] = 0u;
  __syncthreads();
  XcdBarrier bar = xcd_barrier_post(barw, misc);

  { PHASE_IDS
  {
    float4* o4 = (float4*)out;
    for (size_t i = (size_t)bid * NTHR + tid; i < (size_t)NR * D / 4; i += (size_t)G * NTHR) o4[i] = make_float4(0.f, 0.f, 0.f, 0.f);
    for (int i = bid * NTHR + tid; i < TP * 8; i += G * NTHR) {
      const int t = i >> 3, j = i & 7; float sn, cs; sincosf((float)t * a.ropeinv[j], &sn, &cs);
      ropetab[t * 16 + j] = cs; ropetab[t * 16 + 8 + j] = sn;
    }
    for (int i = bid * NTHR + tid; i < 2 * 2 * KVOFF * 64; i += G * NTHR) {
      const int c16 = i & 63, rr = (i >> 6) % KVOFF, bb = ((i >> 6) / KVOFF) & 1, kv = (i >> 6) / (2 * KVOFF);
      *(uint4*)((kv ? vb : kb) + ((size_t)bb * KVROWS + rr) * 512 + c16 * 8) = make_uint4(0u, 0u, 0u, 0u);
    }
    for (int m = gw; m < NROWS; m += NGW) {
      const float* src = m < NR ? a.x + (size_t)m * D : a.meta + (size_t)((m - NR) & 15) * D;
      float v[16]; float s = 0.f;
#pragma unroll
      for (int i = 0; i < 16; ++i) { v[i] = src[i * 64 + lane]; s += v[i]; }
      const float mu = wave_sum(s) * (1.0f / D);
      float q = 0.f;
#pragma unroll
      for (int i = 0; i < 16; ++i) { const float d = v[i] - mu; q += d * d; }
      const float rstd = rsqrtf(wave_sum(q) * (1.0f / D) + LN_EPS);
#pragma unroll
      for (int i = 0; i < 16; ++i) { const int c = i * 64 + lane; h0b[(size_t)m * D + c] = (bf16_t)f2bf((v[i] - mu) * rstd * a.ln_emb_g[c] + a.ln_emb_b[c]); }
      if (lane == 0) st0[m] = make_float2(mu, rstd);
    }
    {
      float* scr = lds + wave * 2304;
      constexpr int NB_IN = (IN_W + 31) / 32, I_IN = (D / 64) * NB_IN, I_OUT = (D / 64) * (D / 32);
      for (int it = gw; it < I_IN + I_OUT; it += NGW) {
        if (it < I_IN) { const int kb_ = it / NB_IN, nb = it % NB_IN; transpose_item(a.w_in, D, IN_W, WinT, D, scr, 64 * kb_, 32 * nb, winT_row(32 * nb), lane); }
        else { const int r = it - I_IN, kb_ = r / (D / 32), nb = r % (D / 32); transpose_item(a.w_out, D, D, WoutT, D, scr, 64 * kb_, 32 * nb, 32 * nb, lane); }
      }
    }
  }
  }
  xcd_barrier(bar);
  { PHASE_IDS
  {
    pg8::Gemm g{h0b, WinT, 16640, 3328, D}; pg8::StaticOrder S; S.init(16640, 3328, G, bid);
    EpiInProj E{ub, qb, KSTRIDE, kiw, ropetab};
    pg8::gemm_phase<EpiInProj, pg8::StaticOrder, true, true>((PG8_LAS unsigned char*)lds_raw, g, S, E);
  }
  }
  xcd_barrier(bar);
  { PHASE_IDS
  for (int m = gw; m < NROWS; m += NGW) {
    const int t = m < NR ? (m & (SEQ - 1)) + NMETA : ((m - NR) & 15);
    const float xk = kiw[(size_t)m * KIW + lane];
    const float mu = wave_sum(xk) * (1.0f / IDD), dv = xk - mu;
    const float rstd = rsqrtf(wave_sum(dv * dv) * (1.0f / IDD) + LN_EPS);
    float y = dv * rstd * a.lnk_g[lane] + a.lnk_b[lane];
    const float p = __shfl_xor(y, 8);
    if (lane < 16) { const float cs = ropetab[t * 16 + (lane & 7)], sn = ropetab[t * 16 + 8 + (lane & 7)]; y = lane < 8 ? y * cs - p * sn : y * cs + p * sn; }
    kiF[(size_t)m * 64 + lane] = f2h(y);
    if (m < NR) {
      float wl = 0.f;
      if (lane < 8) { wl = kiw[(size_t)m * KIW + 64 + lane] * (0.35355339059327373f * 0.125f * 0.5f); wq[(size_t)m * 8 + lane] = wl; }
      float ql = 0.f;
#pragma unroll
      for (int h = 0; h < IH; ++h) ql += __shfl(wl, h) * h2f(qih[(size_t)m * 512 + h * 64 + lane]);
      qlin[(size_t)m * 64 + lane] = f2h(ql);
    }
  }
  }
  { PHASE_IDS
  for (int tile = bid; tile < NR / 32; tile += G) {
    const int m0 = tile * 32, b = m0 >> 13, s0 = m0 & (SEQ - 1);
    bf16_t* ubuf = (bf16_t*)lds_raw;
    float* res = (float*)(lds_raw + 65536);
    __syncthreads();
    for (int i = tid; i < 62 * 64; i += NTHR) {
      const int rr = i >> 6, cc = i & 63, s = s0 - 30 + rr, t = s + NMETA;
      uint4 v = make_uint4(0u, 0u, 0u, 0u);
      if (t >= 0) { const int row = t < NMETA ? NR + b * NMETA + t : b * SEQ + s; v = *(const uint4*)(ub + (size_t)row * 512 + cc * 8); }
      *(uint4*)(ubuf + rr * 512 + cc * 8) = v;
    }
    __syncthreads();
    {
      const int hf = tid >> 8, cp = tid & 255;
      float cw0[CONV_W], cw1[CONV_W];
#pragma unroll
      for (int w = 0; w < CONV_W; ++w) { const float2 c2 = *(const float2*)(a.conv_w + w * CONV_CH + 2 * cp); cw0[w] = c2.x; cw1[w] = c2.y; }
      const float2 cb = *(const float2*)(a.conv_b + 2 * cp);
#pragma unroll 1
      for (int rr = 0; rr < 16; ++rr) {
        const int r = hf * 16 + rr; float a0 = cb.x, a1 = cb.y;
#pragma unroll
        for (int w = 0; w < CONV_W; ++w) { const unsigned pr = *(const unsigned*)(ubuf + (r + w) * 512 + 2 * cp); a0 += cw0[w] * bflo(pr); a1 += cw1[w] * bfhi(pr); }
        *(float2*)(res + r * 512 + 2 * cp) = make_float2(a0, a1);
      }
    }
    __syncthreads();
#pragma unroll 1
    for (int rr = 0; rr < 4; ++rr) {
      const int r = wave + 8 * rr; float v[8]; float s = 0.f;
#pragma unroll
      for (int j = 0; j < 8; ++j) { v[j] = res[r * 512 + j * 64 + lane]; s += v[j]; }
      const float mu = wave_sum(s) * (1.0f / CONV_CH); float q = 0.f;
#pragma unroll
      for (int j = 0; j < 8; ++j) { v[j] -= mu; q += v[j] * v[j]; }
      const float rstd = rsqrtf(wave_sum(q) * (1.0f / CONV_CH) + LN_EPS);
#pragma unroll
      for (int j = 0; j < 8; ++j) { const int c = j * 64 + lane; const float y = v[j] * rstd * a.lnc_g[c] + a.lnc_b[c]; mixb[(size_t)(m0 + r) * D + c] = (bf16_t)f2bf(y / (1.0f + __expf(-y))); }
    }
  }
  }
  xcd_barrier(bar);
  { PHASE_IDS
  {
    unsigned char* ql = lds_raw;
    int* cl = (int*)(lds_raw + 18432);
    int* tl = cl + 256;
    const int q = lane & 15, kg = lane >> 4;
    for (int pi = bid; pi < 512; pi += G)
#pragma unroll 1
      for (int hf = 0; hf < 2; ++hf) {
        const int blk = hf ? 1023 - pi : pi;
        const int m0 = blk * 16, b = m0 >> 13, s0 = m0 & (SEQ - 1), m = m0 + q;
        const int ntile = (s0 >> 4) + 2;
        const int nsl = (ntile + 7) >> 3;
        __syncthreads();
        if (wave == 0) {
#pragma unroll
          for (int h = 0; h < 9; ++h)
#pragma unroll
            for (int ks = 0; ks < 2; ++ks) {
              const unsigned short* src = h < 8 ? qih + (size_t)m * 512 + h * 64 + ks * 32 + kg * 8 : qlin + (size_t)m * 64 + ks * 32 + kg * 8;
              *(uint4*)(ql + ((h * 2 + ks) * 64 + lane) * 16) = *(const uint4*)src;
            }
        }
        float wv[8];
#pragma unroll
        for (int h = 0; h < 8; ++h) wv[h] = wq[(size_t)m * 8 + h];
        __syncthreads();
        unsigned sc[130];
#pragma unroll
        for (int slot = 0; slot < 65; ++slot) {
          const int g = slot * 8 + wave;
          unsigned p0 = 0u, p1 = 0u;
          if (g < ntile) {
            const int krow = g == 0 ? NR + 16 * b + q : b * SEQ + 16 * (g - 1) + q;
            const f16x8 a0 = *(const f16x8*)(kiF + (size_t)krow * 64 + kg * 8), a1 = *(const f16x8*)(kiF + (size_t)krow * 64 + 32 + kg * 8);
            unsigned qo = (unsigned)lane * 16u; asm volatile("" : "+v"(qo));
            const unsigned char* qlp = ql + qo;
            pg8::f32x4 sv = __builtin_amdgcn_mfma_f32_16x16x32_f16(a0, *(const f16x8*)(qlp + (8 * 2 + 0) * 1024), (pg8::f32x4){0.f, 0.f, 0.f, 0.f}, 0, 0, 0);
            sv = __builtin_amdgcn_mfma_f32_16x16x32_f16(a1, *(const f16x8*)(qlp + (8 * 2 + 1) * 1024), sv, 0, 0, 0);
#pragma unroll
            for (int h = 0; h < 8; ++h) {
              pg8::f32x4 tv = __builtin_amdgcn_mfma_f32_16x16x32_f16(a0, *(const f16x8*)(qlp + (h * 2 + 0) * 1024), (pg8::f32x4){0.f, 0.f, 0.f, 0.f}, 0, 0, 0);
              tv = __builtin_amdgcn_mfma_f32_16x16x32_f16(a1, *(const f16x8*)(qlp + (h * 2 + 1) * 1024), tv, 0, 0, 0);
#pragma unroll
              for (int r = 0; r < 4; ++r) sv[r] = fmaf(fabsf(tv[r]), wv[h], sv[r]);
            }
            unsigned h01 = __builtin_bit_cast(unsigned, __builtin_amdgcn_cvt_pkrtz(sv[0], sv[1])), h23 = __builtin_bit_cast(unsigned, __builtin_amdgcn_cvt_pkrtz(sv[2], sv[3]));
            h01 ^= (((h01 >> 15) & 0x00010001u) * 0x7FFFu) | 0x80008000u;
            h23 ^= (((h23 >> 15) & 0x00010001u) * 0x7FFFu) | 0x80008000u;
            if (g == ntile - 1) {
              const int lim = q - 4 * kg;
              h01 &= (lim >= 0 ? 0x0000FFFFu : 0u) | (lim >= 1 ? 0xFFFF0000u : 0u);
              h23 &= (lim >= 2 ? 0x0000FFFFu : 0u) | (lim >= 3 ? 0xFFFF0000u : 0u);
            }
            p0 = h01; p1 = h23;
          }
          sc[2 * slot] = p0; sc[2 * slot + 1] = p1;
        }
        unsigned lo = 0u; int par = 0; const unsigned ones16 = 0x00010001u;
#define CNT_GE(dst, T1) do { const unsigned tm_ = (unsigned)(T1) * 0x00010001u; unsigned ac_ = 0u; \
          _Pragma("unroll") for (int gp = 0; gp < 9; ++gp) if (gp * 8 < nsl) { _Pragma("unroll") for (int i = gp * 16; i < (gp == 8 ? 130 : gp * 16 + 16); ++i) pk_cnt_gt(ac_, sc[i], tm_, ones16); } \
          dst = (int)((ac_ & 0xffffu) + (ac_ >> 16)); } while (0)
#pragma unroll 1
        for (int bit = 15; bit >= 0; --bit) {
          const unsigned cand = lo | (1u << bit);
          int c0; CNT_GE(c0, cand - 1u);
          c0 += __shfl_xor(c0, 16); c0 += __shfl_xor(c0, 32);
          if (kg == 0) cl[(par * 8 + wave) * 16 + q] = c0;
          __syncthreads();
          int tot = 0;
#pragma unroll
          for (int w = 0; w < 8; ++w) tot += cl[(par * 8 + w) * 16 + q];
          if (tot >= TOPK) lo = cand;
          par ^= 1;
        }
        const unsigned T = lo;
        int cge = 0, cgt = 0;
        if (T > 0u) { CNT_GE(cge, T - 1u); }
        if (T < 0xFFFFu) { CNT_GE(cgt, T); }
        if (T == 0u) cge = cgt;
        const int eq = cge - cgt;
        int e0 = __shfl(eq, q), e1 = __shfl(eq, q + 16), e2 = __shfl(eq, q + 32), e3 = __shfl(eq, q + 48);
        int g4 = cgt; g4 += __shfl_xor(g4, 16); g4 += __shfl_xor(g4, 32);
        const int pre_l = (kg > 0 ? e0 : 0) + (kg > 1 ? e1 : 0) + (kg > 2 ? e2 : 0);
        if (kg == 0) { tl[wave * 16 + q] = e0 + e1 + e2 + e3; cl[(par * 8 + wave) * 16 + q] = g4; }
        __syncthreads();
        int totgt = 0, prew = 0;
#pragma unroll
        for (int w = 0; w < 8; ++w) { totgt += cl[(par * 8 + w) * 16 + q]; prew += (w < wave) ? tl[w * 16 + q] : 0; }
        par ^= 1;
        const int need = T > 0u ? TOPK - totgt : 0;
        const int budget = min(max(need - (prew + pre_l), 0), eq);
        int tc = 0;
        unsigned short* mrow = (unsigned short*)(maskb + (size_t)m * MPW);
#pragma unroll
        for (int slot = 0; slot < 65; ++slot) {
          const unsigned p0 = sc[2 * slot], p1 = sc[2 * slot + 1];
          unsigned nib = 0u;
          if (slot < nsl) {
            const unsigned v0 = p0 & 0xffffu, v1 = p0 >> 16, v2 = p1 & 0xffffu, v3 = p1 >> 16;
            bool e;
            e = v0 == T; nib |= ((v0 > T) | (e & (tc < budget))) ? 1u : 0u; tc += e ? 1 : 0;
            e = v1 == T; nib |= ((v1 > T) | (e & (tc < budget))) ? 2u : 0u; tc += e ? 1 : 0;
            e = v2 == T; nib |= ((v2 > T) | (e & (tc < budget))) ? 4u : 0u; tc += e ? 1 : 0;
            e = v3 == T; nib |= ((v3 > T) | (e & (tc < budget))) ? 8u : 0u; tc += e ? 1 : 0;
            nib <<= 4 * kg;
            nib |= __shfl_xor(nib, 16); nib |= __shfl_xor(nib, 32);
          }
          if (kg == 0) mrow[slot * 8 + wave + KVOFF / 16] = (unsigned short)nib;
        }
        if (wave == 0 && kg == 0) {
#pragma unroll
          for (int i = 0; i < KVOFF / 16; ++i) mrow[i] = 0;
        }
#undef CNT_GE
      }
  }
  }
  xcd_barrier(bar);
  { PHASE_IDS
  {
    const attn_body::AttnTensors AT{(const attn_body::bf16*)qb, (const attn_body::bf16*)kb, (const attn_body::bf16*)vb, (attn_body::bf16*)(mixb + CONV_CH), maskb};
    const attn_body::StaticOrder S(G, bid);
    attn_body::attn_phase<attn_body::StaticOrder>((char*)lds_raw, AT, S);
  }
  }
  xcd_barrier(bar);
  { PHASE_IDS
  {
    pg8::Gemm g{mixb, WoutT, NR, D, D}; pg8::StaticOrder S; S.init(NR, D, G, bid);
    EpiF32 E{tmp, D, NR, D};
    pg8::gemm_phase<EpiF32, pg8::StaticOrder, true, true>((PG8_LAS unsigned char*)lds_raw, g, S, E);
  }
  }
  xcd_barrier(bar);
  { PHASE_IDS
  {
    float* scr = lds + wave * 2304;
    for (int it = gw; it < (NE + 1) * 384; it += NGW) {
      const int e = it / 384, r = it % 384, which = r >> 7, q = r & 127;
      if (which < 2) {
        const float* W = e < NE ? (which ? a.w_up : a.w_gate) + (size_t)e * D * DE : (which ? a.ws_up : a.ws_gate);
        const int kb_ = q >> 3, nb = q & 7, n0 = 32 * nb;
        transpose_item(W, D, DE, WguT + (size_t)e * WGU_E, D, scr, 64 * kb_, n0, (n0 >> 7) * 256 + which * 128 + (n0 & 127), lane);
      } else {
        const float* W = e < NE ? a.w_down + (size_t)e * DE * D : a.ws_down;
        const int kb_ = q >> 5, nb = q & 31;
        transpose_item(W, DE, D, WdT + (size_t)e * WD_E, DE, scr, 64 * kb_, 32 * nb, 32 * nb, lane);
      }
    }
  }
  for (int m = gw; m < NR; m += NGW) {
    const float2 st = st0[m];
    float v[16]; float s = 0.f;
#pragma unroll
    for (int i = 0; i < 16; ++i) { const int c = i * 64 + lane; const float hh = (a.x[(size_t)m * D + c] - st.x) * st.y * a.ln_emb_g[c] + a.ln_emb_b[c]; v[i] = DN_ALPHA * hh + tmp[(size_t)m * D + c]; s += v[i]; }
    const float mu = wave_sum(s) * (1.0f / D);
    float q = 0.f;
#pragma unroll
    for (int i = 0; i < 16; ++i) { const float d = v[i] - mu; q += d * d; }
    const float rstd = rsqrtf(wave_sum(q) * (1.0f / D) + LN_EPS);
#pragma unroll
    for (int i = 0; i < 16; ++i) { const int c = i * 64 + lane; v[i] = (v[i] - mu) * rstd * a.ln1_g[c] + a.ln1_b[c]; h1b[(size_t)m * D + c] = (bf16_t)f2bf(v[i]); }
    float lgt = 0.f;
#pragma unroll
    for (int i = 0; i < 16; ++i)
      for (int j = 0; j < 64; ++j) lgt += __shfl(v[i], j) * a.w_router[(i * 64 + j) * NE + lane];
    const float score = sigmoidf_(lgt), biased = score + a.r_bias[lane];
    float m1 = -INFINITY, m2 = -INFINITY;
    for (int j = 0; j < 8; ++j) { const float vv = __shfl(biased, (lane & ~7) + j); if (vv > m1) { m2 = m1; m1 = vv; } else if (vv > m2) m2 = vv; }
    const float gs = m1 + m2; const int g = lane >> 3;
    int grank = 0;
    for (int j = 0; j < 8; ++j) { const float vv = __shfl(gs, j * 8); grank += (vv > gs || (vv == gs && j < g)) ? 1 : 0; }
    const float val = grank < 4 ? biased : -INFINITY;
    int rank = 0;
    for (int j = 0; j < 64; ++j) { const float vv = __shfl(val, j); rank += (vv > val || (vv == val && j < lane)) ? 1 : 0; }
    const bool selq = rank < TOPE;
    const float ssum = wave_sum(selq ? score : 0.f);
    if (selq) { ridx[m * TOPE + rank] = lane; rw[m * TOPE + rank] = score / ssum * ROUTED_SCALE; atomicAdd(&ecnt[lane], 1); }
  }
  }
  xcd_barrier(bar);
  { PHASE_IDS
  {
    __syncthreads();
    if (tid == 0) { int aa = 0; for (int e = 0; e < NE; ++e) { tst[e] = aa; aa += (ecnt[e] + 255) >> 8; } tst[NE] = aa; tst[NE + 1] = aa + NR / 256; }
    __syncthreads();
    for (int i = bid * NTHR + tid; i < NR * TOPE; i += G * NTHR) {
      const int e = ridx[i], p = tst[e] * 256 + atomicAdd(&ecur[e], 1);
      tokmap[p] = i / TOPE; wslot[p] = rw[i];
    }
    for (int e = bid; e < NE; e += G) {
      const int lo = tst[e] * 256 + ecnt[e], hi = tst[e + 1] * 256;
      for (int p = lo + tid; p < hi; p += NTHR) { tokmap[p] = 0; wslot[p] = 0.f; }
    }
    const int sb = tst[NE] * 256;
    for (int i = bid * NTHR + tid; i < NR; i += G * NTHR) { tokmap[sb + i] = i; wslot[sb + i] = 1.0f; }
  }
  }
  xcd_barrier(bar);
  { PHASE_IDS
  {
    MoeSched S{tst, 2, G, bid, WguT, WGU_E, D, nullptr, tokmap};
    EpiGateUp E{hdn};
    gemm_phase_x<EpiGateUp, MoeSched, true>((PG8_LAS unsigned char*)lds_raw, h1b, (unsigned)(D * 2), D, S, E);
  }
  }
  xcd_barrier(bar);
  { PHASE_IDS
  {
    MoeSched S{tst, 4, G, bid, WdT, WD_E, DE, hdn, nullptr};
    EpiDown E{out, tokmap, wslot};
    gemm_phase_x<EpiDown, MoeSched, false>((PG8_LAS unsigned char*)lds_raw, nullptr, (unsigned)(DE * 2), DE, S, E);
  }
  }
  xcd_barrier(bar);
  { PHASE_IDS
  for (int m = gw; m < NR; m += NGW) {
    float v[16]; float s = 0.f;
#pragma unroll
    for (int i = 0; i < 16; ++i) { const int c = i * 64 + lane; v[i] = DN_ALPHA * bf2f(h1b[(size_t)m * D + c]) + out[(size_t)m * D + c]; s += v[i]; }
    const float mu = wave_sum(s) * (1.0f / D);
    float q = 0.f;
#pragma unroll
    for (int i = 0; i < 16; ++i) { const float d = v[i] - mu; q += d * d; }
    const float rstd = rsqrtf(wave_sum(q) * (1.0f / D) + LN_EPS);
#pragma unroll
    for (int i = 0; i < 16; ++i) { const int c = i * 64 + lane; out[(size_t)m * D + c] = (v[i] - mu) * rstd * a.ln2_g[c] + a.ln2_b[c]; }
  }
  }
}

extern "C" void kernel_launch(void* const* d_in, const int* in_sizes, int n_in, void* d_out, int out_size, void* d_ws, size_t ws_size, hipStream_t stream) {
  static int grid = 0;
  if (grid == 0) {
    int dev = 0, cus = 0, per_cu = 0;
    if (hipGetDevice(&dev) != hipSuccess || hipDeviceGetAttribute(&cus, hipDeviceAttributeMultiprocessorCount, dev) != hipSuccess) { fprintf(stderr, "kernel_launch: device query failed\n"); grid = -1; return; }
    if (hipFuncSetAttribute((const void*)mega_fwd, hipFuncAttributeMaxDynamicSharedMemorySize, LDS_BYTES) != hipSuccess) { fprintf(stderr, "kernel_launch: hipFuncSetAttribute failed\n"); grid = -1; return; }
    if (hipOccupancyMaxActiveBlocksPerMultiprocessor(&per_cu, (const void*)mega_fwd, NTHR, LDS_BYTES) != hipSuccess || per_cu < 1) { fprintf(stderr, "kernel_launch: occupancy query says %d\n", per_cu); }
    (void)hipGetLastError();
    grid = cus;
  }
  if (grid < 0) return;
  (void)in_sizes; (void)n_in; (void)out_size; (void)ws_size;
  if (hipMemsetAsync(d_ws, 0, CTL_BYTES, stream) != hipSuccess) { fprintf(stderr, "kernel_launch: memset failed\n"); return; }
  Args a{};
  const float** pp = (const float**)&a;
  for (int i = 0; i < 24; ++i) pp[i] = (const float*)d_in[i];
  a.out = (float*)d_out; a.ws = (unsigned char*)d_ws;
  for (int i = 0; i < 8; ++i) a.ropeinv[i] = (float)pow(500000.0, -2.0 * i / 16.0);
  hipLaunchKernelGGL(mega_fwd, dim3(grid), dim3(NTHR), LDS_BYTES, stream, a);
  const hipError_t le = hipPeekAtLastError();
  if (le != hipSuccess) fprintf(stderr, "kernel_launch: launch failed: %s\n", hipGetErrorName(le));
}
```

```cpp
#include <hip/hip_runtime.h>
#include <hip/hip_bf16.h>
#include <cstdint>
#include <cstdio>
#include <cmath>

constexpr int D = 1024, NB = 2, SEQ = 8192, NMETA = 16, TP = SEQ + NMETA;
constexpr int NR = NB * SEQ;
constexpr int NROWS = NR + NB * NMETA;
constexpr int CONV_CH = 512, CONV_W = 31, NH = 8, HD = 64, IH = 8, IDD = 64, TOPK = 256;
constexpr int IN_W = 3144;
constexpr int OFF_A = 0, OFF_G = 512, OFF_Q = 1024, OFF_K = 1536, OFF_V = 2048, OFF_QI = 2560, OFF_KI = 3072, OFF_WI = 3136;
constexpr int NE = 64, TOPE = 8, DE = 256;
constexpr float LN_EPS = 1e-5f;
constexpr float DN_ALPHA = 1.189207115002721f;
constexpr float ROUTED_SCALE = 2.5f;

__device__ __forceinline__ int row_of(int b, int t) { return t < NMETA ? NR + b * NMETA + t : b * SEQ + (t - NMETA); }
__device__ __forceinline__ void row_bt(int m, int& b, int& t) { if (m < NR) { b = m >> 13; t = (m & (SEQ - 1)) + NMETA; } else { b = (m - NR) >> 4; t = (m - NR) & 15; } }

__device__ __forceinline__ float wave_sum(float v) {
#pragma unroll
  for (int o = 32; o > 0; o >>= 1) v += __shfl_xor(v, o);
  return v;
}
__device__ __forceinline__ float sigmoidf_(float x) { return 1.0f / (1.0f + expf(-x)); }

#define XB_TMO      128
#define XB_XCNT(j)  (256  + 64 * (j))
#define XB_XSUB(j)  (1280 + 64 * (j))
#define XB_XGEN(j)  (2304 + 64 * (j))
#define XB_TOP      3328
#define XB_TOPGEN   3392
#define XCD_BAR_WORDS 3456
#define XB_SPIN_CAP (1u << 18)
#ifndef LAS
#define LAS __attribute__((address_space(3)))
#endif

__device__ __forceinline__ unsigned xb_ld(unsigned* p)              { return __hip_atomic_load(p, __ATOMIC_RELAXED, __HIP_MEMORY_SCOPE_AGENT); }
__device__ __forceinline__ unsigned xb_add(unsigned* p, unsigned v) { return __hip_atomic_fetch_add(p, v, __ATOMIC_RELAXED, __HIP_MEMORY_SCOPE_AGENT); }
__device__ __forceinline__ unsigned xb_xcc_id() { return (unsigned)__builtin_amdgcn_s_getreg((3 << 11) | 20) & 0xFu; }
#define XB_SPIN(cond, bar) do { unsigned _sp = 0; while (cond) { __builtin_amdgcn_s_sleep(1); \
    if ((++_sp & 255u) == 0u) { if (xb_ld(&(bar)[XB_TMO])) break; if (_sp > XB_SPIN_CAP) { atomicAdd(&(bar)[XB_TMO], 1u); break; } } } } while (0)

struct XcdBarrier {
    unsigned* bar; unsigned x;
    volatile LAS unsigned* st;
};

__device__ __forceinline__ XcdBarrier xcd_barrier_post(unsigned* bar, volatile LAS unsigned* st) {
    XcdBarrier b; b.bar = bar; b.x = xb_xcc_id(); b.st = st;
    if (threadIdx.x == 0) (void)xb_add(&bar[XB_XCNT(b.x)], 1u);
    return b;
}
__device__ __forceinline__ void xcd_barrier_complete(unsigned* bar, unsigned x, unsigned& nloc, unsigned& nx) {
    const unsigned G = gridDim.x * gridDim.y * gridDim.z;
    unsigned sum, cnt, mine, sp = 0u;
    for (;;) {
        sum = 0u; cnt = 0u; mine = 0u;
#pragma unroll
        for (unsigned j = 0; j < 16; ++j) { const unsigned c = xb_ld(&bar[XB_XCNT(j)]); sum += c; cnt += (c > 0u) ? 1u : 0u; mine = (j == x) ? c : mine; }
        if (sum == G) break;
        __builtin_amdgcn_s_sleep(1);
        if ((++sp & 255u) == 0u) { if (xb_ld(&bar[XB_TMO])) break; if (sp > XB_SPIN_CAP) { atomicAdd(&bar[XB_TMO], 1u); break; } }
    }
    nloc = mine > 0u ? mine : 1u; nx = cnt > 0u ? cnt : 1u;
}

__device__ __forceinline__ void xcd_barrier(const XcdBarrier& b) {
    asm volatile("s_waitcnt vmcnt(0)" ::: "memory");
    __syncthreads();
    if (threadIdx.x == 0) {
        unsigned* bar = b.bar;
        __builtin_amdgcn_s_waitcnt(0);
        unsigned nloc = b.st[0], nx = b.st[1];
        if (nloc == 0u) { xcd_barrier_complete(bar, b.x, nloc, nx); b.st[0] = nloc; b.st[1] = nx; }
        const unsigned old = xb_add(&bar[XB_XSUB(b.x)], 1u);
        const unsigned gen = old / nloc;
        if (old + 1u == (gen + 1u) * nloc) {
            __builtin_amdgcn_fence(__ATOMIC_RELEASE, "agent");
            asm volatile("s_waitcnt vmcnt(0)" ::: "memory");
            const unsigned og = xb_add(&bar[XB_TOP], 1u);
            const unsigned tg = og / nx;
            if (og + 1u == (tg + 1u) * nx) xb_add(&bar[XB_TOPGEN], 1u);
            else XB_SPIN(xb_ld(&bar[XB_TOPGEN]) == tg, bar);
            __builtin_amdgcn_fence(__ATOMIC_ACQUIRE, "agent");
            xb_add(&bar[XB_XGEN(b.x)], 1u);
            asm volatile("s_waitcnt vmcnt(0)" ::: "memory");
        } else {
            XB_SPIN(xb_ld(&bar[XB_XGEN(b.x)]) == gen, bar);
            __builtin_amdgcn_fence(__ATOMIC_ACQUIRE, "agent");
            asm volatile("s_waitcnt vmcnt(0)" ::: "memory");
        }
    }
    __syncthreads();
}


typedef unsigned short bf16_t;
__device__ __forceinline__ unsigned f2bf(float f) { unsigned u = __float_as_uint(f); return (u + 0x7fffu + ((u >> 16) & 1u)) >> 16; }
__device__ __forceinline__ unsigned pk2(float lo, float hi) { return f2bf(lo) | (f2bf(hi) << 16); }
__device__ __forceinline__ float bf2f(bf16_t v) { return __uint_as_float((unsigned)v << 16); }

namespace pg8 {
#define PG8_LAS __attribute__((address_space(3)))
typedef unsigned short bf16_t;
typedef short bf16x8 __attribute__((ext_vector_type(8)));
typedef float f32x4 __attribute__((ext_vector_type(4)));
typedef unsigned u32x4 __attribute__((ext_vector_type(4)));
constexpr int BM = 256, BK = 64, HALF = 128, HTB = HALF * BK * 2  , STAGE_BYTES = 8 * HTB, NXCD = 8, WGM = 8;

__host__ __device__ __forceinline__ int lds_byte(int r, int c) { const int st = (r >> 4) * 2 + (c >> 5), rr = r & 15, cc = c & 31, ob = rr * 64 + cc * 2; return st * 1024 + (ob ^ (((ob >> 9) & 1) << 5)); }
__host__ __device__ __forceinline__ void stage_rc(int b, int& R, int& C) { const int st = b / 1024, sb = b % 1024, swz = sb ^ (((sb >> 9) & 1) << 5); R = (st >> 1) * 16 + swz / 64; C = (st & 1) * 32 + (swz % 64) / 2; }
__host__ __device__ __forceinline__ int perm32(int rho) { const int n = rho >> 4, i = rho & 15; return 8 * (i >> 2) + 4 * n + (i & 3); }

struct Unit { int pm, pn; };
struct Gemm { const bf16_t* A; const bf16_t* Bt; int M, N, K; };

struct StaticOrder {
    int nM, nN, nwg, G, c;
    __host__ __device__ void init(int M, int N, int G_, int c_) { nM = M / BM; nN = N / BM; nwg = nM * nN; G = G_; c = c_; }
    __host__ __device__ bool next(int i, Unit& u) const {
        const long L = (long)i * G + c; if (L >= nwg) return false;
        int wgid = (int)L; { const int q = nwg / NXCD, r = nwg % NXCD, xcd = wgid % NXCD, off = wgid / NXCD; wgid = (xcd < r ? xcd * (q + 1) : r * (q + 1) + (xcd - r) * q) + off; }
        const int nig = WGM * nN, gid = wgid / nig, fm = gid * WGM, gsz = (nM - fm) < WGM ? (nM - fm) : WGM;
        u.pm = fm + ((wgid % nig) % gsz); u.pn = (wgid % nig) / gsz; return true;
    }
    __device__ __forceinline__ void a_ready(const Unit&) const {}
    __device__ __forceinline__ void done(const Unit&) const {}
};

__device__ __forceinline__ unsigned cvt_pk_bf16(float lo, float hi) { unsigned r; asm volatile("v_cvt_pk_bf16_f32 %0, %1, %2" : "=v"(r) : "v"(lo), "v"(hi)); return r; }
typedef float f32x2 __attribute__((ext_vector_type(2)));
__device__ __forceinline__ f32x2 gelu_pk(f32x2 v) {
    const f32x2 av = __builtin_elementwise_abs(v), d = av * 0.2316418882f + 1.0f;
    f32x2 t; t.x = __builtin_amdgcn_rcpf(d.x); t.y = __builtin_amdgcn_rcpf(d.y);
    f32x2 q = t * 0.5307027145f + (-0.7265760135f); q = q * t + 0.7107068705f; q = q * t + (-0.142248368f); q = q * t + 0.127414796f; q = q * t;
    const f32x2 s = (v * v) * (-0.72134752044f);
    f32x2 e; e.x = __builtin_amdgcn_exp2f(s.x); e.y = __builtin_amdgcn_exp2f(s.y);
    const f32x2 m = v * (q * e), r = v - m;
    f32x2 o; o.x = v.x < 0.f ? m.x : r.x; o.y = v.y < 0.f ? m.y : r.y; return o;
}

template <int ACT  > struct EpiBf16 {
    static constexpr bool PERM = true, AFTER_DRAIN = false; static_assert(ACT == 0 || ACT == 1, "EpiBf16: ACT is 0 (none) or 1 (gelu_pk)");
    bf16_t* O; int ldc; const float* bias; int split_cols; size_t split_stride; float scale0;
    __device__ __forceinline__ void operator()(const f32x4 (&acc)[2][2][4][2], const Unit& u, int wr, int wc, int fr, int fq) const {
        const int row0 = u.pm * BM + wr * 64 + fr; int colt = u.pn * BM; bf16_t* base = O;
        float sc = 1.f; if (split_cols) { const int t = colt / split_cols; base += (size_t)t * split_stride; colt -= t * split_cols; if (t == 0) sc = scale0; }
        const int col0 = colt + wc * 32 + 8 * fq, bcol0 = u.pn * BM + wc * 32 + 8 * fq;
        f32x4 bv[2][2];
#pragma unroll
        for (int bj = 0; bj < 2; ++bj)
#pragma unroll
            for (int n = 0; n < 2; ++n) bv[bj][n] = bias ? *(const f32x4*)(bias + bcol0 + bj * HALF + 4 * n) : (f32x4){0.f, 0.f, 0.f, 0.f};
#pragma unroll
        for (int ai = 0; ai < 2; ++ai)
#pragma unroll
            for (int m = 0; m < 4; ++m) { bf16_t* rowp = base + (size_t)(row0 + ai * HALF + m * 16) * ldc + col0;
#pragma unroll
                for (int bj = 0; bj < 2; ++bj) { f32x4 v0 = acc[ai][bj][m][0] + bv[bj][0], v1 = acc[ai][bj][m][1] + bv[bj][1];
                    if (ACT == 1) { f32x2 a = gelu_pk((f32x2){v0[0], v0[1]}), b = gelu_pk((f32x2){v0[2], v0[3]}), c = gelu_pk((f32x2){v1[0], v1[1]}), d = gelu_pk((f32x2){v1[2], v1[3]});
                        v0 = (f32x4){a.x, a.y, b.x, b.y}; v1 = (f32x4){c.x, c.y, d.x, d.y}; }
                    v0 = v0 * sc; v1 = v1 * sc; u32x4 w; w.x = cvt_pk_bf16(v0[0], v0[1]); w.y = cvt_pk_bf16(v0[2], v0[3]); w.z = cvt_pk_bf16(v1[0], v1[1]); w.w = cvt_pk_bf16(v1[2], v1[3]);
                    *(u32x4*)(rowp + bj * HALF) = w; } }
    }
};

struct PanelStats {
    unsigned* xbuf;
    unsigned* cnt;
    unsigned* tmo;
    int ntn; float eps;
    unsigned code;
    __device__ __forceinline__ bool run(const f32x4 (&v)[2][2][4][2], const Unit& u, int wr, int wc, int fr, int fq, PG8_LAS unsigned char* lds, int wid, int lane) const {
        typedef float f32x2v __attribute__((ext_vector_type(2)));
        PG8_LAS f32x2v* P = (PG8_LAS f32x2v*)lds;
        PG8_LAS f32x2v* S = (PG8_LAS f32x2v*)(lds + 8192);
        PG8_LAS unsigned* flag = (PG8_LAS unsigned*)(lds + 8192 + 2048);
#pragma unroll
        for (int ai = 0; ai < 2; ++ai)
#pragma unroll
            for (int m = 0; m < 4; ++m) {
                float s = 0.f;
#pragma unroll
                for (int bj = 0; bj < 2; ++bj)
#pragma unroll
                    for (int n = 0; n < 2; ++n) { const f32x4 x = v[ai][bj][m][n]; s += (x[0] + x[1]) + (x[2] + x[3]); }
                s += __shfl_xor(s, 16); s += __shfl_xor(s, 32);
                const float mw = s * (1.0f / 64.0f); float q = 0.f;
#pragma unroll
                for (int bj = 0; bj < 2; ++bj)
#pragma unroll
                    for (int n = 0; n < 2; ++n) { const f32x4 d = v[ai][bj][m][n] - mw; q += (d[0] * d[0] + d[1] * d[1]) + (d[2] * d[2] + d[3] * d[3]); }
                q += __shfl_xor(q, 16); q += __shfl_xor(q, 32);
                if (fq == 0) P[(ai * HALF + wr * 64 + m * 16 + fr) * 4 + wc] = (f32x2v){mw, q};
            }
        asm volatile("s_waitcnt lgkmcnt(0)" ::: "memory"); __builtin_amdgcn_s_barrier(); asm volatile("" ::: "memory");
#if defined(BROKEN_EXCHANGE_NO_WAIT)
#warning BROKEN CONTROL BUILD: the row-statistics exchange does not wait; results are wrong by design
        if (blockIdx.x >= 64) { const long long t0_ = clock64(); while (clock64() - t0_ < 60000) __builtin_amdgcn_s_sleep(8); }
#endif
        const int row = wid * 32 + (lane & 31);
        if (lane < 32) {
            const f32x2v a = P[row * 4 + 0], b = P[row * 4 + 1], c = P[row * 4 + 2], d = P[row * 4 + 3];
            const float mt = (a.x + b.x + c.x + d.x) * 0.25f;
            const float da = a.x - mt, db = b.x - mt, dc = c.x - mt, dd = d.x - mt;
            const float m2 = (a.y + b.y) + (c.y + d.y) + 64.0f * ((da * da + db * db) + (dc * dc + dd * dd));
            unsigned long long* slot = (unsigned long long*)xbuf + ((size_t)(u.pm * BM + row) * 4 + u.pn);
            __hip_atomic_store(slot, ((unsigned long long)__float_as_uint(m2) << 32) | __float_as_uint(mt), __ATOMIC_RELAXED, __HIP_MEMORY_SCOPE_AGENT);
        }
        asm volatile("s_waitcnt vmcnt(0)" ::: "memory");
        if (lane == 0) __hip_atomic_fetch_add(cnt + 64 * u.pm, 1u, __ATOMIC_RELAXED, __HIP_MEMORY_SCOPE_AGENT);
        if (wid == 0) {
            bool dead = false; const unsigned long long t0 = __builtin_amdgcn_s_memrealtime(); const unsigned want = 8u * (unsigned)ntn;
            for (;;) {
#if defined(BROKEN_EXCHANGE_NO_WAIT)
                break;
#endif
                if ((unsigned)__builtin_amdgcn_readfirstlane(__hip_atomic_load(cnt + 64 * u.pm, __ATOMIC_RELAXED, __HIP_MEMORY_SCOPE_AGENT)) >= want) break;
                if (__builtin_amdgcn_s_memrealtime() - t0 > 2000000ull) {
                    if (lane == 0) { unsigned expect = 0u; __hip_atomic_compare_exchange_strong(tmo + 1, &expect, code | (unsigned)(u.pm & 0xff), __ATOMIC_RELAXED, __ATOMIC_RELAXED, __HIP_MEMORY_SCOPE_AGENT);
                                     __hip_atomic_store(tmo, 1u, __ATOMIC_RELAXED, __HIP_MEMORY_SCOPE_AGENT); }
                    dead = true; break; }
                __builtin_amdgcn_s_sleep(2);
            }
            __builtin_amdgcn_fence(__ATOMIC_ACQUIRE, "agent");
            if (lane == 0) flag[0] = dead ? 1u : 0u;
        }
        asm volatile("s_waitcnt vmcnt(0) lgkmcnt(0)" ::: "memory"); __builtin_amdgcn_s_barrier(); asm volatile("" ::: "memory");
        const bool bad = flag[0] != 0u;
        if (lane < 32) {
            const unsigned long long* slot = (const unsigned long long*)xbuf + (size_t)(u.pm * BM + row) * 4; float mt[4], m2[4]; float ms = 0.f;
#pragma unroll
            for (int t = 0; t < 4; ++t) { if (t < ntn) { const unsigned long long w = __hip_atomic_load(slot + t, __ATOMIC_RELAXED, __HIP_MEMORY_SCOPE_AGENT); mt[t] = __uint_as_float((unsigned)w); m2[t] = __uint_as_float((unsigned)(w >> 32)); } else { mt[t] = 0.f; m2[t] = 0.f; } ms += mt[t]; }
            const float mean = ms / (float)ntn; float q = 0.f;
#pragma unroll
            for (int t = 0; t < 4; ++t) if (t < ntn) { const float dm = mt[t] - mean; q += m2[t] + 256.0f * dm * dm; }
            S[row] = (f32x2v){mean, 1.0f / sqrtf(q / (256.0f * (float)ntn) + eps)};
        }
        asm volatile("s_waitcnt lgkmcnt(0)" ::: "memory"); __builtin_amdgcn_s_barrier(); asm volatile("" ::: "memory");
        return bad;
    }
};
struct EpiLnRes {
    static constexpr bool PERM = false, AFTER_DRAIN = true;
    const float* base; float* out; int ldc; const float* bias; PanelStats st; unsigned poison;
    __device__ __forceinline__ void fused(f32x4 (&acc)[2][2][4][2], const Unit& u, int wr, int wc, int fr, int fq, PG8_LAS unsigned char* lds, int wid, int lane) const {
        typedef float f32x2v __attribute__((ext_vector_type(2)));
        const PG8_LAS f32x2v* S = (const PG8_LAS f32x2v*)(lds + 8192);
        const int col0 = u.pn * BM + wc * 32 + 4 * fq;
#pragma unroll
        for (int bj = 0; bj < 2; ++bj)
#pragma unroll
            for (int n = 0; n < 2; ++n) { const f32x4 bv = bias ? *(const f32x4*)(bias + col0 + bj * HALF + n * 16) : (f32x4){0.f, 0.f, 0.f, 0.f};
#pragma unroll
                for (int ai = 0; ai < 2; ++ai)
#pragma unroll
                    for (int m = 0; m < 4; ++m) acc[ai][bj][m][n] += bv; }
        f32x4 pre[4][2][2];
#pragma unroll
        for (int m = 0; m < 4; ++m) { const size_t off = (size_t)(u.pm * BM + wr * 64 + m * 16 + fr) * ldc + col0;
#pragma unroll
            for (int bj = 0; bj < 2; ++bj)
#pragma unroll
                for (int n = 0; n < 2; ++n) pre[m][bj][n] = *(const f32x4*)(base + off + bj * HALF + n * 16); }
        const bool bad = st.run(acc, u, wr, wc, fr, fq, lds, wid, lane) || poison != 0u;
        const float qnan = __builtin_nanf("");
#pragma unroll
        for (int ai = 0; ai < 2; ++ai)
#pragma unroll
            for (int m = 0; m < 4; ++m) { const int r = ai * HALF + wr * 64 + m * 16 + fr; const f32x2v sr = S[r]; const size_t off = (size_t)(u.pm * BM + r) * ldc + col0;
#pragma unroll
                for (int bj = 0; bj < 2; ++bj)
#pragma unroll
                    for (int n = 0; n < 2; ++n) { const f32x4 bs = ai == 0 ? pre[m][bj][n] : *(const f32x4*)(base + off + bj * HALF + n * 16); f32x4 o = bs + (acc[ai][bj][m][n] - sr.x) * sr.y;
                        if (bad) o = (f32x4){qnan, qnan, qnan, qnan}; *(f32x4*)(out + off + bj * HALF + n * 16) = o; }
                if (m & 1) asm volatile("" ::: "memory"); }
    }
};
struct EpiLnResLn {
    static constexpr bool PERM = false, AFTER_DRAIN = true;
    const float* base; float* out; bf16_t* xn; int ldc; const float* bias; PanelStats st1, st2; unsigned poison;
    __device__ __forceinline__ void fused(f32x4 (&acc)[2][2][4][2], const Unit& u, int wr, int wc, int fr, int fq, PG8_LAS unsigned char* lds, int wid, int lane) const {
        typedef float f32x2v __attribute__((ext_vector_type(2))); typedef unsigned u32x2v __attribute__((ext_vector_type(2)));
        const PG8_LAS f32x2v* S = (const PG8_LAS f32x2v*)(lds + 8192);
        const int col0 = u.pn * BM + wc * 32 + 4 * fq;
#pragma unroll
        for (int bj = 0; bj < 2; ++bj)
#pragma unroll
            for (int n = 0; n < 2; ++n) { const f32x4 bv = bias ? *(const f32x4*)(bias + col0 + bj * HALF + n * 16) : (f32x4){0.f, 0.f, 0.f, 0.f};
#pragma unroll
                for (int ai = 0; ai < 2; ++ai)
#pragma unroll
                    for (int m = 0; m < 4; ++m) acc[ai][bj][m][n] += bv; }
        bool bad = st1.run(acc, u, wr, wc, fr, fq, lds, wid, lane) || poison != 0u;
        const float qnan = __builtin_nanf("");
#pragma unroll
        for (int ai = 0; ai < 2; ++ai)
#pragma unroll
            for (int m = 0; m < 4; ++m) { const int r = ai * HALF + wr * 64 + m * 16 + fr; const f32x2v sr = S[r]; const size_t off = (size_t)(u.pm * BM + r) * ldc + col0;
#pragma unroll
                for (int bj = 0; bj < 2; ++bj)
#pragma unroll
                    for (int n = 0; n < 2; ++n) { const f32x4 bs = *(const f32x4*)(base + off + bj * HALF + n * 16); acc[ai][bj][m][n] = bs + (acc[ai][bj][m][n] - sr.x) * sr.y; }
                asm volatile("" : "+v"(acc[ai][0][m][0]), "+v"(acc[ai][0][m][1]), "+v"(acc[ai][1][m][0]), "+v"(acc[ai][1][m][1]));
                if (m & 1) asm volatile("" ::: "memory"); }
        const bool bad1 = bad;
        bad = st2.run(acc, u, wr, wc, fr, fq, lds, wid, lane) || bad;
#pragma unroll
        for (int ai = 0; ai < 2; ++ai)
#pragma unroll
            for (int m = 0; m < 4; ++m) { const int r = ai * HALF + wr * 64 + m * 16 + fr; const f32x2v sr = S[r]; const size_t off = (size_t)(u.pm * BM + r) * ldc + col0;
#pragma unroll
                for (int bj = 0; bj < 2; ++bj)
#pragma unroll
                    for (int n = 0; n < 2; ++n) { const f32x4 x1 = acc[ai][bj][m][n]; *(f32x4*)(out + off + bj * HALF + n * 16) = bad1 ? (f32x4){qnan, qnan, qnan, qnan} : x1;
                        const f32x4 o = (x1 - sr.x) * sr.y; u32x2v w; w.x = cvt_pk_bf16(o[0], o[1]); w.y = cvt_pk_bf16(o[2], o[3]);
                        if (bad) { w.x = 0x7fc07fc0u; w.y = 0x7fc07fc0u; } *(u32x2v*)(xn + off + bj * HALF + n * 16) = w; }
                asm volatile("" ::: "memory"); }
    }
};

template <class Epi, class Sched, bool ALIGN_EPI = false, bool SP2 = false>
__device__ __forceinline__ void gemm_phase(PG8_LAS unsigned char* lds, const Gemm g, const Sched& S, const Epi& E) {
    int tid = threadIdx.x; asm volatile("" : "+v"(tid));
    const int wid = __builtin_amdgcn_readfirstlane(tid >> 6), lane = tid & 63, wr = wid >> 2, wc = wid & 3, fr = lane & 15, fq = lane >> 4;
    const int K = g.K, nt = K / BK;
    unsigned voffA[2], voffB[2];
#pragma unroll
    for (int i = 0; i < 2; ++i) { int R, C; stage_rc(tid * 16 + i * 8192, R, C); const int Rb = Epi::PERM ? ((R & ~31) + perm32(R & 31)) : R;
        voffA[i] = (unsigned)(R * K + C) * 2u; voffB[i] = (unsigned)(Rb * K + C) * 2u; }
    const size_t kstep = (size_t)(BK * 2);
    const size_t hstep = (size_t)HALF * K * 2;
    const size_t tstep = 2 * hstep;
    const unsigned ldsw = (unsigned)wid * 1024u;
    const int aoff = lds_byte(wr * 64 + fr, fq * 8), boff = lds_byte(wc * 32 + fr, fq * 8);
#define PG8_SA(b, h) (((b) * 2 + (h)) * HTB)
#define PG8_SB(b, h) ((4 + (b) * 2 + (h)) * HTB)
#define PG8_STAGE(bufoff, gbase, voff) do { _Pragma("unroll") for (int _i = 0; _i < 2; ++_i) \
        __builtin_amdgcn_global_load_lds((const unsigned*)((const char*)(gbase) + (voff)[_i]), (PG8_LAS unsigned*)(lds + (bufoff) + ldsw + _i * 8192), 16, 0, 0); } while (0)
#define PG8_LDA(dst, b, h) do { _Pragma("unroll") for (int m = 0; m < 4; ++m) _Pragma("unroll") for (int k = 0; k < 2; ++k) dst[m][k] = *(const PG8_LAS bf16x8*)(lds + PG8_SA(b, h) + aoff + m * 2048 + k * 1024); } while (0)
#define PG8_LDB(dst, b, h) do { _Pragma("unroll") for (int n = 0; n < 2; ++n) _Pragma("unroll") for (int k = 0; k < 2; ++k) dst[n][k] = *(const PG8_LAS bf16x8*)(lds + PG8_SB(b, h) + boff + n * 2048 + k * 1024); } while (0)
#define PG8_MMA(ai, bj, At, Bt) do { __builtin_amdgcn_s_setprio(1); _Pragma("unroll") for (int m = 0; m < 4; ++m) _Pragma("unroll") for (int n = 0; n < 2; ++n) _Pragma("unroll") for (int k = 0; k < 2; ++k) \
        acc[ai][bj][m][n] = __builtin_amdgcn_mfma_f32_16x16x32_bf16(Bt[n][k], At[m][k], acc[ai][bj][m][n], 0, 0, 0); __builtin_amdgcn_s_setprio(0); } while (0)
#define PG8_WAIT_V(n) asm volatile("s_waitcnt vmcnt(" #n ")" ::: "memory")
#define PG8_WAIT_L(n) asm volatile("s_waitcnt lgkmcnt(" #n ")" ::: "memory")
#define PG8_BAR __builtin_amdgcn_s_barrier()
#define PG8_SCHED __builtin_amdgcn_sched_barrier(0)
    Unit cur, nxt; int ui = 0;
    if (!S.next(0, cur)) return;
    f32x4 acc[2][2][4][2];
#pragma unroll
    for (int a = 0; a < 2; ++a)
#pragma unroll
        for (int b = 0; b < 2; ++b)
#pragma unroll
            for (int m = 0; m < 4; ++m)
#pragma unroll
                for (int n = 0; n < 2; ++n) acc[a][b][m][n] = (f32x4){0.f, 0.f, 0.f, 0.f};
    bf16x8 At[4][2], B0[2][2], B1[2][2];
    const char* cA = (const char*)g.A + (size_t)cur.pm * tstep; const char* cB = (const char*)g.Bt + (size_t)cur.pn * tstep;
    S.a_ready(cur);
    if constexpr (SP2) {
        PG8_STAGE(PG8_SB(0, 0), cB, voffB); PG8_STAGE(PG8_SB(0, 1), cB + hstep, voffB); PG8_STAGE(PG8_SA(0, 0), cA, voffA); PG8_STAGE(PG8_SA(0, 1), cA + hstep, voffA);
        if (wr == 1) PG8_BAR;
        PG8_WAIT_V(2); PG8_BAR;
        PG8_STAGE(PG8_SB(1, 0), cB + kstep, voffB); PG8_STAGE(PG8_SA(1, 0), cA + kstep, voffA); PG8_STAGE(PG8_SB(1, 1), cB + hstep + kstep, voffB);
        PG8_WAIT_V(6); PG8_BAR;
    } else {
        PG8_STAGE(PG8_SB(0, 0), cB, voffB); PG8_STAGE(PG8_SA(0, 0), cA, voffA); PG8_STAGE(PG8_SB(0, 1), cB + hstep, voffB); PG8_STAGE(PG8_SA(0, 1), cA + hstep, voffA);
        if (wr == 1) PG8_BAR;
        PG8_WAIT_V(4); PG8_BAR;
        PG8_STAGE(PG8_SB(1, 0), cB + kstep, voffB); PG8_STAGE(PG8_SA(1, 0), cA + kstep, voffA); PG8_STAGE(PG8_SB(1, 1), cB + hstep + kstep, voffB);
        PG8_WAIT_V(6); PG8_BAR;
    }
    for (;;) {
        const bool has_next = S.next(ui + 1, nxt);
        const char* nA = has_next ? (const char*)g.A + (size_t)nxt.pm * tstep : cA; const char* nB = has_next ? (const char*)g.Bt + (size_t)nxt.pn * tstep : cB;
        for (int t = 0; t < nt; t += 2) {
            const bool last = (t == nt - 2);
            const char* a1 = cA + (size_t)(t + 1) * kstep;
            const char* a2 = last ? nA : cA + (size_t)(t + 2) * kstep; const char* b2 = last ? nB : cB + (size_t)(t + 2) * kstep;
            const char* a3 = a2 + kstep; const char* b3 = b2 + kstep;
            if (last && has_next) S.a_ready(nxt);
            if constexpr (SP2) {
            PG8_LDB(B0, 0, 0); PG8_LDB(B1, 0, 1); PG8_SCHED; PG8_LDA(At, 0, 0); PG8_STAGE(PG8_SA(1, 1), a1 + hstep, voffA);
            PG8_WAIT_V(8); PG8_WAIT_L(0); PG8_BAR; PG8_MMA(0, 0, At, B0); PG8_MMA(0, 1, At, B1); PG8_BAR; PG8_SCHED;
            PG8_LDA(At, 0, 1); PG8_STAGE(PG8_SB(0, 0), b2, voffB); PG8_STAGE(PG8_SB(0, 1), b2 + hstep, voffB); PG8_STAGE(PG8_SA(0, 0), a2, voffA);
            PG8_WAIT_V(8); PG8_WAIT_L(0); PG8_BAR; PG8_MMA(1, 0, At, B0); PG8_MMA(1, 1, At, B1); PG8_BAR; PG8_SCHED;
            PG8_LDB(B0, 1, 0); PG8_LDB(B1, 1, 1); PG8_SCHED; PG8_LDA(At, 1, 0); PG8_STAGE(PG8_SA(0, 1), a2 + hstep, voffA);
            PG8_WAIT_V(8); PG8_WAIT_L(0); PG8_BAR; PG8_MMA(0, 0, At, B0); PG8_MMA(0, 1, At, B1); PG8_BAR; PG8_SCHED;
            PG8_LDA(At, 1, 1); PG8_STAGE(PG8_SB(1, 0), b3, voffB); PG8_STAGE(PG8_SB(1, 1), b3 + hstep, voffB); PG8_STAGE(PG8_SA(1, 0), a3, voffA);
            PG8_WAIT_V(8); PG8_WAIT_L(0); PG8_BAR; PG8_MMA(1, 0, At, B0); PG8_MMA(1, 1, At, B1); PG8_BAR; PG8_SCHED;
            } else {
            PG8_LDB(B0, 0, 0); PG8_SCHED; PG8_LDA(At, 0, 0); PG8_STAGE(PG8_SA(1, 1), a1 + hstep, voffA);
            PG8_WAIT_L(8); PG8_BAR; PG8_WAIT_L(0); PG8_MMA(0, 0, At, B0); PG8_BAR; PG8_SCHED;
            PG8_LDB(B1, 0, 1); PG8_STAGE(PG8_SB(0, 0), b2, voffB);
            PG8_BAR; PG8_WAIT_L(0); PG8_MMA(0, 1, At, B1); PG8_BAR;
            PG8_LDA(At, 0, 1); PG8_STAGE(PG8_SA(0, 0), a2, voffA);
            PG8_BAR; PG8_WAIT_L(0); PG8_MMA(1, 0, At, B0); PG8_BAR; PG8_SCHED;
            PG8_STAGE(PG8_SB(0, 1), b2 + hstep, voffB);
            PG8_WAIT_V(6); PG8_BAR; PG8_MMA(1, 1, At, B1); PG8_BAR;
            PG8_LDB(B0, 1, 0); PG8_SCHED; PG8_LDA(At, 1, 0); PG8_STAGE(PG8_SA(0, 1), a2 + hstep, voffA);
            PG8_WAIT_L(8); PG8_BAR; PG8_WAIT_L(0); PG8_MMA(0, 0, At, B0); PG8_BAR; PG8_SCHED;
            PG8_LDB(B1, 1, 1); PG8_STAGE(PG8_SB(1, 0), b3, voffB);
            PG8_BAR; PG8_WAIT_L(0); PG8_MMA(0, 1, At, B1); PG8_BAR;
            PG8_LDA(At, 1, 1); PG8_STAGE(PG8_SA(1, 0), a3, voffA);
            PG8_BAR; PG8_WAIT_L(0); PG8_MMA(1, 0, At, B0); PG8_BAR; PG8_SCHED;
            PG8_STAGE(PG8_SB(1, 1), b3 + hstep, voffB);
            PG8_WAIT_V(6); PG8_BAR; PG8_MMA(1, 1, At, B1); PG8_BAR;
            }
        }
        if constexpr (ALIGN_EPI) { if (wr == 0) PG8_BAR; }
        if constexpr (!Epi::AFTER_DRAIN) { E(acc, cur, wr, wc, fr, fq); S.done(cur); }
        if (!has_next) break;
#pragma unroll
        for (int a = 0; a < 2; ++a)
#pragma unroll
            for (int b = 0; b < 2; ++b)
#pragma unroll
                for (int m = 0; m < 4; ++m)
#pragma unroll
                    for (int n = 0; n < 2; ++n) acc[a][b][m][n] = (f32x4){0.f, 0.f, 0.f, 0.f};
        cur = nxt; cA = nA; cB = nB; ++ui;
        if constexpr (ALIGN_EPI) { if (wr == 1) PG8_BAR; }
    }
    PG8_WAIT_V(0);
    if constexpr (!ALIGN_EPI) { if (wr == 0) PG8_BAR; }
    PG8_BAR;
    if constexpr (Epi::AFTER_DRAIN) { E.fused(acc, cur, wr, wc, fr, fq, lds, wid, lane); S.done(cur); }
#undef PG8_SA
#undef PG8_SB
#undef PG8_STAGE
#undef PG8_LDA
#undef PG8_LDB
#undef PG8_MMA
#undef PG8_WAIT_V
#undef PG8_WAIT_L
#undef PG8_BAR
#undef PG8_SCHED
}
}
namespace attn_body {
using bf16=__hip_bfloat16;
using bf16x8=__attribute__((ext_vector_type(8)))short;
using s16x4=__attribute__((ext_vector_type(4)))short;
using f32x16=__attribute__((ext_vector_type(16)))float;
using u32x4=__attribute__((ext_vector_type(4)))unsigned;
constexpr int BATCH=2,NHEAD=8,SEQ=8192,D=64,DM=NHEAD*D,DMO=1024,KVROWS=8320,KVOFF=112,MASKPW=264;
constexpr int NW=8,QBLK=32,QB=QBLK*NW,KVBLK=64,NQB=SEQ/QB;
constexpr int ATTN_UNIT_ROWS=QB;
__device__ __forceinline__ int crow(int r,int hi){return (r&3)+8*(r>>2)+4*hi;}
#define SBAR() __builtin_amdgcn_sched_barrier(0)
__device__ __forceinline__ void cmask(f32x16&p0,f32x16&p1,int jb,int qrel,int hi){
  const float NEG=-INFINITY; int kb=64*jb+4*hi;
  #pragma unroll
  for(int r=0;r<16;++r){int kv=kb+(r&3)+8*(r>>2); if(kv>qrel)p0[r]=NEG; if(kv+32>qrel)p1[r]=NEG;}
}

constexpr int NSLOT=3, SLOTB=8192;
constexpr int LDS_K=0, LDS_V=NSLOT*SLOTB, LDS_WS=2*NSLOT*SLOTB, LDS_OST=LDS_WS+NW*64*4, LDS_BYTES=LDS_OST+NW*4096;
constexpr float C2=0.125f*1.4426950408889634f;
__device__ __forceinline__ void glds16(const void*gsrc,unsigned lds_dst){unsigned keep;
  asm volatile("s_mov_b32 %0, m0\n\ts_mov_b32 m0, %2\n\ts_nop 0\n\tglobal_load_lds_dwordx4 %1, off\n\ts_mov_b32 m0, %0":"=&s"(keep):"v"(gsrc),"s"(lds_dst):"memory");}
__device__ __forceinline__ float max3f(float a,float b,float c){float r;asm("v_max3_f32 %0, %1, %2, %3":"=v"(r):"v"(a),"v"(b),"v"(c));return r;}
__device__ __forceinline__ float max2f(float a,float b){float r;asm("v_max_f32_e32 %0, %1, %2":"=v"(r):"v"(a),"v"(b));return r;}
__device__ __forceinline__ float fadd_s(float a,float b){float r;asm("v_add_f32_e32 %0, %1, %2":"=v"(r):"v"(a),"v"(b));return r;}
__device__ __forceinline__ float fsub_s(float a,float b){float r;asm("v_sub_f32_e32 %0, %1, %2":"=v"(r):"v"(a),"v"(b));return r;}
typedef float f32x2_t __attribute__((ext_vector_type(2))); typedef __bf16 bf16x2_t __attribute__((ext_vector_type(2)));
__device__ __forceinline__ unsigned cvtpk_s(float lo,float hi){f32x2_t v={lo,hi};bf16x2_t b=__builtin_convertvector(v,bf16x2_t);return __builtin_bit_cast(unsigned,b);}
#define WAIT_BAR(N) asm volatile("s_waitcnt vmcnt(" #N ") lgkmcnt(0)\n\ts_barrier":"+v"(mwn)::"memory")

__device__ __forceinline__ void qkt(f32x16&p0,f32x16&p1,const char*Kslot,const bf16x8*qr,const f32x16&negm,int r32,int hi){
  const char*kb=Kslot+hi*1024+r32*16;
  #pragma unroll
  for(int d0=0;d0<4;++d0){
    const bf16x8 b0=*reinterpret_cast<const bf16x8*>(kb+d0*2048);
    const bf16x8 b1=*reinterpret_cast<const bf16x8*>(kb+d0*2048+512);
    if(d0==0){p0=__builtin_amdgcn_mfma_f32_32x32x16_bf16(b0,qr[0],negm,0,0,0);p1=__builtin_amdgcn_mfma_f32_32x32x16_bf16(b1,qr[0],negm,0,0,0);}
    else{p0=__builtin_amdgcn_mfma_f32_32x32x16_bf16(b0,qr[d0],p0,0,0,0);p1=__builtin_amdgcn_mfma_f32_32x32x16_bf16(b1,qr[d0],p1,0,0,0);}}
}
typedef __attribute__((address_space(3))) const char* lds_cptr;
typedef short v4i16_t __attribute__((ext_vector_type(4)));
__device__ __forceinline__ void kload8(bf16x8*kf,lds_cptr kp){
  kf[0]=*(const __attribute__((address_space(3))) bf16x8*)(kp);      kf[1]=*(const __attribute__((address_space(3))) bf16x8*)(kp+512);
  kf[2]=*(const __attribute__((address_space(3))) bf16x8*)(kp+2048); kf[3]=*(const __attribute__((address_space(3))) bf16x8*)(kp+2560);
  kf[4]=*(const __attribute__((address_space(3))) bf16x8*)(kp+4096); kf[5]=*(const __attribute__((address_space(3))) bf16x8*)(kp+4608);
  kf[6]=*(const __attribute__((address_space(3))) bf16x8*)(kp+6144); kf[7]=*(const __attribute__((address_space(3))) bf16x8*)(kp+6656);
}
__device__ __forceinline__ void kload2(bf16x8*kf,lds_cptr kp,int j){ kf[2*j]=*(const __attribute__((address_space(3))) bf16x8*)(kp+j*2048); kf[2*j+1]=*(const __attribute__((address_space(3))) bf16x8*)(kp+j*2048+512); }
__device__ __forceinline__ s16x4 vtr(lds_cptr p){ return __builtin_bit_cast(s16x4,__builtin_amdgcn_ds_read_tr16_b64_v4i16((__attribute__((address_space(3))) v4i16_t*)p)); }
__device__ __forceinline__ float rowmax(const f32x16&p0,const f32x16&p1){
  float a=max3f(p0[0],p0[1],p1[0]),b=max3f(p0[2],p0[3],p1[1]);a=max3f(a,p1[2],p1[3]);
  #pragma unroll
  for(int r=4;r<16;r+=4){a=max3f(a,p0[r],p0[r+1]);b=max3f(b,p0[r+2],p0[r+3]);a=max3f(a,p1[r],p1[r+1]);b=max3f(b,p1[r+2],p1[r+3]);}
  const float m=max2f(a,b);
  auto rr=__builtin_amdgcn_permlane32_swap(__float_as_uint(m),__float_as_uint(m),false,false);
  return max2f(__uint_as_float(rr[0]),__uint_as_float(rr[1]));
}
__device__ __forceinline__ void pv(f32x16*o,int vb,bf16x8 pa0,bf16x8 pa1,bf16x8 pa2,bf16x8 pa3){
  #pragma unroll
  for(int d0=0;d0<2;++d0){s16x4 lo[4],hi[4];
    #pragma unroll
    for(int ks=0;ks<4;++ks){
      asm volatile("ds_read_b64_tr_b16 %0,%1 offset:%c2":"=&v"(lo[ks]):"v"(vb),"i"(d0*4096+ks*1024):"memory");
      asm volatile("ds_read_b64_tr_b16 %0,%1 offset:%c2":"=&v"(hi[ks]):"v"(vb),"i"(d0*4096+ks*1024+512):"memory");}
    asm volatile("s_waitcnt lgkmcnt(0)":::"memory");SBAR();
    #define PK(k) (bf16x8){lo[k][0],lo[k][1],lo[k][2],lo[k][3],hi[k][0],hi[k][1],hi[k][2],hi[k][3]}
    o[d0]=__builtin_amdgcn_mfma_f32_32x32x16_bf16(pa0,PK(0),o[d0],0,0,0);
    o[d0]=__builtin_amdgcn_mfma_f32_32x32x16_bf16(pa1,PK(1),o[d0],0,0,0);
    o[d0]=__builtin_amdgcn_mfma_f32_32x32x16_bf16(pa2,PK(2),o[d0],0,0,0);
    o[d0]=__builtin_amdgcn_mfma_f32_32x32x16_bf16(pa3,PK(3),o[d0],0,0,0);
    #undef PK
  }
}

#ifndef ATTN_STORE16
#define ATTN_STORE16(p,v) (*(u32x4*)(p)=(v))
#endif
template<int THRL> __device__ __forceinline__ void attn_unit(int b,int h,int qb,const bf16*Q,const bf16*__restrict__ K,const bf16*__restrict__ V,bf16*O,const unsigned*__restrict__ MK,char*shm){
  const int tid=threadIdx.x,lane=tid&63,r32=lane&31,hi=lane>>5; const int wid=__builtin_amdgcn_readfirstlane(tid>>6);
  const long rowbase=(long)b*SEQ, kvbase=(long)b*KVROWS; const int q0=qb*QB;
  const bf16*Qw=Q+(rowbase+q0+wid*QBLK)*DM+h*D;
  const bf16*Kh=K+kvbase*DM+h*D,*Vh=V+kvbase*DM+h*D;
  const unsigned lds0=(unsigned)(uintptr_t)shm;
  float*wsf=(float*)(shm+LDS_WS)+wid*64;
  const bf16*ksrc=Kh+(long)lane*DM+wid*8;
  const bf16*vsrc=Vh+(long)(16*(wid&3)+(lane>>2))*DM+(wid>>2)*32+(lane&3)*8;
  const unsigned kdst=lds0+LDS_K+wid*1024, vdst=lds0+LDS_V+wid*1024;
  #define DMA_K(t,slot) glds16(ksrc+(long)(t)*KVBLK*DM,(unsigned)__builtin_amdgcn_readfirstlane(kdst+(slot)))
  #define DMA_V(t,slot) glds16(vsrc+(long)(t)*KVBLK*DM,(unsigned)__builtin_amdgcn_readfirstlane(vdst+(slot)))
  const int vb0=(int)(lds0+LDS_V)+((lane>>4)&1)*32+(lane&3)*8+(4*hi+((lane&15)>>2))*64;
  const char*Kbase=shm+LDS_K; bf16x8 kf[8];
  const lds_cptr shm3=(lds_cptr)shm; const lds_cptr kp0=shm3+LDS_K+hi*1024+r32*16; const lds_cptr vp0=shm3+LDS_V+((lane>>4)&1)*32+(lane&3)*8+(4*hi+((lane&15)>>2))*64;
  const int NT=(q0+QB+128)/KVBLK;
  const unsigned moff=(unsigned)(((rowbase+q0+wid*QBLK+r32)*(long)MASKPW)*4);
  typedef unsigned u32x2_t __attribute__((ext_vector_type(2)));
  u32x2_t mwn,mwc;
  #define MLOAD(t) asm volatile("global_load_dwordx2 %0, %1, %2":"=v"(mwn):"v"(moff+8u*(unsigned)(t)),"s"(MK):"memory")
  #define MROT() do{ mwc.x=mwn.x>>(4*hi); mwc.y=mwn.y>>(4*hi); }while(0)
  MLOAD(0);
  DMA_K(0,0);DMA_V(0,0);DMA_K(1,SLOTB);
  bf16x8 qr[4];
  #pragma unroll
  for(int d0=0;d0<4;++d0)qr[d0]=*reinterpret_cast<const bf16x8*>(&Qw[(long)r32*DM+d0*16+hi*8]);
  float mhat=0.f,l_reg=0.f;f32x16 o[2];o[0]=f32x16{};o[1]=f32x16{};f32x16 negm=f32x16{};asm volatile("":"+v"(negm));
  const int qrel=wid*QBLK+r32;
  #define CMASK(P0,P1,t) do{}while(0)
  bool resc=false;
  #define START(P0,P1) do{ const float rm=rowmax(P0,P1); resc=false; \
    { const float dl=rm; mhat=fadd_s(mhat,dl); \
      _Pragma("unroll") for(int r=0;r<16;++r){P0[r]=fsub_s(P0[r],dl);P1[r]=fsub_s(P1[r],dl);} \
      _Pragma("unroll") for(int r=0;r<16;++r)negm[r]=-mhat; asm volatile("":"+v"(negm)); } \
    _Pragma("unroll") for(int r=0;r<16;++r)P0[r]=__builtin_amdgcn_exp2f(P0[r]); }while(0)
  #define RESC() do{ if(resc){ asm volatile("s_waitcnt lgkmcnt(0)":::"memory"); \
      _Pragma("unroll") for(int d_=0;d_<2;++d_) _Pragma("unroll") for(int r=0;r<16;++r)o[d_][r]*=wsf[crow(r,hi)]; } }while(0)
  f32x16 pA0,pA1,pB0,pB1;
  int sl_prev=0,sl_cur=0,sl_next=SLOTB;
  #define ROT() do{sl_prev=sl_cur;sl_cur=sl_next;sl_next=(sl_next==(NSLOT-1)*SLOTB)?0:sl_next+SLOTB;}while(0)
  DMA_K(2,2*SLOTB);
  WAIT_BAR(3); MROT();
  qkt(pA0,pA1,Kbase,qr,negm,r32,hi);asm volatile("s_nop 15\n\ts_nop 7":"+v"(pA0),"+v"(pA1));CMASK(pA0,pA1,0);
  START(pA0,pA1);
  _Pragma("unroll") for(int r=0;r<16;++r)pA1[r]=__builtin_amdgcn_exp2f(pA1[r]);
  WAIT_BAR(0);
  DMA_K(3,0);DMA_V(1,SLOTB);
  ROT();
  kload8(kf,kp0+sl_cur);
  WAIT_BAR(2);
  s16x4 vlo[8],vhi[8]; u32x4 pw0,pw1,pw2,pw3;
  #define PKW(P,B) cvtpk_s(P[B],P[B+1])
  #define PAF(k) __builtin_bit_cast(bf16x8,pw##k)
  #define VFR(i) (bf16x8){vlo[i][0],vlo[i][1],vlo[i][2],vlo[i][3],vhi[i][0],vhi[i][1],vhi[i][2],vhi[i][3]}
  #define PIN(x) asm volatile("":"+v"(x))
  #define MX3(a,b,c) __builtin_fmaxf(__builtin_fmaxf((a),(b)),(c))
  #define MK(P,W,r) P[r]=__uint_as_float(__float_as_uint(P[r])&(unsigned)__builtin_amdgcn_sbfe((int)(W),((r)&3)+8*((r)>>2),1))
  #define GAPA(MF,M0,M1,M2,M3,A0,A1,A2,A3,W0,W1,PW) do{ MF; M0; M1; M2; M3; sacc+=A0; sacc+=A1; sacc+=A2; sacc+=A3; PIN(sacc); W0; W1; PIN(PW); SBAR(); }while(0)
  #define EX(v) __builtin_amdgcn_exp2f(v)
  #define GAPB(MF,X,B) do{ MF; X[B]=EX(X[B]); X[B+1]=EX(X[B+1]); X[B+2]=EX(X[B+2]); X[B+3]=EX(X[B+3]); PIN(X); SBAR(); }while(0)
  #define VRD(i) do{ vlo[i]=vtr(vp_+(((i)>>2)*4096+((i)&3)*1024)); vhi[i]=vtr(vp_+(((i)>>2)*4096+((i)&3)*1024+512)); }while(0)
  #define KRD(G,j) do{ if(G){ kload2(kf,kp0+sl_next,j); SBAR(); } }while(0)
  #define STEP(C0,C1,P0,P1,t,GK,GV,GL) do{ SBAR(); \
    MLOAD(t); \
    const lds_cptr vp_=vp0+sl_prev; \
    VRD(0); SBAR(); MK(P0,mwc.x,0); MK(P0,mwc.x,1); float sacc=(P0[0]+P0[1]); \
    GAPA(C0=__builtin_amdgcn_mfma_f32_32x32x16_bf16(kf[0],qr[0],negm,0,0,0), MK(P0,mwc.x,2),MK(P0,mwc.x,3),MK(P0,mwc.x,4),MK(P0,mwc.x,5),     P0[2],P0[3],P0[4],P0[5],     pw0[0]=PKW(P0,0), pw0[1]=PKW(P0,2), pw0); \
    VRD(4); SBAR(); GAPA(C1=__builtin_amdgcn_mfma_f32_32x32x16_bf16(kf[1],qr[0],negm,0,0,0), MK(P0,mwc.x,6),MK(P0,mwc.x,7),MK(P0,mwc.x,8),MK(P0,mwc.x,9),     P0[6],P0[7],P0[8],P0[9],     pw0[2]=PKW(P0,4), pw0[3]=PKW(P0,6), pw0); \
    VRD(1); SBAR(); GAPA(C0=__builtin_amdgcn_mfma_f32_32x32x16_bf16(kf[2],qr[1],C0,0,0,0),   MK(P0,mwc.x,10),MK(P0,mwc.x,11),MK(P0,mwc.x,12),MK(P0,mwc.x,13), P0[10],P0[11],P0[12],P0[13], pw1[0]=PKW(P0,8), pw1[1]=PKW(P0,10), pw1); \
    VRD(5); SBAR(); GAPA(C1=__builtin_amdgcn_mfma_f32_32x32x16_bf16(kf[3],qr[1],C1,0,0,0),   MK(P0,mwc.x,14),MK(P0,mwc.x,15),MK(P1,mwc.y,0),MK(P1,mwc.y,1),   P0[14],P0[15],P1[0],P1[1],   pw1[2]=PKW(P0,12),pw1[3]=PKW(P0,14), pw1); \
    VRD(2); SBAR(); GAPA(C0=__builtin_amdgcn_mfma_f32_32x32x16_bf16(kf[4],qr[2],C0,0,0,0),   MK(P1,mwc.y,2),MK(P1,mwc.y,3),MK(P1,mwc.y,4),MK(P1,mwc.y,5),     P1[2],P1[3],P1[4],P1[5],     pw2[0]=PKW(P1,0), pw2[1]=PKW(P1,2), pw2); \
    VRD(6); SBAR(); GAPA(C1=__builtin_amdgcn_mfma_f32_32x32x16_bf16(kf[5],qr[2],C1,0,0,0),   MK(P1,mwc.y,6),MK(P1,mwc.y,7),MK(P1,mwc.y,8),MK(P1,mwc.y,9),     P1[6],P1[7],P1[8],P1[9],     pw2[2]=PKW(P1,4), pw2[3]=PKW(P1,6), pw2); \
    VRD(3); SBAR(); GAPA(C0=__builtin_amdgcn_mfma_f32_32x32x16_bf16(kf[6],qr[3],C0,0,0,0),   MK(P1,mwc.y,10),MK(P1,mwc.y,11),MK(P1,mwc.y,12),MK(P1,mwc.y,13), P1[10],P1[11],P1[12],P1[13], pw3[0]=PKW(P1,8), pw3[1]=PKW(P1,10), pw3); \
    VRD(7); SBAR(); GAPA(C1=__builtin_amdgcn_mfma_f32_32x32x16_bf16(kf[7],qr[3],C1,0,0,0),   MK(P1,mwc.y,14),MK(P1,mwc.y,15),(void)0,(void)0,                P1[14],P1[15],0.f,0.f,       pw3[2]=PKW(P1,12),pw3[3]=PKW(P1,14), pw3); \
    l_reg+=sacc; \
    if(GK){DMA_K((t)+3,sl_cur);} if(GV){DMA_V((t)+1,sl_next);} \
    CMASK(C0,C1,t); \
    { float a=MX3(C0[0],C0[1],C1[0]),b=MX3(C0[2],C0[3],C1[1]); a=MX3(a,C1[2],C1[3]); \
      _Pragma("unroll") for(int r=4;r<16;r+=4){a=MX3(a,C0[r],C0[r+1]);b=MX3(b,C0[r+2],C0[r+3]);a=MX3(a,C1[r],C1[r+1]);b=MX3(b,C1[r+2],C1[r+3]);} \
      float rm=__builtin_fmaxf(a,b); { auto rr=__builtin_amdgcn_permlane32_swap(__float_as_uint(rm),__float_as_uint(rm),false,false); rm=__builtin_fmaxf(__uint_as_float(rr[0]),__uint_as_float(rr[1])); } \
      resc=false; \
      if(__builtin_expect(__any(rm>(float)THRL),0)){ const float dl=__builtin_fmaxf(rm,0.f); mhat+=dl; \
        _Pragma("unroll") for(int r=0;r<16;++r){C0[r]-=dl;C1[r]-=dl;} \
        _Pragma("unroll") for(int r=0;r<16;++r)negm[r]=-mhat; asm volatile("":"+v"(negm)); \
        const float f=__builtin_amdgcn_exp2f(-dl); l_reg*=f; if(hi==0)wsf[r32]=f; resc=true; } } \
    SBAR(); \
    GAPB(o[0]=__builtin_amdgcn_mfma_f32_32x32x16_bf16(PAF(0),VFR(0),o[0],0,0,0), C0,0); \
    GAPB(o[1]=__builtin_amdgcn_mfma_f32_32x32x16_bf16(PAF(0),VFR(4),o[1],0,0,0), C0,4); \
    KRD(GL,0); GAPB(o[0]=__builtin_amdgcn_mfma_f32_32x32x16_bf16(PAF(1),VFR(1),o[0],0,0,0), C0,8); \
    KRD(GL,1); GAPB(o[1]=__builtin_amdgcn_mfma_f32_32x32x16_bf16(PAF(1),VFR(5),o[1],0,0,0), C0,12); \
    KRD(GL,2); GAPB(o[0]=__builtin_amdgcn_mfma_f32_32x32x16_bf16(PAF(2),VFR(2),o[0],0,0,0), C1,0); \
    KRD(GL,3); GAPB(o[1]=__builtin_amdgcn_mfma_f32_32x32x16_bf16(PAF(2),VFR(6),o[1],0,0,0), C1,4); \
    GAPB(o[0]=__builtin_amdgcn_mfma_f32_32x32x16_bf16(PAF(3),VFR(3),o[0],0,0,0), C1,8); \
    GAPB(o[1]=__builtin_amdgcn_mfma_f32_32x32x16_bf16(PAF(3),VFR(7),o[1],0,0,0), C1,12); \
    }while(0)
  int t=1;
  #undef CMASK
  #define CMASK(P0,P1,t) do{}while(0)
  for(;t+5<NT;t+=2){
    STEP(pB0,pB1,pA0,pA1,t,true,true,true);     WAIT_BAR(2); MROT(); RESC(); ROT();
    STEP(pA0,pA1,pB0,pB1,t+1,true,true,true);   WAIT_BAR(2); MROT(); RESC(); ROT();
  }
  #undef CMASK
  #define CMASK(P0,P1,t) do{}while(0)
  #define ENDW(tt) do{ if((tt)+3<NT){WAIT_BAR(2);} else if((tt)+2<NT){WAIT_BAR(1);} else {WAIT_BAR(0);} }while(0)
  for(;t+1<NT;t+=2){
    STEP(pB0,pB1,pA0,pA1,t,(t+3<NT),(t+1<NT),(t+1<NT));       ENDW(t);   MROT(); RESC(); ROT();
    STEP(pA0,pA1,pB0,pB1,t+1,(t+4<NT),(t+2<NT),(t+2<NT));     ENDW(t+1); MROT(); RESC(); ROT();
  }
  STEP(pB0,pB1,pA0,pA1,NT-1,false,false,false); RESC();
  asm volatile("s_waitcnt vmcnt(0)":"+v"(mwn)::"memory"); MROT();
  { _Pragma("unroll") for(int r=0;r<16;++r){ MK(pB0,mwc.x,r); MK(pB1,mwc.y,r); } }
  { float sacc=pB0[0]+pB0[1]; _Pragma("unroll") for(int r=2;r<16;++r)sacc+=pB0[r]; _Pragma("unroll") for(int r=0;r<16;++r)sacc+=pB1[r]; l_reg+=sacc;
    pw0=(u32x4){PKW(pB0,0),PKW(pB0,2),PKW(pB0,4),PKW(pB0,6)};pw1=(u32x4){PKW(pB0,8),PKW(pB0,10),PKW(pB0,12),PKW(pB0,14)};pw2=(u32x4){PKW(pB1,0),PKW(pB1,2),PKW(pB1,4),PKW(pB1,6)};pw3=(u32x4){PKW(pB1,8),PKW(pB1,10),PKW(pB1,12),PKW(pB1,14)};
    SBAR(); pv(o,vb0+sl_cur,PAF(0),PAF(1),PAF(2),PAF(3)); }
  #undef PKW
  #undef PAF
  #undef VFR
  #undef PIN
  #undef MX3
  #undef GAPA
  #undef MK
  #undef GAPB
  #undef EX
  #undef VRD
  #undef KRD
  #undef STEP
  #undef ENDW
  {auto rr=__builtin_amdgcn_permlane32_swap(__float_as_uint(l_reg),__float_as_uint(l_reg),false,false);l_reg=__uint_as_float(rr[0])+__uint_as_float(rr[1]);}
  if(hi==0)wsf[32+r32]=l_reg;asm volatile("s_waitcnt lgkmcnt(0)":::"memory");
  float rli[16];
  #pragma unroll
  for(int r=0;r<16;++r)rli[r]=__builtin_amdgcn_rcpf(wsf[32+crow(r,hi)]);
  bf16*Ow=O+(rowbase+q0+wid*QBLK)*DMO+h*D;
  { bf16*stg=(bf16*)(shm+LDS_OST)+wid*2048;
    #pragma unroll
    for(int r=0;r<16;++r){const int orow=crow(r,hi);
      #pragma unroll
      for(int d0=0;d0<2;++d0)stg[orow*64+d0*32+r32]=__float2bfloat16(o[d0][r]*rli[r]);}
    asm volatile("s_waitcnt lgkmcnt(0)":::"memory");
    #pragma unroll
    for(int i=0;i<4;++i){const int row=i*8+(lane>>3),ch=lane&7; const u32x4 v=*(const u32x4*)(stg+row*64+ch*8); ATTN_STORE16(Ow+(long)row*DMO+ch*8,v);} }
  asm volatile("s_waitcnt lgkmcnt(0)\n\ts_barrier":::"memory");
  #undef MLOAD
  #undef MROT
  #undef DMA_K
  #undef DMA_V
  #undef CMASK
  #undef START
  #undef RESC
  #undef ROT
}
constexpr int ATTN_LDS_BYTES=LDS_BYTES;
struct AttnTensors { const bf16* Q; const bf16* K; const bf16* V; bf16* O; const unsigned* MK; };
struct AttnUnit { int bh; int qb; };
struct StaticOrder {
  int vcu, grid;
  __device__ __forceinline__ explicit StaticOrder(int grid_,int block):vcu((grid_%8==0)?(block%8)*(grid_/8)+block/8:block),grid(grid_){}
  __device__ __forceinline__ bool next(int i,AttnUnit&u)const{ const int L=i*grid+vcu; if(L>=512)return false; const int pr=L>>1;
    if(grid==256){ if(i>=2)return false; const int s=vcu&15; u.bh=vcu>>4; u.qb=(i==0)?s:31-s; return true; }
    u.bh=L>>5; u.qb=L&31; (void)pr; return true; }
  __device__ __forceinline__ void a_ready(const AttnUnit&)const{}
  __device__ __forceinline__ void done(const AttnUnit&)const{}
};
template<class Sched,int THRL=8> __device__ __forceinline__ void attn_phase(char*lds,const AttnTensors&T,const Sched&S){
  AttnUnit u;
  for(int i=0;S.next(i,u);++i){ S.a_ready(u); attn_unit<THRL>(u.bh/NHEAD,u.bh%NHEAD,u.qb,T.Q,T.K,T.V,T.O,T.MK,lds); S.done(u); }
}
#undef SBAR
#undef WAIT_BAR
}

typedef _Float16 f16;
__device__ __forceinline__ unsigned short f2h(float f) { const f16 h = (f16)f; return __builtin_bit_cast(unsigned short, h); }
__device__ __forceinline__ float h2f(unsigned short u) { return (float)__builtin_bit_cast(f16, u); }
__device__ __forceinline__ float bflo(unsigned p) { return __uint_as_float(p << 16); }
__device__ __forceinline__ float bfhi(unsigned p) { return __uint_as_float(p & 0xffff0000u); }
constexpr float C2 = 0.125f * 1.4426950408889634f;
constexpr int KIW = 72;
constexpr int MPW = 264;
constexpr int KVROWS = 8320, KVOFF = 112;

struct EpiF32 {
  static constexpr bool PERM = false, AFTER_DRAIN = false;
  float* C; int ldc, Mreal, Nreal;
  __device__ __forceinline__ void operator()(const pg8::f32x4 (&acc)[2][2][4][2], const pg8::Unit& u, int wr, int wc, int fr, int fq) const {
#pragma unroll
    for (int ai = 0; ai < 2; ++ai)
#pragma unroll
      for (int m = 0; m < 4; ++m) {
        const int r = u.pm * 256 + ai * 128 + wr * 64 + m * 16 + fr;
        if (r >= Mreal) continue;
#pragma unroll
        for (int bj = 0; bj < 2; ++bj)
#pragma unroll
          for (int n = 0; n < 2; ++n) {
            const int c = u.pn * 256 + bj * 128 + wc * 32 + n * 16 + 4 * fq;
            if (c < Nreal) *(pg8::f32x4*)(C + (size_t)r * ldc + c) = acc[ai][bj][m][n];
          }
      }
  }
};

struct EpiInProj {
  static constexpr bool PERM = false, AFTER_DRAIN = false;
  bf16_t* ub; bf16_t* qkvq; size_t kstride; float* kiw; const float* ropetab;
  __device__ __forceinline__ void operator()(const pg8::f32x4 (&acc)[2][2][4][2], const pg8::Unit& u, int wr, int wc, int fr, int fq) const {
    const int pn = u.pn;
#pragma unroll
    for (int ai = 0; ai < 2; ++ai)
#pragma unroll
      for (int m = 0; m < 4; ++m) {
        const int r = u.pm * 256 + ai * 128 + wr * 64 + m * 16 + fr;
        const bool rok = r < NROWS;
        int t = r < NR ? (r & (SEQ - 1)) + NMETA : ((r - NR) & 15);
        if (!rok) t = 0;
        if (pn < 4) {
#pragma unroll
          for (int n = 0; n < 2; ++n) {
            const pg8::f32x4 av = acc[ai][0][m][n], gv = acc[ai][1][m][n];
            float o[4];
#pragma unroll
            for (int j = 0; j < 4; ++j) o[j] = av[j] / (1.0f + __expf(-gv[j]));
            const int col = pn * 128 + wc * 32 + n * 16 + 4 * fq;
            if (rok) *(uint2*)(ub + (size_t)r * 512 + col) = make_uint2(pk2(o[0], o[1]), pk2(o[2], o[3]));
          }
        } else if (pn < 12) {
          const int kind = (pn - 4) >> 1, cbase = ((pn - 4) & 1) * 256;
#pragma unroll
          for (int bj = 0; bj < 2; ++bj)
#pragma unroll
            for (int n = 0; n < 2; ++n) {
              pg8::f32x4 v = acc[ai][bj][m][n];
              if (n == 0 && kind != 2 && (wc & 1) == 0) {
                const pg8::f32x4 cs = *(const pg8::f32x4*)(ropetab + t * 16 + 4 * (fq & 1)), sn = *(const pg8::f32x4*)(ropetab + t * 16 + 8 + 4 * (fq & 1));
#pragma unroll
                for (int j = 0; j < 4; ++j) { const float p = __shfl_xor(v[j], 32); v[j] = fq < 2 ? v[j] * cs[j] - p * sn[j] : v[j] * cs[j] + p * sn[j]; }
              }
              const int col = cbase + bj * 128 + wc * 32 + n * 16 + 4 * fq;
              const int bb = r < NR ? (r >> 13) : ((r - NR) >> 4);
              const size_t drow = (kind == 1 || kind == 2) ? (size_t)bb * KVROWS + KVOFF + t : (size_t)r;
              bf16_t* dst = qkvq + (size_t)kind * kstride + drow * 512 + col;
              if (kind == 3) {
                if (rok) *(uint2*)dst = make_uint2((unsigned)f2h(v[0]) | ((unsigned)f2h(v[1]) << 16), (unsigned)f2h(v[2]) | ((unsigned)f2h(v[3]) << 16));
              } else {
                if (kind == 0) v = v * C2;
                if (rok) *(uint2*)dst = make_uint2(pk2(v[0], v[1]), pk2(v[2], v[3]));
              }
            }
        } else {
#pragma unroll
          for (int n = 0; n < 2; ++n) {
            const int col = wc * 32 + n * 16 + 4 * fq;
            if (rok && col < KIW) *(pg8::f32x4*)(kiw + (size_t)r * KIW + col) = acc[ai][0][m][n];
          }
        }
      }
  }
};

__device__ __forceinline__ void transpose_item(const float* __restrict__ W, int K, int N, bf16_t* __restrict__ WT, int ldt, float* scr, int k0, int n0, int drow0, int lane) {
#pragma unroll 8
  for (int i = 0; i < 32; ++i) { const int kk = 2 * i + (lane >> 5), n = n0 + (lane & 31); scr[kk * 33 + (lane & 31)] = n < N ? W[(size_t)(k0 + kk) * N + n] : 0.f; }
  asm volatile("s_waitcnt lgkmcnt(0)" ::: "memory");
  const int c = lane & 7;
#pragma unroll
  for (int j = 0; j < 4; ++j) { const int n = (lane >> 3) + 8 * j; const float* p = scr + (8 * c) * 33 + n;
    uint4 o; o.x = pk2(p[0 * 33], p[1 * 33]); o.y = pk2(p[2 * 33], p[3 * 33]); o.z = pk2(p[4 * 33], p[5 * 33]); o.w = pk2(p[6 * 33], p[7 * 33]);
    *(uint4*)(WT + (size_t)(drow0 + n) * ldt + k0 + 8 * c) = o; }
  asm volatile("s_waitcnt lgkmcnt(0)" ::: "memory");
}
__device__ __forceinline__ int winT_row(int c) {
  if (c < 512) return (c >> 7) * 256 + (c & 127);
  if (c < 1024) return ((c - 512) >> 7) * 256 + 128 + ((c - 512) & 127);
  return c;
}

struct XUnit { int pm, pn, e; };
template <class Epi, class Sched, bool GATHER, int K, unsigned apitch>
__device__ __forceinline__ void gemm_phase_x(PG8_LAS unsigned char* lds, const bf16_t* Abase, const Sched& S, const Epi& E) {
  using namespace pg8;
  int tid = threadIdx.x; asm volatile("" : "+v"(tid));
  const int wid = __builtin_amdgcn_readfirstlane(tid >> 6), lane = tid & 63, wr = wid >> 2, wc = wid & 3, fr = lane & 15, fq = lane >> 4;
  constexpr int nt = K / BK;
  unsigned voffB[2], vAc[2][2], vAn[2][2]; int Rl[2]; unsigned cOff[2];
#pragma unroll
  for (int i = 0; i < 2; ++i) { int R, C; stage_rc(tid * 16 + i * 8192, R, C); Rl[i] = R; cOff[i] = (unsigned)C * 2u; const int Rb = Epi::PERM ? ((R & ~31) + perm32(R & 31)) : R; voffB[i] = (unsigned)(Rb * K + C) * 2u; }
  constexpr size_t kstep = (size_t)(BK * 2), hstepB = (size_t)HALF * K * 2;
  const unsigned ldsw = (unsigned)wid * 1024u;
  const int aoff = lds_byte(wr * 64 + fr, fq * 8), boff = lds_byte(wc * 32 + fr, fq * 8);
#define X_SA(b, h) (((b) * 2 + (h)) * HTB)
#define X_SB(b, h) ((4 + (b) * 2 + (h)) * HTB)
#define X_STAGE(bufoff, gbase, voff) do { _Pragma("unroll") for (int _i = 0; _i < 2; ++_i) \
        __builtin_amdgcn_global_load_lds((const unsigned*)((const char*)(gbase) + (voff)[_i]), (PG8_LAS unsigned*)(lds + (bufoff) + ldsw + _i * 8192), 16, 0, 0); } while (0)
#define X_LDA(dst, b, h) do { _Pragma("unroll") for (int m = 0; m < 4; ++m) _Pragma("unroll") for (int k = 0; k < 2; ++k) dst[m][k] = *(const PG8_LAS bf16x8*)(lds + X_SA(b, h) + aoff + m * 2048 + k * 1024); } while (0)
#define X_LDB(dst, b, h) do { _Pragma("unroll") for (int n = 0; n < 2; ++n) _Pragma("unroll") for (int k = 0; k < 2; ++k) dst[n][k] = *(const PG8_LAS bf16x8*)(lds + X_SB(b, h) + boff + n * 2048 + k * 1024); } while (0)
#define X_MMA(ai, bj, At, Bt) do { __builtin_amdgcn_s_setprio(1); _Pragma("unroll") for (int m = 0; m < 4; ++m) _Pragma("unroll") for (int n = 0; n < 2; ++n) _Pragma("unroll") for (int k = 0; k < 2; ++k) \
        acc[ai][bj][m][n] = __builtin_amdgcn_mfma_f32_16x16x32_bf16(Bt[n][k], At[m][k], acc[ai][bj][m][n], 0, 0, 0); __builtin_amdgcn_s_setprio(0); } while (0)
#define X_WAIT_V(n) asm volatile("s_waitcnt vmcnt(" #n ")" ::: "memory")
#define X_WAIT_L(n) asm volatile("s_waitcnt lgkmcnt(" #n ")" ::: "memory")
#define X_BAR __builtin_amdgcn_s_barrier()
#define X_SCHED __builtin_amdgcn_sched_barrier(0)
#define X_SETV(dst, u) do { if constexpr (GATHER) { const int* rw_ = S.rows(u); _Pragma("unroll") for (int h = 0; h < 2; ++h) _Pragma("unroll") for (int i = 0; i < 2; ++i) dst[h][i] = (unsigned)rw_[h * HALF + Rl[i]] * apitch + cOff[i]; } \
        else { _Pragma("unroll") for (int h = 0; h < 2; ++h) _Pragma("unroll") for (int i = 0; i < 2; ++i) dst[h][i] = (unsigned)(h * HALF + Rl[i]) * apitch + cOff[i]; } } while (0)
  XUnit cur, nxt; int ui = 0;
  if (!S.next(0, cur)) return;
  f32x4 acc[2][2][4][2];
#pragma unroll
  for (int a = 0; a < 2; ++a)
#pragma unroll
    for (int b = 0; b < 2; ++b)
#pragma unroll
      for (int m = 0; m < 4; ++m)
#pragma unroll
        for (int n = 0; n < 2; ++n) acc[a][b][m][n] = (f32x4){0.f, 0.f, 0.f, 0.f};
  bf16x8 At[4][2], B0[2][2], B1[2][2];
  const char* cA = GATHER ? (const char*)Abase : (const char*)S.a_ptr(cur); const char* cB = (const char*)S.b_ptr(cur);
  X_SETV(vAc, cur);
  X_STAGE(X_SB(0, 0), cB, voffB); X_STAGE(X_SB(0, 1), cB + hstepB, voffB); X_STAGE(X_SA(0, 0), cA, vAc[0]); X_STAGE(X_SA(0, 1), cA, vAc[1]);
  if (wr == 1) X_BAR;
  X_WAIT_V(2); X_BAR;
  X_STAGE(X_SB(1, 0), cB + kstep, voffB); X_STAGE(X_SA(1, 0), cA + kstep, vAc[0]); X_STAGE(X_SB(1, 1), cB + hstepB + kstep, voffB);
  X_WAIT_V(6); X_BAR;
  for (;;) {
    const bool has_next = S.next(ui + 1, nxt);
    const char* nA = has_next ? (GATHER ? (const char*)Abase : (const char*)S.a_ptr(nxt)) : cA; const char* nB = has_next ? (const char*)S.b_ptr(nxt) : cB;
    if (has_next) { X_SETV(vAn, nxt); } else {
#pragma unroll
      for (int h = 0; h < 2; ++h)
#pragma unroll
        for (int i = 0; i < 2; ++i) vAn[h][i] = vAc[h][i]; }
#pragma unroll 1
    for (int t = 0; t < nt; t += 2) {
      const bool last = (t == nt - 2);
      const char* a1 = cA + (size_t)(t + 1) * kstep;
      const char* a2 = last ? nA : cA + (size_t)(t + 2) * kstep; const char* b2 = last ? nB : cB + (size_t)(t + 2) * kstep;
      const char* a3 = a2 + kstep; const char* b3 = b2 + kstep;
      unsigned v0[2], v1[2];
#pragma unroll
      for (int i = 0; i < 2; ++i) { v0[i] = last ? vAn[0][i] : vAc[0][i]; v1[i] = last ? vAn[1][i] : vAc[1][i]; }
      X_LDB(B0, 0, 0); X_LDB(B1, 0, 1); X_SCHED; X_LDA(At, 0, 0); X_STAGE(X_SA(1, 1), a1, vAc[1]);
      X_WAIT_V(8); X_WAIT_L(0); X_BAR; X_MMA(0, 0, At, B0); X_MMA(0, 1, At, B1); X_BAR; X_SCHED;
      X_LDA(At, 0, 1); X_STAGE(X_SB(0, 0), b2, voffB); X_STAGE(X_SB(0, 1), b2 + hstepB, voffB); X_STAGE(X_SA(0, 0), a2, v0);
      X_WAIT_V(8); X_WAIT_L(0); X_BAR; X_MMA(1, 0, At, B0); X_MMA(1, 1, At, B1); X_BAR; X_SCHED;
      X_LDB(B0, 1, 0); X_LDB(B1, 1, 1); X_SCHED; X_LDA(At, 1, 0); X_STAGE(X_SA(0, 1), a2, v1);
      X_WAIT_V(8); X_WAIT_L(0); X_BAR; X_MMA(0, 0, At, B0); X_MMA(0, 1, At, B1); X_BAR; X_SCHED;
      X_LDA(At, 1, 1); X_STAGE(X_SB(1, 0), b3, voffB); X_STAGE(X_SB(1, 1), b3 + hstepB, voffB); X_STAGE(X_SA(1, 0), a3, v0);
      X_WAIT_V(8); X_WAIT_L(0); X_BAR; X_MMA(1, 0, At, B0); X_MMA(1, 1, At, B1); X_BAR; X_SCHED;
    }
    if (wr == 0) X_BAR;
    E(acc, cur, wr, wc, fr, fq);
    if (!has_next) break;
#pragma unroll
    for (int a = 0; a < 2; ++a)
#pragma unroll
      for (int b = 0; b < 2; ++b)
#pragma unroll
        for (int m = 0; m < 4; ++m)
#pragma unroll
          for (int n = 0; n < 2; ++n) acc[a][b][m][n] = (f32x4){0.f, 0.f, 0.f, 0.f};
    cur = nxt; cA = nA; cB = nB; ++ui;
#pragma unroll
    for (int h = 0; h < 2; ++h)
#pragma unroll
      for (int i = 0; i < 2; ++i) vAc[h][i] = vAn[h][i];
    if (wr == 1) X_BAR;
  }
  X_WAIT_V(0);
  X_BAR;
#undef X_SA
#undef X_SB
#undef X_STAGE
#undef X_LDA
#undef X_LDB
#undef X_MMA
#undef X_WAIT_V
#undef X_WAIT_L
#undef X_BAR
#undef X_SCHED
#undef X_SETV
}

constexpr int MOE_MAXT = 131072 / 256 + 64;
constexpr size_t wl_al(size_t x) { return (x + 255) & ~(size_t)255; }
struct WL {
  static constexpr int NSLOT = (MOE_MAXT + 64) * 256;
  static constexpr int NSLOT_R = MOE_MAXT * 256;
  static constexpr size_t WGU_E = (size_t)512 * D, WD_E = (size_t)D * DE;
  static constexpr size_t KSTRIDE = (size_t)16640 * 512;
  static constexpr size_t o_ropetab = 65536;
  static constexpr size_t o_st0 = o_ropetab + wl_al((size_t)TP * 16 * 4);
  static constexpr size_t o_ridx = o_st0 + wl_al((size_t)NROWS * 8);
  static constexpr size_t o_rw = o_ridx + wl_al((size_t)NR * TOPE * 4);
  static constexpr size_t o_slotof = o_rw + wl_al((size_t)NR * TOPE * 4);
  static constexpr size_t o_tokmap = o_slotof + wl_al((size_t)NR * TOPE * 4);
  static constexpr size_t o_wslot = o_tokmap + wl_al((size_t)NSLOT * 4);
  static constexpr size_t o_WdT = o_wslot + wl_al((size_t)NSLOT * 4);
  static constexpr size_t o_zone = o_WdT + wl_al((size_t)(NE + 1) * WD_E * 2);
  static constexpr size_t o_maskb = o_zone;
  static constexpr size_t o_WinT = o_maskb + wl_al((size_t)NR * MPW * 4);
  static constexpr size_t o_WoutT = o_WinT + wl_al((size_t)3328 * D * 2);
  static constexpr size_t o_regionE = o_WoutT + wl_al((size_t)D * D * 2);
  static constexpr size_t o_kiF = o_regionE + wl_al((size_t)(NE + 1) * WGU_E * 2);
  static constexpr size_t o_qlin = o_kiF + wl_al((size_t)NROWS * 64 * 2);
  static constexpr size_t o_wq = o_qlin + wl_al((size_t)NR * 64 * 2);
  static constexpr size_t o_zone_used = o_wq + wl_al((size_t)NR * 8 * 4);
  static constexpr size_t o_ub = (o_zone_used > o_zone + (size_t)NSLOT_R * D ? o_zone_used : o_zone + wl_al((size_t)NSLOT_R * D));
  static constexpr size_t o_qb = o_ub + wl_al((size_t)NROWS * 512 * 2);
  static constexpr size_t o_kiw = o_qb + wl_al(KSTRIDE * 2 * 4);
  static constexpr size_t o_end = o_kiw + wl_al((size_t)NROWS * KIW * 4);
};
static_assert(WL::o_end <= (size_t)289000000, "workspace budget");
static_assert((size_t)WL::NSLOT * 256 * 2 <= WL::o_end - WL::o_ub && (size_t)NR * D * 4 <= WL::o_end - WL::o_ub && WL::o_zone_used <= WL::o_ub, "overlays fit");
template <int NN, int K, size_t BOFF, size_t BSTRIDE_B, size_t AOFF, int E_LO, int E_HI>
struct MoeSched {
  const unsigned char* ws; const int* tstart; int G, c;
  __device__ __forceinline__ bool next(int i, XUnit& u) const {
    const int L = i * G + c + __builtin_amdgcn_readfirstlane(tstart[E_LO]) * NN, total = __builtin_amdgcn_readfirstlane(tstart[E_HI]) * NN; if (L >= total) return false;
    int e = E_LO;
#pragma unroll 1
    while (tstart[e + 1] * NN <= L) ++e;
    const int ne = tstart[e + 1] - tstart[e], r = L - tstart[e] * NN;
    u.e = __builtin_amdgcn_readfirstlane(e); u.pn = __builtin_amdgcn_readfirstlane(r / ne); u.pm = __builtin_amdgcn_readfirstlane(tstart[e] + r % ne); return true;
  }
  __device__ __forceinline__ const bf16_t* b_ptr(const XUnit& u) const { return (const bf16_t*)(ws + BOFF + (size_t)u.e * BSTRIDE_B) + (size_t)u.pn * 256 * K; }
  __device__ __forceinline__ const bf16_t* a_ptr(const XUnit& u) const { return (const bf16_t*)(ws + AOFF) + (size_t)u.pm * 256 * K; }
  __device__ __forceinline__ const int* rows(const XUnit& u) const { return (const int*)(ws + WL::o_tokmap) + u.pm * 256; }
};
struct EpiGateUp {
  static constexpr bool PERM = false;
  unsigned char* ws;
  __device__ __forceinline__ void operator()(const pg8::f32x4 (&acc)[2][2][4][2], const XUnit& u, int wr, int wc, int fr, int fq) const {
#pragma unroll
    for (int ai = 0; ai < 2; ++ai)
#pragma unroll
      for (int m = 0; m < 4; ++m) {
        const size_t slot = (size_t)u.pm * 256 + ai * 128 + wr * 64 + m * 16 + fr;
#pragma unroll
        for (int n = 0; n < 2; ++n) {
          const pg8::f32x4 g = acc[ai][0][m][n], up = acc[ai][1][m][n]; float o[4];
#pragma unroll
          for (int j = 0; j < 4; ++j) o[j] = g[j] / (1.0f + __expf(-g[j])) * up[j];
          *(uint2*)((bf16_t*)(ws + WL::o_ub) + slot * DE + u.pn * 128 + wc * 32 + n * 16 + 4 * fq) = make_uint2(pk2(o[0], o[1]), pk2(o[2], o[3]));
        }
      }
  }
};
constexpr float YSCALE = 64.0f;
constexpr int H1P = 2 * D;
struct EpiDownY {
  static constexpr bool PERM = true;
  unsigned char* ws;
  __device__ __forceinline__ void operator()(const pg8::f32x4 (&acc)[2][2][4][2], const XUnit& u, int wr, int wc, int fr, int fq) const {
#pragma unroll
    for (int ai = 0; ai < 2; ++ai)
#pragma unroll
      for (int m = 0; m < 4; ++m) {
        const int slot = u.pm * 256 + ai * 128 + wr * 64 + m * 16 + fr;
        const int col = u.pn * 256 + wc * 32 + 8 * fq;
        const float w = ((const float*)(ws + WL::o_wslot))[slot] * YSCALE;
#pragma unroll
        for (int bj = 0; bj < 2; ++bj) {
          const pg8::f32x4 v0 = acc[ai][bj][m][0] * w, v1 = acc[ai][bj][m][1] * w;
          int lo = 0, hi = 0;
          lo = __builtin_amdgcn_cvt_pk_fp8_f32(v0[0], v0[1], lo, false); lo = __builtin_amdgcn_cvt_pk_fp8_f32(v0[2], v0[3], lo, true);
          hi = __builtin_amdgcn_cvt_pk_fp8_f32(v1[0], v1[1], hi, false); hi = __builtin_amdgcn_cvt_pk_fp8_f32(v1[2], v1[3], hi, true);
          *(uint2*)(ws + WL::o_zone + (size_t)slot * D + col + bj * 128) = make_uint2((unsigned)lo, (unsigned)hi);
        }
      }
  }
};
struct EpiDownS {
  static constexpr bool PERM = true;
  bf16_t* orow; int tile0;
  __device__ __forceinline__ void operator()(const pg8::f32x4 (&acc)[2][2][4][2], const XUnit& u, int wr, int wc, int fr, int fq) const {
#pragma unroll
    for (int ai = 0; ai < 2; ++ai)
#pragma unroll
      for (int m = 0; m < 4; ++m) {
        const int tok = (u.pm - tile0) * 256 + ai * 128 + wr * 64 + m * 16 + fr;
        bf16_t* dst = orow + (size_t)tok * H1P + D + u.pn * 256 + wc * 32 + 8 * fq;
#pragma unroll
        for (int bj = 0; bj < 2; ++bj) {
          const pg8::f32x4 v0 = acc[ai][bj][m][0], v1 = acc[ai][bj][m][1];
          *(uint4*)(dst + bj * 128) = make_uint4(pk2(v0[0], v0[1]), pk2(v0[2], v0[3]), pk2(v1[0], v1[1]), pk2(v1[2], v1[3]));
        }
      }
  }
};

typedef _Float16 f16x8 __attribute__((ext_vector_type(8)));
__device__ __forceinline__ void pk_cnt_gt(unsigned& acc, unsigned x, unsigned tm1, unsigned ones) {
  unsigned d;
  asm("v_pk_sub_u16 %0, %2, %3 clamp\n\tv_pk_min_u16 %0, %0, %4\n\tv_pk_add_u16 %1, %1, %0" : "=&v"(d), "+v"(acc) : "v"(x), "v"(tm1), "s"(ones));
}

constexpr int NTHR = 512, NWAVES = 8;
constexpr int LDS_BYTES = 147456;
constexpr int MISC_OFF = 131072 + 8192;
constexpr size_t CTL_BYTES = 65536;

struct Args {
  const float *x, *meta, *ln_emb_g, *ln_emb_b, *w_in, *conv_w, *conv_b, *lnc_g, *lnc_b, *lnk_g, *lnk_b, *w_out, *ln1_g, *ln1_b, *w_router, *r_bias,
              *w_gate, *w_up, *w_down, *ws_gate, *ws_up, *ws_down, *ln2_g, *ln2_b;
  float* out; unsigned char* ws;
  float ropeinv[8];
};

__device__ __forceinline__ unsigned fkey(float f) { unsigned u = __float_as_uint(f); return (u & 0x80000000u) ? ~u : (u | 0x80000000u); }

__global__ void __launch_bounds__(NTHR, 2) mega_fwd(Args a) {
  extern __shared__ __attribute__((aligned(16))) unsigned char lds_raw[];
  float* lds = (float*)lds_raw;
  const int G = gridDim.x, bid = blockIdx.x, NGW = G * NWAVES;
#define tst ((int*)(lds_raw + MISC_OFF + 256))
#define PHASE_IDS int tid = threadIdx.x; asm volatile("" : "+v"(tid)); const int lane = tid & 63, wave = tid >> 6, gw = bid * NWAVES + wave; (void)lane; (void)wave; (void)gw;
#define WSP(T, O) ((T*)(a.ws + (O)))
#define barw    WSP(unsigned, 0)
#define ecnt    WSP(int, 16384)
#define ecur    WSP(int, 16384 + 256)
#define ropetab WSP(float, WL::o_ropetab)
#define st0     WSP(float2, WL::o_st0)
#define maskb   WSP(unsigned, WL::o_maskb)
#define ridx    WSP(int, WL::o_ridx)
#define rw      WSP(float, WL::o_rw)
#define slotof  WSP(int, WL::o_slotof)
#define tokmap  WSP(int, WL::o_tokmap)
#define wslot   WSP(float, WL::o_wslot)
#define WinT    WSP(bf16_t, WL::o_WinT)
#define WoutT   WSP(bf16_t, WL::o_WoutT)
#define h0b     WSP(bf16_t, WL::o_regionE)
#define mixb    WSP(bf16_t, WL::o_regionE)
#define WguT    WSP(bf16_t, WL::o_regionE)
#define WdT     WSP(bf16_t, WL::o_WdT)
#define y8      WSP(unsigned char, WL::o_zone)
#define kiF     WSP(unsigned short, WL::o_kiF)
#define qlin    WSP(unsigned short, WL::o_qlin)
#define wq      WSP(float, WL::o_wq)
#define h1b     ((bf16_t*)a.out)
#define ub      WSP(bf16_t, WL::o_ub)
#define qb      WSP(bf16_t, WL::o_qb)
#define kb      WSP(bf16_t, WL::o_qb + WL::KSTRIDE * 2)
#define vb      WSP(bf16_t, WL::o_qb + WL::KSTRIDE * 4)
#define qih     WSP(unsigned short, WL::o_qb + WL::KSTRIDE * 6)
#define kiw     WSP(float, WL::o_kiw)
#define tmp     WSP(float, WL::o_ub)
#define hdn     WSP(bf16_t, WL::o_ub)
  constexpr size_t WGU_E = WL::WGU_E, WD_E = WL::WD_E, KSTRIDE = WL::KSTRIDE;
  float* const out = a.out;

  volatile LAS unsigned* misc = (volatile LAS unsigned*)((LAS unsigned char*)lds_raw + MISC_OFF);
  if (threadIdx.x < 16) misc[threadIdx.x] = 0u;
  __syncthreads();
  XcdBarrier bar = xcd_barrier_post(barw, misc);

  { PHASE_IDS
  {
    for (int i = bid * NTHR + tid; i < TP * 8; i += G * NTHR) {
      const int t = i >> 3, j = i & 7; float sn, cs; sincosf((float)t * a.ropeinv[j], &sn, &cs);
      ropetab[t * 16 + j] = cs; ropetab[t * 16 + 8 + j] = sn;
    }
    for (int i = bid * NTHR + tid; i < 2 * 2 * KVOFF * 64; i += G * NTHR) {
      const int c16 = i & 63, rr = (i >> 6) % KVOFF, bb = ((i >> 6) / KVOFF) & 1, kv = (i >> 6) / (2 * KVOFF);
      *(uint4*)((kv ? vb : kb) + ((size_t)bb * KVROWS + rr) * 512 + c16 * 8) = make_uint4(0u, 0u, 0u, 0u);
    }
    for (int m = gw; m < NROWS; m += NGW) {
      const float* src = m < NR ? a.x + (size_t)m * D : a.meta + (size_t)((m - NR) & 15) * D;
      float v[16]; float s = 0.f;
#pragma unroll
      for (int i = 0; i < 16; ++i) { v[i] = src[i * 64 + lane]; s += v[i]; }
      const float mu = wave_sum(s) * (1.0f / D);
      float q = 0.f;
#pragma unroll
      for (int i = 0; i < 16; ++i) { const float d = v[i] - mu; q += d * d; }
      const float rstd = rsqrtf(wave_sum(q) * (1.0f / D) + LN_EPS);
#pragma unroll
      for (int i = 0; i < 16; ++i) { const int c = i * 64 + lane; h0b[(size_t)m * D + c] = (bf16_t)f2bf((v[i] - mu) * rstd * a.ln_emb_g[c] + a.ln_emb_b[c]); }
      if (lane == 0) st0[m] = make_float2(mu, rstd);
    }
    {
      float* scr = lds + wave * 2304;
      constexpr int NB_IN = (IN_W + 31) / 32, I_IN = (D / 64) * NB_IN, I_OUT = (D / 64) * (D / 32);
      for (int it = gw; it < I_IN + I_OUT; it += NGW) {
        if (it < I_IN) { const int kb_ = it / NB_IN, nb = it % NB_IN; transpose_item(a.w_in, D, IN_W, WinT, D, scr, 64 * kb_, 32 * nb, winT_row(32 * nb), lane); }
        else { const int r = it - I_IN, kb_ = r / (D / 32), nb = r % (D / 32); transpose_item(a.w_out, D, D, WoutT, D, scr, 64 * kb_, 32 * nb, 32 * nb, lane); }
      }
    }
  }
  }
  xcd_barrier(bar);
  { PHASE_IDS
  {
    pg8::Gemm g{h0b, WinT, 16640, 3328, D}; pg8::StaticOrder S; S.init(16640, 3328, G, bid);
    EpiInProj E{ub, qb, KSTRIDE, kiw, ropetab};
    pg8::gemm_phase<EpiInProj, pg8::StaticOrder, true, true>((PG8_LAS unsigned char*)lds_raw, g, S, E);
  }
  }
  xcd_barrier(bar);
  { PHASE_IDS
  for (int m = gw; m < NROWS; m += NGW) {
    const int t = m < NR ? (m & (SEQ - 1)) + NMETA : ((m - NR) & 15);
    const float xk = kiw[(size_t)m * KIW + lane];
    const float mu = wave_sum(xk) * (1.0f / IDD), dv = xk - mu;
    const float rstd = rsqrtf(wave_sum(dv * dv) * (1.0f / IDD) + LN_EPS);
    float y = dv * rstd * a.lnk_g[lane] + a.lnk_b[lane];
    const float p = __shfl_xor(y, 8);
    if (lane < 16) { const float cs = ropetab[t * 16 + (lane & 7)], sn = ropetab[t * 16 + 8 + (lane & 7)]; y = lane < 8 ? y * cs - p * sn : y * cs + p * sn; }
    kiF[(size_t)m * 64 + lane] = f2h(y);
    if (m < NR) {
      float wl = 0.f;
      if (lane < 8) { wl = kiw[(size_t)m * KIW + 64 + lane] * (0.35355339059327373f * 0.125f * 0.5f); wq[(size_t)m * 8 + lane] = wl; }
      float ql = 0.f;
#pragma unroll
      for (int h = 0; h < IH; ++h) ql += __shfl(wl, h) * h2f(qih[(size_t)m * 512 + h * 64 + lane]);
      qlin[(size_t)m * 64 + lane] = f2h(ql);
    }
  }
  }
  { PHASE_IDS
  for (int tile = bid; tile < NR / 32; tile += G) {
    const int m0 = tile * 32, b = m0 >> 13, s0 = m0 & (SEQ - 1);
    bf16_t* ubuf = (bf16_t*)lds_raw;
    float* res = (float*)(lds_raw + 65536);
    __syncthreads();
    for (int i = tid; i < 62 * 64; i += NTHR) {
      const int rr = i >> 6, cc = i & 63, s = s0 - 30 + rr, t = s + NMETA;
      uint4 v = make_uint4(0u, 0u, 0u, 0u);
      if (t >= 0) { const int row = t < NMETA ? NR + b * NMETA + t : b * SEQ + s; v = *(const uint4*)(ub + (size_t)row * 512 + cc * 8); }
      *(uint4*)(ubuf + rr * 512 + cc * 8) = v;
    }
    __syncthreads();
    {
      const int hf = tid >> 8, cp = tid & 255;
      float cw0[CONV_W], cw1[CONV_W];
#pragma unroll
      for (int w = 0; w < CONV_W; ++w) { const float2 c2 = *(const float2*)(a.conv_w + w * CONV_CH + 2 * cp); cw0[w] = c2.x; cw1[w] = c2.y; }
      const float2 cb = *(const float2*)(a.conv_b + 2 * cp);
#pragma unroll 1
      for (int rr = 0; rr < 16; ++rr) {
        const int r = hf * 16 + rr; float a0 = cb.x, a1 = cb.y;
#pragma unroll
        for (int w = 0; w < CONV_W; ++w) { const unsigned pr = *(const unsigned*)(ubuf + (r + w) * 512 + 2 * cp); a0 += cw0[w] * bflo(pr); a1 += cw1[w] * bfhi(pr); }
        *(float2*)(res + r * 512 + 2 * cp) = make_float2(a0, a1);
      }
    }
    __syncthreads();
#pragma unroll 1
    for (int rr = 0; rr < 4; ++rr) {
      const int r = wave + 8 * rr; float v[8]; float s = 0.f;
#pragma unroll
      for (int j = 0; j < 8; ++j) { v[j] = res[r * 512 + j * 64 + lane]; s += v[j]; }
      const float mu = wave_sum(s) * (1.0f / CONV_CH); float q = 0.f;
#pragma unroll
      for (int j = 0; j < 8; ++j) { v[j] -= mu; q += v[j] * v[j]; }
      const float rstd = rsqrtf(wave_sum(q) * (1.0f / CONV_CH) + LN_EPS);
#pragma unroll
      for (int j = 0; j < 8; ++j) { const int c = j * 64 + lane; const float y = v[j] * rstd * a.lnc_g[c] + a.lnc_b[c]; mixb[(size_t)(m0 + r) * D + c] = (bf16_t)f2bf(y / (1.0f + __expf(-y))); }
    }
  }
  }
  xcd_barrier(bar);
  { PHASE_IDS
  {
    unsigned char* ql = lds_raw;
    int* cl = (int*)(lds_raw + 18432);
    int* tl = cl + 256;
    const int q = lane & 15, kg = lane >> 4;
    for (int pi = bid; pi < 512; pi += G)
#pragma unroll 1
      for (int hf = 0; hf < 2; ++hf) {
        const int blk = hf ? 1023 - pi : pi;
        const int m0 = blk * 16, b = m0 >> 13, s0 = m0 & (SEQ - 1), m = m0 + q;
        const int ntile = (s0 >> 4) + 2;
        const int nsl = (ntile + 7) >> 3;
        __syncthreads();
        if (wave == 0) {
#pragma unroll
          for (int h = 0; h < 9; ++h)
#pragma unroll
            for (int ks = 0; ks < 2; ++ks) {
              const unsigned short* src = h < 8 ? qih + (size_t)m * 512 + h * 64 + ks * 32 + kg * 8 : qlin + (size_t)m * 64 + ks * 32 + kg * 8;
              *(uint4*)(ql + ((h * 2 + ks) * 64 + lane) * 16) = *(const uint4*)src;
            }
        }
        float wv[8];
#pragma unroll
        for (int h = 0; h < 8; ++h) wv[h] = wq[(size_t)m * 8 + h];
        __syncthreads();
        unsigned sc[130];
#pragma unroll
        for (int slot = 0; slot < 65; ++slot) {
          const int g = slot * 8 + wave;
          unsigned p0 = 0u, p1 = 0u;
          if (g < ntile) {
            const int krow = g == 0 ? NR + 16 * b + q : b * SEQ + 16 * (g - 1) + q;
            const f16x8 a0 = *(const f16x8*)(kiF + (size_t)krow * 64 + kg * 8), a1 = *(const f16x8*)(kiF + (size_t)krow * 64 + 32 + kg * 8);
            unsigned qo = (unsigned)lane * 16u; asm volatile("" : "+v"(qo));
            const unsigned char* qlp = ql + qo;
            pg8::f32x4 sv = __builtin_amdgcn_mfma_f32_16x16x32_f16(a0, *(const f16x8*)(qlp + (8 * 2 + 0) * 1024), (pg8::f32x4){0.f, 0.f, 0.f, 0.f}, 0, 0, 0);
            sv = __builtin_amdgcn_mfma_f32_16x16x32_f16(a1, *(const f16x8*)(qlp + (8 * 2 + 1) * 1024), sv, 0, 0, 0);
#pragma unroll
            for (int h = 0; h < 8; ++h) {
              pg8::f32x4 tv = __builtin_amdgcn_mfma_f32_16x16x32_f16(a0, *(const f16x8*)(qlp + (h * 2 + 0) * 1024), (pg8::f32x4){0.f, 0.f, 0.f, 0.f}, 0, 0, 0);
              tv = __builtin_amdgcn_mfma_f32_16x16x32_f16(a1, *(const f16x8*)(qlp + (h * 2 + 1) * 1024), tv, 0, 0, 0);
#pragma unroll
              for (int r = 0; r < 4; ++r) sv[r] = fmaf(fabsf(tv[r]), wv[h], sv[r]);
            }
            unsigned h01 = __builtin_bit_cast(unsigned, __builtin_amdgcn_cvt_pkrtz(sv[0], sv[1])), h23 = __builtin_bit_cast(unsigned, __builtin_amdgcn_cvt_pkrtz(sv[2], sv[3]));
            h01 ^= (((h01 >> 15) & 0x00010001u) * 0x7FFFu) | 0x80008000u;
            h23 ^= (((h23 >> 15) & 0x00010001u) * 0x7FFFu) | 0x80008000u;
            if (g == ntile - 1) {
              const int lim = q - 4 * kg;
              h01 &= (lim >= 0 ? 0x0000FFFFu : 0u) | (lim >= 1 ? 0xFFFF0000u : 0u);
              h23 &= (lim >= 2 ? 0x0000FFFFu : 0u) | (lim >= 3 ? 0xFFFF0000u : 0u);
            }
            p0 = h01; p1 = h23;
          }
          sc[2 * slot] = p0; sc[2 * slot + 1] = p1;
        }
        unsigned lo = 0u; int par = 0; const unsigned ones16 = 0x00010001u;
#define CNT_GE(dst, T1) do { const unsigned tm_ = (unsigned)(T1) * 0x00010001u; unsigned ac_ = 0u; \
          _Pragma("unroll") for (int gp = 0; gp < 9; ++gp) if (gp * 8 < nsl) { _Pragma("unroll") for (int i = gp * 16; i < (gp == 8 ? 130 : gp * 16 + 16); ++i) pk_cnt_gt(ac_, sc[i], tm_, ones16); } \
          dst = (int)((ac_ & 0xffffu) + (ac_ >> 16)); } while (0)
#pragma unroll 1
        for (int bit = 15; bit >= 0; --bit) {
          const unsigned cand = lo | (1u << bit);
          int c0; CNT_GE(c0, cand - 1u);
          c0 += __shfl_xor(c0, 16); c0 += __shfl_xor(c0, 32);
          if (kg == 0) cl[(par * 8 + wave) * 16 + q] = c0;
          __syncthreads();
          int tot = 0;
#pragma unroll
          for (int w = 0; w < 8; ++w) tot += cl[(par * 8 + w) * 16 + q];
          if (tot >= TOPK) lo = cand;
          par ^= 1;
        }
        const unsigned T = lo;
        int cge = 0, cgt = 0;
        if (T > 0u) { CNT_GE(cge, T - 1u); }
        if (T < 0xFFFFu) { CNT_GE(cgt, T); }
        if (T == 0u) cge = cgt;
        const int eq = cge - cgt;
        int e0 = __shfl(eq, q), e1 = __shfl(eq, q + 16), e2 = __shfl(eq, q + 32), e3 = __shfl(eq, q + 48);
        int g4 = cgt; g4 += __shfl_xor(g4, 16); g4 += __shfl_xor(g4, 32);
        const int pre_l = (kg > 0 ? e0 : 0) + (kg > 1 ? e1 : 0) + (kg > 2 ? e2 : 0);
        if (kg == 0) { tl[wave * 16 + q] = e0 + e1 + e2 + e3; cl[(par * 8 + wave) * 16 + q] = g4; }
        __syncthreads();
        int totgt = 0, prew = 0;
#pragma unroll
        for (int w = 0; w < 8; ++w) { totgt += cl[(par * 8 + w) * 16 + q]; prew += (w < wave) ? tl[w * 16 + q] : 0; }
        par ^= 1;
        const int need = T > 0u ? TOPK - totgt : 0;
        const int budget = min(max(need - (prew + pre_l), 0), eq);
        int tc = 0;
        unsigned short* mrow = (unsigned short*)(maskb + (size_t)m * MPW);
#pragma unroll
        for (int slot = 0; slot < 65; ++slot) {
          const unsigned p0 = sc[2 * slot], p1 = sc[2 * slot + 1];
          unsigned nib = 0u;
          if (slot < nsl) {
            const unsigned v0 = p0 & 0xffffu, v1 = p0 >> 16, v2 = p1 & 0xffffu, v3 = p1 >> 16;
            bool e;
            e = v0 == T; nib |= ((v0 > T) | (e & (tc < budget))) ? 1u : 0u; tc += e ? 1 : 0;
            e = v1 == T; nib |= ((v1 > T) | (e & (tc < budget))) ? 2u : 0u; tc += e ? 1 : 0;
            e = v2 == T; nib |= ((v2 > T) | (e & (tc < budget))) ? 4u : 0u; tc += e ? 1 : 0;
            e = v3 == T; nib |= ((v3 > T) | (e & (tc < budget))) ? 8u : 0u; tc += e ? 1 : 0;
            nib <<= 4 * kg;
            nib |= __shfl_xor(nib, 16); nib |= __shfl_xor(nib, 32);
          }
          if (kg == 0) mrow[slot * 8 + wave + KVOFF / 16] = (unsigned short)nib;
        }
        if (wave == 0 && kg == 0) {
#pragma unroll
          for (int i = 0; i < KVOFF / 16; ++i) mrow[i] = 0;
        }
#undef CNT_GE
      }
  }
  }
  xcd_barrier(bar);
  { PHASE_IDS
  {
    const attn_body::AttnTensors AT{(const attn_body::bf16*)qb, (const attn_body::bf16*)kb, (const attn_body::bf16*)vb, (attn_body::bf16*)(mixb + CONV_CH), maskb};
    const attn_body::StaticOrder S(G, bid);
    attn_body::attn_phase<attn_body::StaticOrder>((char*)lds_raw, AT, S);
  }
  }
  xcd_barrier(bar);
  { PHASE_IDS
  {
    pg8::Gemm g{mixb, WoutT, NR, D, D}; pg8::StaticOrder S; S.init(NR, D, G, bid);
    EpiF32 E{tmp, D, NR, D};
    pg8::gemm_phase<EpiF32, pg8::StaticOrder, true, true>((PG8_LAS unsigned char*)lds_raw, g, S, E);
  }
  }
  xcd_barrier(bar);
  { PHASE_IDS
  {
    float* scr = lds + wave * 2304;
    for (int it = gw; it < (NE + 1) * 384; it += NGW) {
      const int e = it / 384, r = it % 384, which = r >> 7, q = r & 127;
      if (which < 2) {
        const float* W = e < NE ? (which ? a.w_up : a.w_gate) + (size_t)e * D * DE : (which ? a.ws_up : a.ws_gate);
        const int kb_ = q >> 3, nb = q & 7, n0 = 32 * nb;
        transpose_item(W, D, DE, WguT + (size_t)e * WGU_E, D, scr, 64 * kb_, n0, (n0 >> 7) * 256 + which * 128 + (n0 & 127), lane);
      } else {
        const float* W = e < NE ? a.w_down + (size_t)e * DE * D : a.ws_down;
        const int kb_ = q >> 5, nb = q & 31;
        transpose_item(W, DE, D, WdT + (size_t)e * WD_E, DE, scr, 64 * kb_, 32 * nb, 32 * nb, lane);
      }
    }
  }
  for (int m = gw; m < NR; m += NGW) {
    const float2 st = st0[m];
    float v[16]; float s = 0.f;
#pragma unroll
    for (int i = 0; i < 16; ++i) { const int c = i * 64 + lane; const float hh = (a.x[(size_t)m * D + c] - st.x) * st.y * a.ln_emb_g[c] + a.ln_emb_b[c]; v[i] = DN_ALPHA * hh + tmp[(size_t)m * D + c]; s += v[i]; }
    const float mu = wave_sum(s) * (1.0f / D);
    float q = 0.f;
#pragma unroll
    for (int i = 0; i < 16; ++i) { const float d = v[i] - mu; q += d * d; }
    const float rstd = rsqrtf(wave_sum(q) * (1.0f / D) + LN_EPS);
#pragma unroll
    for (int i = 0; i < 16; ++i) { const int c = i * 64 + lane; v[i] = (v[i] - mu) * rstd * a.ln1_g[c] + a.ln1_b[c]; h1b[(size_t)m * H1P + c] = (bf16_t)f2bf(v[i]); }
    float lgt = 0.f;
#pragma unroll
    for (int i = 0; i < 16; ++i)
      for (int j = 0; j < 64; ++j) lgt += __shfl(v[i], j) * a.w_router[(i * 64 + j) * NE + lane];
    const float score = sigmoidf_(lgt), biased = score + a.r_bias[lane];
    float m1 = -INFINITY, m2 = -INFINITY;
    for (int j = 0; j < 8; ++j) { const float vv = __shfl(biased, (lane & ~7) + j); if (vv > m1) { m2 = m1; m1 = vv; } else if (vv > m2) m2 = vv; }
    const float gs = m1 + m2; const int g = lane >> 3;
    int grank = 0;
    for (int j = 0; j < 8; ++j) { const float vv = __shfl(gs, j * 8); grank += (vv > gs || (vv == gs && j < g)) ? 1 : 0; }
    const float val = grank < 4 ? biased : -INFINITY;
    int rank = 0;
    for (int j = 0; j < 64; ++j) { const float vv = __shfl(val, j); rank += (vv > val || (vv == val && j < lane)) ? 1 : 0; }
    const bool selq = rank < TOPE;
    const float ssum = wave_sum(selq ? score : 0.f);
    if (selq) { ridx[m * TOPE + rank] = lane; rw[m * TOPE + rank] = score / ssum * ROUTED_SCALE; atomicAdd(&ecnt[lane], 1); }
  }
  }
  xcd_barrier(bar);
  { PHASE_IDS
  {
    __syncthreads();
    if (tid == 0) { int aa = 0; for (int e = 0; e < NE; ++e) { tst[e] = aa; aa += (ecnt[e] + 255) >> 8; } tst[NE] = aa; tst[NE + 1] = aa + NR / 256; }
    __syncthreads();
    for (int i = bid * NTHR + tid; i < NR * TOPE; i += G * NTHR) {
      const int e = ridx[i], p = tst[e] * 256 + atomicAdd(&ecur[e], 1);
      tokmap[p] = i / TOPE; wslot[p] = rw[i]; slotof[i] = p;
    }
    for (int e = bid; e < NE; e += G) {
      const int lo = tst[e] * 256 + ecnt[e], hi = tst[e + 1] * 256;
      for (int p = lo + tid; p < hi; p += NTHR) { tokmap[p] = 0; wslot[p] = 0.f; }
    }
    const int sb = tst[NE] * 256;
    for (int i = bid * NTHR + tid; i < NR; i += G * NTHR) { tokmap[sb + i] = i; wslot[sb + i] = 1.0f; }
  }
  }
  xcd_barrier(bar);
  { PHASE_IDS
  {
    typedef MoeSched<2, D, WL::o_regionE, WL::WGU_E * 2, 0, 0, NE + 1> SchedGU;
    SchedGU S{a.ws, tst, G, bid};
    EpiGateUp E{a.ws};
    gemm_phase_x<EpiGateUp, SchedGU, true, D, (unsigned)(H1P * 2)>((PG8_LAS unsigned char*)lds_raw, h1b, S, E);
  }
  }
  xcd_barrier(bar);
  { PHASE_IDS
  {
    {
      typedef MoeSched<4, DE, WL::o_WdT, WL::WD_E * 2, WL::o_ub, 0, NE> SchedD;
      SchedD S{a.ws, tst, G, bid};
      EpiDownY E{a.ws};
      gemm_phase_x<EpiDownY, SchedD, false, DE, (unsigned)(DE * 2)>((PG8_LAS unsigned char*)lds_raw, nullptr, S, E);
    }
    {
      typedef MoeSched<4, DE, WL::o_WdT, WL::WD_E * 2, WL::o_ub, NE, NE + 1> SchedD;
      SchedD S{a.ws, tst, G, bid};
      EpiDownS E{h1b, __builtin_amdgcn_readfirstlane(tst[NE])};
      gemm_phase_x<EpiDownS, SchedD, false, DE, (unsigned)(DE * 2)>((PG8_LAS unsigned char*)lds_raw, nullptr, S, E);
    }
  }
  }
  xcd_barrier(bar);
  { PHASE_IDS
  for (int m = gw; m < NR; m += NGW) {
    const bf16_t* hrow = h1b + (size_t)m * H1P;
    float v[16];
#pragma unroll
    for (int j = 0; j < 4; ++j) {
      const int c = j * 256 + lane * 4;
      const uint2 hh = *(const uint2*)(hrow + c), ss = *(const uint2*)(hrow + D + c);
      v[4 * j + 0] = DN_ALPHA * bflo(hh.x) + bflo(ss.x); v[4 * j + 1] = DN_ALPHA * bfhi(hh.x) + bfhi(ss.x);
      v[4 * j + 2] = DN_ALPHA * bflo(hh.y) + bflo(ss.y); v[4 * j + 3] = DN_ALPHA * bfhi(hh.y) + bfhi(ss.y);
    }
    float racc[16];
#pragma unroll
    for (int i = 0; i < 16; ++i) racc[i] = 0.f;
#pragma unroll
    for (int k = 0; k < TOPE; ++k) {
      const unsigned char* yr = y8 + (size_t)slotof[m * TOPE + k] * D;
#pragma unroll
      for (int j = 0; j < 4; ++j) {
        const unsigned w = *(const unsigned*)(yr + j * 256 + lane * 4);
        const auto lo2 = __builtin_amdgcn_cvt_pk_f32_fp8((int)w, false), hi2 = __builtin_amdgcn_cvt_pk_f32_fp8((int)w, true);
        racc[4 * j + 0] += lo2[0]; racc[4 * j + 1] += lo2[1]; racc[4 * j + 2] += hi2[0]; racc[4 * j + 3] += hi2[1];
      }
    }
    float s = 0.f;
#pragma unroll
    for (int i = 0; i < 16; ++i) { v[i] += racc[i] * (1.0f / YSCALE); s += v[i]; }
    const float mu = wave_sum(s) * (1.0f / D);
    float q = 0.f;
#pragma unroll
    for (int i = 0; i < 16; ++i) { v[i] -= mu; q += v[i] * v[i]; }
    const float rstd = rsqrtf(wave_sum(q) * (1.0f / D) + LN_EPS);
#pragma unroll
    for (int j = 0; j < 4; ++j) {
      const int c = j * 256 + lane * 4;
      const float4 g4 = *(const float4*)(a.ln2_g + c), b4 = *(const float4*)(a.ln2_b + c);
      *(float4*)(out + (size_t)m * D + c) = make_float4(v[4 * j] * rstd * g4.x + b4.x, v[4 * j + 1] * rstd * g4.y + b4.y, v[4 * j + 2] * rstd * g4.z + b4.z, v[4 * j + 3] * rstd * g4.w + b4.w);
    }
  }
  }
}

extern "C" void kernel_launch(void* const* d_in, const int* in_sizes, int n_in, void* d_out, int out_size, void* d_ws, size_t ws_size, hipStream_t stream) {
  static int grid = 0;
  if (grid == 0) {
    int dev = 0, cus = 0, per_cu = 0;
    if (hipGetDevice(&dev) != hipSuccess || hipDeviceGetAttribute(&cus, hipDeviceAttributeMultiprocessorCount, dev) != hipSuccess) { fprintf(stderr, "kernel_launch: device query failed\n"); grid = -1; return; }
    if (hipFuncSetAttribute((const void*)mega_fwd, hipFuncAttributeMaxDynamicSharedMemorySize, LDS_BYTES) != hipSuccess) { fprintf(stderr, "kernel_launch: hipFuncSetAttribute failed\n"); grid = -1; return; }
    if (hipOccupancyMaxActiveBlocksPerMultiprocessor(&per_cu, (const void*)mega_fwd, NTHR, LDS_BYTES) != hipSuccess || per_cu < 1) { fprintf(stderr, "kernel_launch: occupancy query says %d\n", per_cu); }
    (void)hipGetLastError();
    grid = cus;
  }
  if (grid < 0) return;
  (void)in_sizes; (void)n_in; (void)out_size; (void)ws_size;
  if (hipMemsetAsync(d_ws, 0, CTL_BYTES, stream) != hipSuccess) { fprintf(stderr, "kernel_launch: memset failed\n"); return; }
  Args a{};
  const float** pp = (const float**)&a;
  for (int i = 0; i < 24; ++i) pp[i] = (const float*)d_in[i];
  a.out = (float*)d_out; a.ws = (unsigned char*)d_ws;
  for (int i = 0; i < 8; ++i) a.ropeinv[i] = (float)pow(500000.0, -2.0 * i / 16.0);
  hipLaunchKernelGGL(mega_fwd, dim3(grid), dim3(NTHR), LDS_BYTES, stream, a);
  const hipError_t le = hipPeekAtLastError();
  if (le != hipSuccess) fprintf(stderr, "kernel_launch: launch failed: %s\n", hipGetErrorName(le));
}
```

```cpp
#include <hip/hip_runtime.h>
#include <hip/hip_bf16.h>
#include <cstdint>
#include <cstdio>
#include <cmath>

constexpr int D = 1024, NB = 2, SEQ = 8192, NMETA = 16, TP = SEQ + NMETA;
constexpr int NR = NB * SEQ;
constexpr int NROWS = NR + NB * NMETA;
constexpr int CONV_CH = 512, CONV_W = 31, NH = 8, HD = 64, IH = 8, IDD = 64, TOPK = 256;
constexpr int IN_W = 3144;
constexpr int OFF_A = 0, OFF_G = 512, OFF_Q = 1024, OFF_K = 1536, OFF_V = 2048, OFF_QI = 2560, OFF_KI = 3072, OFF_WI = 3136;
constexpr int NE = 64, TOPE = 8, DE = 256;
constexpr float LN_EPS = 1e-5f;
constexpr float DN_ALPHA = 1.189207115002721f;
constexpr float ROUTED_SCALE = 2.5f;

__device__ __forceinline__ int row_of(int b, int t) { return t < NMETA ? NR + b * NMETA + t : b * SEQ + (t - NMETA); }
__device__ __forceinline__ void row_bt(int m, int& b, int& t) { if (m < NR) { b = m >> 13; t = (m & (SEQ - 1)) + NMETA; } else { b = (m - NR) >> 4; t = (m - NR) & 15; } }

__device__ __forceinline__ float wave_sum(float v) {
#pragma unroll
  for (int o = 32; o > 0; o >>= 1) v += __shfl_xor(v, o);
  return v;
}
__device__ __forceinline__ float sigmoidf_(float x) { return 1.0f / (1.0f + expf(-x)); }

#define XB_TMO      128
#define XB_XCNT(j)  (256  + 64 * (j))
#define XB_XSUB(j)  (1280 + 64 * (j))
#define XB_XGEN(j)  (2304 + 64 * (j))
#define XB_TOP      3328
#define XB_TOPGEN   3392
#define XCD_BAR_WORDS 3456
#define XB_SPIN_CAP (1u << 18)
#ifndef LAS
#define LAS __attribute__((address_space(3)))
#endif

__device__ __forceinline__ unsigned xb_ld(unsigned* p)              { return __hip_atomic_load(p, __ATOMIC_RELAXED, __HIP_MEMORY_SCOPE_AGENT); }
__device__ __forceinline__ unsigned xb_add(unsigned* p, unsigned v) { return __hip_atomic_fetch_add(p, v, __ATOMIC_RELAXED, __HIP_MEMORY_SCOPE_AGENT); }
__device__ __forceinline__ unsigned xb_xcc_id() { return (unsigned)__builtin_amdgcn_s_getreg((3 << 11) | 20) & 0xFu; }
#define XB_SPIN(cond, bar) do { unsigned _sp = 0; while (cond) { __builtin_amdgcn_s_sleep(1); \
    if ((++_sp & 255u) == 0u) { if (xb_ld(&(bar)[XB_TMO])) break; if (_sp > XB_SPIN_CAP) { atomicAdd(&(bar)[XB_TMO], 1u); break; } } } } while (0)

struct XcdBarrier {
    unsigned* bar; unsigned x;
    volatile LAS unsigned* st;
};

__device__ __forceinline__ XcdBarrier xcd_barrier_post(unsigned* bar, volatile LAS unsigned* st) {
    XcdBarrier b; b.bar = bar; b.x = xb_xcc_id(); b.st = st;
    if (threadIdx.x == 0) (void)xb_add(&bar[XB_XCNT(b.x)], 1u);
    return b;
}
__device__ __forceinline__ void xcd_barrier_complete(unsigned* bar, unsigned x, unsigned& nloc, unsigned& nx) {
    const unsigned G = gridDim.x * gridDim.y * gridDim.z;
    unsigned sum, cnt, mine, sp = 0u;
    for (;;) {
        sum = 0u; cnt = 0u; mine = 0u;
#pragma unroll
        for (unsigned j = 0; j < 16; ++j) { const unsigned c = xb_ld(&bar[XB_XCNT(j)]); sum += c; cnt += (c > 0u) ? 1u : 0u; mine = (j == x) ? c : mine; }
        if (sum == G) break;
        __builtin_amdgcn_s_sleep(1);
        if ((++sp & 255u) == 0u) { if (xb_ld(&bar[XB_TMO])) break; if (sp > XB_SPIN_CAP) { atomicAdd(&bar[XB_TMO], 1u); break; } }
    }
    nloc = mine > 0u ? mine : 1u; nx = cnt > 0u ? cnt : 1u;
}

__device__ __forceinline__ void xcd_barrier(const XcdBarrier& b) {
    asm volatile("s_waitcnt vmcnt(0)" ::: "memory");
    __syncthreads();
    if (threadIdx.x == 0) {
        unsigned* bar = b.bar;
        __builtin_amdgcn_s_waitcnt(0);
        unsigned nloc = b.st[0], nx = b.st[1];
        if (nloc == 0u) { xcd_barrier_complete(bar, b.x, nloc, nx); b.st[0] = nloc; b.st[1] = nx; }
        const unsigned old = xb_add(&bar[XB_XSUB(b.x)], 1u);
        const unsigned gen = old / nloc;
        if (old + 1u == (gen + 1u) * nloc) {
            __builtin_amdgcn_fence(__ATOMIC_RELEASE, "agent");
            asm volatile("s_waitcnt vmcnt(0)" ::: "memory");
            const unsigned og = xb_add(&bar[XB_TOP], 1u);
            const unsigned tg = og / nx;
            if (og + 1u == (tg + 1u) * nx) xb_add(&bar[XB_TOPGEN], 1u);
            else XB_SPIN(xb_ld(&bar[XB_TOPGEN]) == tg, bar);
            __builtin_amdgcn_fence(__ATOMIC_ACQUIRE, "agent");
            xb_add(&bar[XB_XGEN(b.x)], 1u);
            asm volatile("s_waitcnt vmcnt(0)" ::: "memory");
        } else {
            XB_SPIN(xb_ld(&bar[XB_XGEN(b.x)]) == gen, bar);
            __builtin_amdgcn_fence(__ATOMIC_ACQUIRE, "agent");
            asm volatile("s_waitcnt vmcnt(0)" ::: "memory");
        }
    }
    __syncthreads();
}


typedef unsigned short bf16_t;
__device__ __forceinline__ unsigned f2bf(float f) { unsigned u = __float_as_uint(f); return (u + 0x7fffu + ((u >> 16) & 1u)) >> 16; }
__device__ __forceinline__ unsigned pk2(float lo, float hi) { return f2bf(lo) | (f2bf(hi) << 16); }
__device__ __forceinline__ float bf2f(bf16_t v) { return __uint_as_float((unsigned)v << 16); }

namespace pg8 {
#define PG8_LAS __attribute__((address_space(3)))
typedef unsigned short bf16_t;
typedef short bf16x8 __attribute__((ext_vector_type(8)));
typedef float f32x4 __attribute__((ext_vector_type(4)));
typedef unsigned u32x4 __attribute__((ext_vector_type(4)));
constexpr int BM = 256, BK = 64, HALF = 128, HTB = HALF * BK * 2  , STAGE_BYTES = 8 * HTB, NXCD = 8, WGM = 8;

__host__ __device__ __forceinline__ int lds_byte(int r, int c) { const int st = (r >> 4) * 2 + (c >> 5), rr = r & 15, cc = c & 31, ob = rr * 64 + cc * 2; return st * 1024 + (ob ^ (((ob >> 9) & 1) << 5)); }
__host__ __device__ __forceinline__ void stage_rc(int b, int& R, int& C) { const int st = b / 1024, sb = b % 1024, swz = sb ^ (((sb >> 9) & 1) << 5); R = (st >> 1) * 16 + swz / 64; C = (st & 1) * 32 + (swz % 64) / 2; }
__host__ __device__ __forceinline__ int perm32(int rho) { const int n = rho >> 4, i = rho & 15; return 8 * (i >> 2) + 4 * n + (i & 3); }

struct Unit { int pm, pn; };
struct Gemm { const bf16_t* A; const bf16_t* Bt; int M, N, K; };

struct StaticOrder {
    int nM, nN, nwg, G, c;
    __host__ __device__ void init(int M, int N, int G_, int c_) { nM = M / BM; nN = N / BM; nwg = nM * nN; G = G_; c = c_; }
    __host__ __device__ bool next(int i, Unit& u) const {
        const long L = (long)i * G + c; if (L >= nwg) return false;
        int wgid = (int)L; { const int q = nwg / NXCD, r = nwg % NXCD, xcd = wgid % NXCD, off = wgid / NXCD; wgid = (xcd < r ? xcd * (q + 1) : r * (q + 1) + (xcd - r) * q) + off; }
        const int nig = WGM * nN, gid = wgid / nig, fm = gid * WGM, gsz = (nM - fm) < WGM ? (nM - fm) : WGM;
        u.pm = fm + ((wgid % nig) % gsz); u.pn = (wgid % nig) / gsz; return true;
    }
    __device__ __forceinline__ void a_ready(const Unit&) const {}
    __device__ __forceinline__ void done(const Unit&) const {}
};

__device__ __forceinline__ unsigned cvt_pk_bf16(float lo, float hi) { unsigned r; asm volatile("v_cvt_pk_bf16_f32 %0, %1, %2" : "=v"(r) : "v"(lo), "v"(hi)); return r; }
typedef float f32x2 __attribute__((ext_vector_type(2)));
__device__ __forceinline__ f32x2 gelu_pk(f32x2 v) {
    const f32x2 av = __builtin_elementwise_abs(v), d = av * 0.2316418882f + 1.0f;
    f32x2 t; t.x = __builtin_amdgcn_rcpf(d.x); t.y = __builtin_amdgcn_rcpf(d.y);
    f32x2 q = t * 0.5307027145f + (-0.7265760135f); q = q * t + 0.7107068705f; q = q * t + (-0.142248368f); q = q * t + 0.127414796f; q = q * t;
    const f32x2 s = (v * v) * (-0.72134752044f);
    f32x2 e; e.x = __builtin_amdgcn_exp2f(s.x); e.y = __builtin_amdgcn_exp2f(s.y);
    const f32x2 m = v * (q * e), r = v - m;
    f32x2 o; o.x = v.x < 0.f ? m.x : r.x; o.y = v.y < 0.f ? m.y : r.y; return o;
}

template <int ACT  > struct EpiBf16 {
    static constexpr bool PERM = true, AFTER_DRAIN = false; static_assert(ACT == 0 || ACT == 1, "EpiBf16: ACT is 0 (none) or 1 (gelu_pk)");
    bf16_t* O; int ldc; const float* bias; int split_cols; size_t split_stride; float scale0;
    __device__ __forceinline__ void operator()(const f32x4 (&acc)[2][2][4][2], const Unit& u, int wr, int wc, int fr, int fq) const {
        const int row0 = u.pm * BM + wr * 64 + fr; int colt = u.pn * BM; bf16_t* base = O;
        float sc = 1.f; if (split_cols) { const int t = colt / split_cols; base += (size_t)t * split_stride; colt -= t * split_cols; if (t == 0) sc = scale0; }
        const int col0 = colt + wc * 32 + 8 * fq, bcol0 = u.pn * BM + wc * 32 + 8 * fq;
        f32x4 bv[2][2];
#pragma unroll
        for (int bj = 0; bj < 2; ++bj)
#pragma unroll
            for (int n = 0; n < 2; ++n) bv[bj][n] = bias ? *(const f32x4*)(bias + bcol0 + bj * HALF + 4 * n) : (f32x4){0.f, 0.f, 0.f, 0.f};
#pragma unroll
        for (int ai = 0; ai < 2; ++ai)
#pragma unroll
            for (int m = 0; m < 4; ++m) { bf16_t* rowp = base + (size_t)(row0 + ai * HALF + m * 16) * ldc + col0;
#pragma unroll
                for (int bj = 0; bj < 2; ++bj) { f32x4 v0 = acc[ai][bj][m][0] + bv[bj][0], v1 = acc[ai][bj][m][1] + bv[bj][1];
                    if (ACT == 1) { f32x2 a = gelu_pk((f32x2){v0[0], v0[1]}), b = gelu_pk((f32x2){v0[2], v0[3]}), c = gelu_pk((f32x2){v1[0], v1[1]}), d = gelu_pk((f32x2){v1[2], v1[3]});
                        v0 = (f32x4){a.x, a.y, b.x, b.y}; v1 = (f32x4){c.x, c.y, d.x, d.y}; }
                    v0 = v0 * sc; v1 = v1 * sc; u32x4 w; w.x = cvt_pk_bf16(v0[0], v0[1]); w.y = cvt_pk_bf16(v0[2], v0[3]); w.z = cvt_pk_bf16(v1[0], v1[1]); w.w = cvt_pk_bf16(v1[2], v1[3]);
                    *(u32x4*)(rowp + bj * HALF) = w; } }
    }
};

struct PanelStats {
    unsigned* xbuf;
    unsigned* cnt;
    unsigned* tmo;
    int ntn; float eps;
    unsigned code;
    __device__ __forceinline__ bool run(const f32x4 (&v)[2][2][4][2], const Unit& u, int wr, int wc, int fr, int fq, PG8_LAS unsigned char* lds, int wid, int lane) const {
        typedef float f32x2v __attribute__((ext_vector_type(2)));
        PG8_LAS f32x2v* P = (PG8_LAS f32x2v*)lds;
        PG8_LAS f32x2v* S = (PG8_LAS f32x2v*)(lds + 8192);
        PG8_LAS unsigned* flag = (PG8_LAS unsigned*)(lds + 8192 + 2048);
#pragma unroll
        for (int ai = 0; ai < 2; ++ai)
#pragma unroll
            for (int m = 0; m < 4; ++m) {
                float s = 0.f;
#pragma unroll
                for (int bj = 0; bj < 2; ++bj)
#pragma unroll
                    for (int n = 0; n < 2; ++n) { const f32x4 x = v[ai][bj][m][n]; s += (x[0] + x[1]) + (x[2] + x[3]); }
                s += __shfl_xor(s, 16); s += __shfl_xor(s, 32);
                const float mw = s * (1.0f / 64.0f); float q = 0.f;
#pragma unroll
                for (int bj = 0; bj < 2; ++bj)
#pragma unroll
                    for (int n = 0; n < 2; ++n) { const f32x4 d = v[ai][bj][m][n] - mw; q += (d[0] * d[0] + d[1] * d[1]) + (d[2] * d[2] + d[3] * d[3]); }
                q += __shfl_xor(q, 16); q += __shfl_xor(q, 32);
                if (fq == 0) P[(ai * HALF + wr * 64 + m * 16 + fr) * 4 + wc] = (f32x2v){mw, q};
            }
        asm volatile("s_waitcnt lgkmcnt(0)" ::: "memory"); __builtin_amdgcn_s_barrier(); asm volatile("" ::: "memory");
#if defined(BROKEN_EXCHANGE_NO_WAIT)
#warning BROKEN CONTROL BUILD: the row-statistics exchange does not wait; results are wrong by design
        if (blockIdx.x >= 64) { const long long t0_ = clock64(); while (clock64() - t0_ < 60000) __builtin_amdgcn_s_sleep(8); }
#endif
        const int row = wid * 32 + (lane & 31);
        if (lane < 32) {
            const f32x2v a = P[row * 4 + 0], b = P[row * 4 + 1], c = P[row * 4 + 2], d = P[row * 4 + 3];
            const float mt = (a.x + b.x + c.x + d.x) * 0.25f;
            const float da = a.x - mt, db = b.x - mt, dc = c.x - mt, dd = d.x - mt;
            const float m2 = (a.y + b.y) + (c.y + d.y) + 64.0f * ((da * da + db * db) + (dc * dc + dd * dd));
            unsigned long long* slot = (unsigned long long*)xbuf + ((size_t)(u.pm * BM + row) * 4 + u.pn);
            __hip_atomic_store(slot, ((unsigned long long)__float_as_uint(m2) << 32) | __float_as_uint(mt), __ATOMIC_RELAXED, __HIP_MEMORY_SCOPE_AGENT);
        }
        asm volatile("s_waitcnt vmcnt(0)" ::: "memory");
        if (lane == 0) __hip_atomic_fetch_add(cnt + 64 * u.pm, 1u, __ATOMIC_RELAXED, __HIP_MEMORY_SCOPE_AGENT);
        if (wid == 0) {
            bool dead = false; const unsigned long long t0 = __builtin_amdgcn_s_memrealtime(); const unsigned want = 8u * (unsigned)ntn;
            for (;;) {
#if defined(BROKEN_EXCHANGE_NO_WAIT)
                break;
#endif
                if ((unsigned)__builtin_amdgcn_readfirstlane(__hip_atomic_load(cnt + 64 * u.pm, __ATOMIC_RELAXED, __HIP_MEMORY_SCOPE_AGENT)) >= want) break;
                if (__builtin_amdgcn_s_memrealtime() - t0 > 2000000ull) {
                    if (lane == 0) { unsigned expect = 0u; __hip_atomic_compare_exchange_strong(tmo + 1, &expect, code | (unsigned)(u.pm & 0xff), __ATOMIC_RELAXED, __ATOMIC_RELAXED, __HIP_MEMORY_SCOPE_AGENT);
                                     __hip_atomic_store(tmo, 1u, __ATOMIC_RELAXED, __HIP_MEMORY_SCOPE_AGENT); }
                    dead = true; break; }
                __builtin_amdgcn_s_sleep(2);
            }
            __builtin_amdgcn_fence(__ATOMIC_ACQUIRE, "agent");
            if (lane == 0) flag[0] = dead ? 1u : 0u;
        }
        asm volatile("s_waitcnt vmcnt(0) lgkmcnt(0)" ::: "memory"); __builtin_amdgcn_s_barrier(); asm volatile("" ::: "memory");
        const bool bad = flag[0] != 0u;
        if (lane < 32) {
            const unsigned long long* slot = (const unsigned long long*)xbuf + (size_t)(u.pm * BM + row) * 4; float mt[4], m2[4]; float ms = 0.f;
#pragma unroll
            for (int t = 0; t < 4; ++t) { if (t < ntn) { const unsigned long long w = __hip_atomic_load(slot + t, __ATOMIC_RELAXED, __HIP_MEMORY_SCOPE_AGENT); mt[t] = __uint_as_float((unsigned)w); m2[t] = __uint_as_float((unsigned)(w >> 32)); } else { mt[t] = 0.f; m2[t] = 0.f; } ms += mt[t]; }
            const float mean = ms / (float)ntn; float q = 0.f;
#pragma unroll
            for (int t = 0; t < 4; ++t) if (t < ntn) { const float dm = mt[t] - mean; q += m2[t] + 256.0f * dm * dm; }
            S[row] = (f32x2v){mean, 1.0f / sqrtf(q / (256.0f * (float)ntn) + eps)};
        }
        asm volatile("s_waitcnt lgkmcnt(0)" ::: "memory"); __builtin_amdgcn_s_barrier(); asm volatile("" ::: "memory");
        return bad;
    }
};
struct EpiLnRes {
    static constexpr bool PERM = false, AFTER_DRAIN = true;
    const float* base; float* out; int ldc; const float* bias; PanelStats st; unsigned poison;
    __device__ __forceinline__ void fused(f32x4 (&acc)[2][2][4][2], const Unit& u, int wr, int wc, int fr, int fq, PG8_LAS unsigned char* lds, int wid, int lane) const {
        typedef float f32x2v __attribute__((ext_vector_type(2)));
        const PG8_LAS f32x2v* S = (const PG8_LAS f32x2v*)(lds + 8192);
        const int col0 = u.pn * BM + wc * 32 + 4 * fq;
#pragma unroll
        for (int bj = 0; bj < 2; ++bj)
#pragma unroll
            for (int n = 0; n < 2; ++n) { const f32x4 bv = bias ? *(const f32x4*)(bias + col0 + bj * HALF + n * 16) : (f32x4){0.f, 0.f, 0.f, 0.f};
#pragma unroll
                for (int ai = 0; ai < 2; ++ai)
#pragma unroll
                    for (int m = 0; m < 4; ++m) acc[ai][bj][m][n] += bv; }
        f32x4 pre[4][2][2];
#pragma unroll
        for (int m = 0; m < 4; ++m) { const size_t off = (size_t)(u.pm * BM + wr * 64 + m * 16 + fr) * ldc + col0;
#pragma unroll
            for (int bj = 0; bj < 2; ++bj)
#pragma unroll
                for (int n = 0; n < 2; ++n) pre[m][bj][n] = *(const f32x4*)(base + off + bj * HALF + n * 16); }
        const bool bad = st.run(acc, u, wr, wc, fr, fq, lds, wid, lane) || poison != 0u;
        const float qnan = __builtin_nanf("");
#pragma unroll
        for (int ai = 0; ai < 2; ++ai)
#pragma unroll
            for (int m = 0; m < 4; ++m) { const int r = ai * HALF + wr * 64 + m * 16 + fr; const f32x2v sr = S[r]; const size_t off = (size_t)(u.pm * BM + r) * ldc + col0;
#pragma unroll
                for (int bj = 0; bj < 2; ++bj)
#pragma unroll
                    for (int n = 0; n < 2; ++n) { const f32x4 bs = ai == 0 ? pre[m][bj][n] : *(const f32x4*)(base + off + bj * HALF + n * 16); f32x4 o = bs + (acc[ai][bj][m][n] - sr.x) * sr.y;
                        if (bad) o = (f32x4){qnan, qnan, qnan, qnan}; *(f32x4*)(out + off + bj * HALF + n * 16) = o; }
                if (m & 1) asm volatile("" ::: "memory"); }
    }
};
struct EpiLnResLn {
    static constexpr bool PERM = false, AFTER_DRAIN = true;
    const float* base; float* out; bf16_t* xn; int ldc; const float* bias; PanelStats st1, st2; unsigned poison;
    __device__ __forceinline__ void fused(f32x4 (&acc)[2][2][4][2], const Unit& u, int wr, int wc, int fr, int fq, PG8_LAS unsigned char* lds, int wid, int lane) const {
        typedef float f32x2v __attribute__((ext_vector_type(2))); typedef unsigned u32x2v __attribute__((ext_vector_type(2)));
        const PG8_LAS f32x2v* S = (const PG8_LAS f32x2v*)(lds + 8192);
        const int col0 = u.pn * BM + wc * 32 + 4 * fq;
#pragma unroll
        for (int bj = 0; bj < 2; ++bj)
#pragma unroll
            for (int n = 0; n < 2; ++n) { const f32x4 bv = bias ? *(const f32x4*)(bias + col0 + bj * HALF + n * 16) : (f32x4){0.f, 0.f, 0.f, 0.f};
#pragma unroll
                for (int ai = 0; ai < 2; ++ai)
#pragma unroll
                    for (int m = 0; m < 4; ++m) acc[ai][bj][m][n] += bv; }
        bool bad = st1.run(acc, u, wr, wc, fr, fq, lds, wid, lane) || poison != 0u;
        const float qnan = __builtin_nanf("");
#pragma unroll
        for (int ai = 0; ai < 2; ++ai)
#pragma unroll
            for (int m = 0; m < 4; ++m) { const int r = ai * HALF + wr * 64 + m * 16 + fr; const f32x2v sr = S[r]; const size_t off = (size_t)(u.pm * BM + r) * ldc + col0;
#pragma unroll
                for (int bj = 0; bj < 2; ++bj)
#pragma unroll
                    for (int n = 0; n < 2; ++n) { const f32x4 bs = *(const f32x4*)(base + off + bj * HALF + n * 16); acc[ai][bj][m][n] = bs + (acc[ai][bj][m][n] - sr.x) * sr.y; }
                asm volatile("" : "+v"(acc[ai][0][m][0]), "+v"(acc[ai][0][m][1]), "+v"(acc[ai][1][m][0]), "+v"(acc[ai][1][m][1]));
                if (m & 1) asm volatile("" ::: "memory"); }
        const bool bad1 = bad;
        bad = st2.run(acc, u, wr, wc, fr, fq, lds, wid, lane) || bad;
#pragma unroll
        for (int ai = 0; ai < 2; ++ai)
#pragma unroll
            for (int m = 0; m < 4; ++m) { const int r = ai * HALF + wr * 64 + m * 16 + fr; const f32x2v sr = S[r]; const size_t off = (size_t)(u.pm * BM + r) * ldc + col0;
#pragma unroll
                for (int bj = 0; bj < 2; ++bj)
#pragma unroll
                    for (int n = 0; n < 2; ++n) { const f32x4 x1 = acc[ai][bj][m][n]; *(f32x4*)(out + off + bj * HALF + n * 16) = bad1 ? (f32x4){qnan, qnan, qnan, qnan} : x1;
                        const f32x4 o = (x1 - sr.x) * sr.y; u32x2v w; w.x = cvt_pk_bf16(o[0], o[1]); w.y = cvt_pk_bf16(o[2], o[3]);
                        if (bad) { w.x = 0x7fc07fc0u; w.y = 0x7fc07fc0u; } *(u32x2v*)(xn + off + bj * HALF + n * 16) = w; }
                asm volatile("" ::: "memory"); }
    }
};

template <class Epi, class Sched, bool ALIGN_EPI = false, bool SP2 = false>
__device__ __forceinline__ void gemm_phase(PG8_LAS unsigned char* lds, const Gemm g, const Sched& S, const Epi& E) {
    int tid = threadIdx.x; asm volatile("" : "+v"(tid));
    const int wid = __builtin_amdgcn_readfirstlane(tid >> 6), lane = tid & 63, wr = wid >> 2, wc = wid & 3, fr = lane & 15, fq = lane >> 4;
    const int K = g.K, nt = K / BK;
    unsigned voffA[2], voffB[2];
#pragma unroll
    for (int i = 0; i < 2; ++i) { int R, C; stage_rc(tid * 16 + i * 8192, R, C); const int Rb = Epi::PERM ? ((R & ~31) + perm32(R & 31)) : R;
        voffA[i] = (unsigned)(R * K + C) * 2u; voffB[i] = (unsigned)(Rb * K + C) * 2u; }
    const size_t kstep = (size_t)(BK * 2);
    const size_t hstep = (size_t)HALF * K * 2;
    const size_t tstep = 2 * hstep;
    const unsigned ldsw = (unsigned)wid * 1024u;
    const int aoff = lds_byte(wr * 64 + fr, fq * 8), boff = lds_byte(wc * 32 + fr, fq * 8);
#define PG8_SA(b, h) (((b) * 2 + (h)) * HTB)
#define PG8_SB(b, h) ((4 + (b) * 2 + (h)) * HTB)
#define PG8_STAGE(bufoff, gbase, voff) do { _Pragma("unroll") for (int _i = 0; _i < 2; ++_i) \
        __builtin_amdgcn_global_load_lds((const unsigned*)((const char*)(gbase) + (voff)[_i]), (PG8_LAS unsigned*)(lds + (bufoff) + ldsw + _i * 8192), 16, 0, 0); } while (0)
#define PG8_LDA(dst, b, h) do { _Pragma("unroll") for (int m = 0; m < 4; ++m) _Pragma("unroll") for (int k = 0; k < 2; ++k) dst[m][k] = *(const PG8_LAS bf16x8*)(lds + PG8_SA(b, h) + aoff + m * 2048 + k * 1024); } while (0)
#define PG8_LDB(dst, b, h) do { _Pragma("unroll") for (int n = 0; n < 2; ++n) _Pragma("unroll") for (int k = 0; k < 2; ++k) dst[n][k] = *(const PG8_LAS bf16x8*)(lds + PG8_SB(b, h) + boff + n * 2048 + k * 1024); } while (0)
#define PG8_MMA(ai, bj, At, Bt) do { __builtin_amdgcn_s_setprio(1); _Pragma("unroll") for (int m = 0; m < 4; ++m) _Pragma("unroll") for (int n = 0; n < 2; ++n) _Pragma("unroll") for (int k = 0; k < 2; ++k) \
        acc[ai][bj][m][n] = __builtin_amdgcn_mfma_f32_16x16x32_bf16(Bt[n][k], At[m][k], acc[ai][bj][m][n], 0, 0, 0); __builtin_amdgcn_s_setprio(0); } while (0)
#define PG8_WAIT_V(n) asm volatile("s_waitcnt vmcnt(" #n ")" ::: "memory")
#define PG8_WAIT_L(n) asm volatile("s_waitcnt lgkmcnt(" #n ")" ::: "memory")
#define PG8_BAR __builtin_amdgcn_s_barrier()
#define PG8_SCHED __builtin_amdgcn_sched_barrier(0)
    Unit cur, nxt; int ui = 0;
    if (!S.next(0, cur)) return;
    f32x4 acc[2][2][4][2];
#pragma unroll
    for (int a = 0; a < 2; ++a)
#pragma unroll
        for (int b = 0; b < 2; ++b)
#pragma unroll
            for (int m = 0; m < 4; ++m)
#pragma unroll
                for (int n = 0; n < 2; ++n) acc[a][b][m][n] = (f32x4){0.f, 0.f, 0.f, 0.f};
    bf16x8 At[4][2], B0[2][2], B1[2][2];
    const char* cA = (const char*)g.A + (size_t)cur.pm * tstep; const char* cB = (const char*)g.Bt + (size_t)cur.pn * tstep;
    S.a_ready(cur);
    if constexpr (SP2) {
        PG8_STAGE(PG8_SB(0, 0), cB, voffB); PG8_STAGE(PG8_SB(0, 1), cB + hstep, voffB); PG8_STAGE(PG8_SA(0, 0), cA, voffA); PG8_STAGE(PG8_SA(0, 1), cA + hstep, voffA);
        if (wr == 1) PG8_BAR;
        PG8_WAIT_V(2); PG8_BAR;
        PG8_STAGE(PG8_SB(1, 0), cB + kstep, voffB); PG8_STAGE(PG8_SA(1, 0), cA + kstep, voffA); PG8_STAGE(PG8_SB(1, 1), cB + hstep + kstep, voffB);
        PG8_WAIT_V(6); PG8_BAR;
    } else {
        PG8_STAGE(PG8_SB(0, 0), cB, voffB); PG8_STAGE(PG8_SA(0, 0), cA, voffA); PG8_STAGE(PG8_SB(0, 1), cB + hstep, voffB); PG8_STAGE(PG8_SA(0, 1), cA + hstep, voffA);
        if (wr == 1) PG8_BAR;
        PG8_WAIT_V(4); PG8_BAR;
        PG8_STAGE(PG8_SB(1, 0), cB + kstep, voffB); PG8_STAGE(PG8_SA(1, 0), cA + kstep, voffA); PG8_STAGE(PG8_SB(1, 1), cB + hstep + kstep, voffB);
        PG8_WAIT_V(6); PG8_BAR;
    }
    for (;;) {
        const bool has_next = S.next(ui + 1, nxt);
        const char* nA = has_next ? (const char*)g.A + (size_t)nxt.pm * tstep : cA; const char* nB = has_next ? (const char*)g.Bt + (size_t)nxt.pn * tstep : cB;
        for (int t = 0; t < nt; t += 2) {
            const bool last = (t == nt - 2);
            const char* a1 = cA + (size_t)(t + 1) * kstep;
            const char* a2 = last ? nA : cA + (size_t)(t + 2) * kstep; const char* b2 = last ? nB : cB + (size_t)(t + 2) * kstep;
            const char* a3 = a2 + kstep; const char* b3 = b2 + kstep;
            if (last && has_next) S.a_ready(nxt);
            if constexpr (SP2) {
            PG8_LDB(B0, 0, 0); PG8_LDB(B1, 0, 1); PG8_SCHED; PG8_LDA(At, 0, 0); PG8_STAGE(PG8_SA(1, 1), a1 + hstep, voffA);
            PG8_WAIT_V(8); PG8_WAIT_L(0); PG8_BAR; PG8_MMA(0, 0, At, B0); PG8_MMA(0, 1, At, B1); PG8_BAR; PG8_SCHED;
            PG8_LDA(At, 0, 1); PG8_STAGE(PG8_SB(0, 0), b2, voffB); PG8_STAGE(PG8_SB(0, 1), b2 + hstep, voffB); PG8_STAGE(PG8_SA(0, 0), a2, voffA);
            PG8_WAIT_V(8); PG8_WAIT_L(0); PG8_BAR; PG8_MMA(1, 0, At, B0); PG8_MMA(1, 1, At, B1); PG8_BAR; PG8_SCHED;
            PG8_LDB(B0, 1, 0); PG8_LDB(B1, 1, 1); PG8_SCHED; PG8_LDA(At, 1, 0); PG8_STAGE(PG8_SA(0, 1), a2 + hstep, voffA);
            PG8_WAIT_V(8); PG8_WAIT_L(0); PG8_BAR; PG8_MMA(0, 0, At, B0); PG8_MMA(0, 1, At, B1); PG8_BAR; PG8_SCHED;
            PG8_LDA(At, 1, 1); PG8_STAGE(PG8_SB(1, 0), b3, voffB); PG8_STAGE(PG8_SB(1, 1), b3 + hstep, voffB); PG8_STAGE(PG8_SA(1, 0), a3, voffA);
            PG8_WAIT_V(8); PG8_WAIT_L(0); PG8_BAR; PG8_MMA(1, 0, At, B0); PG8_MMA(1, 1, At, B1); PG8_BAR; PG8_SCHED;
            } else {
            PG8_LDB(B0, 0, 0); PG8_SCHED; PG8_LDA(At, 0, 0); PG8_STAGE(PG8_SA(1, 1), a1 + hstep, voffA);
            PG8_WAIT_L(8); PG8_BAR; PG8_WAIT_L(0); PG8_MMA(0, 0, At, B0); PG8_BAR; PG8_SCHED;
            PG8_LDB(B1, 0, 1); PG8_STAGE(PG8_SB(0, 0), b2, voffB);
            PG8_BAR; PG8_WAIT_L(0); PG8_MMA(0, 1, At, B1); PG8_BAR;
            PG8_LDA(At, 0, 1); PG8_STAGE(PG8_SA(0, 0), a2, voffA);
            PG8_BAR; PG8_WAIT_L(0); PG8_MMA(1, 0, At, B0); PG8_BAR; PG8_SCHED;
            PG8_STAGE(PG8_SB(0, 1), b2 + hstep, voffB);
            PG8_WAIT_V(6); PG8_BAR; PG8_MMA(1, 1, At, B1); PG8_BAR;
            PG8_LDB(B0, 1, 0); PG8_SCHED; PG8_LDA(At, 1, 0); PG8_STAGE(PG8_SA(0, 1), a2 + hstep, voffA);
            PG8_WAIT_L(8); PG8_BAR; PG8_WAIT_L(0); PG8_MMA(0, 0, At, B0); PG8_BAR; PG8_SCHED;
            PG8_LDB(B1, 1, 1); PG8_STAGE(PG8_SB(1, 0), b3, voffB);
            PG8_BAR; PG8_WAIT_L(0); PG8_MMA(0, 1, At, B1); PG8_BAR;
            PG8_LDA(At, 1, 1); PG8_STAGE(PG8_SA(1, 0), a3, voffA);
            PG8_BAR; PG8_WAIT_L(0); PG8_MMA(1, 0, At, B0); PG8_BAR; PG8_SCHED;
            PG8_STAGE(PG8_SB(1, 1), b3 + hstep, voffB);
            PG8_WAIT_V(6); PG8_BAR; PG8_MMA(1, 1, At, B1); PG8_BAR;
            }
        }
        if constexpr (ALIGN_EPI) { if (wr == 0) PG8_BAR; }
        if constexpr (!Epi::AFTER_DRAIN) { E(acc, cur, wr, wc, fr, fq); S.done(cur); }
        if (!has_next) break;
#pragma unroll
        for (int a = 0; a < 2; ++a)
#pragma unroll
            for (int b = 0; b < 2; ++b)
#pragma unroll
                for (int m = 0; m < 4; ++m)
#pragma unroll
                    for (int n = 0; n < 2; ++n) acc[a][b][m][n] = (f32x4){0.f, 0.f, 0.f, 0.f};
        cur = nxt; cA = nA; cB = nB; ++ui;
        if constexpr (ALIGN_EPI) { if (wr == 1) PG8_BAR; }
    }
    PG8_WAIT_V(0);
    if constexpr (!ALIGN_EPI) { if (wr == 0) PG8_BAR; }
    PG8_BAR;
    if constexpr (Epi::AFTER_DRAIN) { E.fused(acc, cur, wr, wc, fr, fq, lds, wid, lane); S.done(cur); }
#undef PG8_SA
#undef PG8_SB
#undef PG8_STAGE
#undef PG8_LDA
#undef PG8_LDB
#undef PG8_MMA
#undef PG8_WAIT_V
#undef PG8_WAIT_L
#undef PG8_BAR
#undef PG8_SCHED
}
}
namespace attn_body {
using bf16=__hip_bfloat16;
using bf16x8=__attribute__((ext_vector_type(8)))short;
using s16x4=__attribute__((ext_vector_type(4)))short;
using f32x16=__attribute__((ext_vector_type(16)))float;
using u32x4=__attribute__((ext_vector_type(4)))unsigned;
constexpr int BATCH=2,NHEAD=8,SEQ=8192,D=64,DM=NHEAD*D,DMO=1024,KVROWS=8320,KVOFF=112,MASKNT=130;
constexpr int NW=8,QBLK=32,QB=QBLK*NW,KVBLK=64,NQB=SEQ/QB;
constexpr int ATTN_UNIT_ROWS=QB;
__device__ __forceinline__ int crow(int r,int hi){return (r&3)+8*(r>>2)+4*hi;}
#define SBAR() __builtin_amdgcn_sched_barrier(0)
__device__ __forceinline__ void cmask(f32x16&p0,f32x16&p1,int jb,int qrel,int hi){
  const float NEG=-INFINITY; int kb=64*jb+4*hi;
  #pragma unroll
  for(int r=0;r<16;++r){int kv=kb+(r&3)+8*(r>>2); if(kv>qrel)p0[r]=NEG; if(kv+32>qrel)p1[r]=NEG;}
}

constexpr int NSLOT=3, SLOTB=8192;
constexpr int LDS_K=0, LDS_V=NSLOT*SLOTB, LDS_WS=2*NSLOT*SLOTB, LDS_OST=LDS_WS+NW*64*4, LDS_MK=LDS_OST+NW*4096, LDS_BYTES=LDS_MK+NW*512;
constexpr float C2=0.125f*1.4426950408889634f;
__device__ __forceinline__ void glds16(const void*gsrc,unsigned lds_dst){unsigned keep;
  asm volatile("s_mov_b32 %0, m0\n\ts_mov_b32 m0, %2\n\ts_nop 0\n\tglobal_load_lds_dwordx4 %1, off\n\ts_mov_b32 m0, %0":"=&s"(keep):"v"(gsrc),"s"(lds_dst):"memory");}
__device__ __forceinline__ void glds4(const void*gsrc,unsigned lds_dst){unsigned keep;
  asm volatile("s_mov_b32 %0, m0\n\ts_mov_b32 m0, %2\n\ts_nop 0\n\tglobal_load_lds_dword %1, off\n\ts_mov_b32 m0, %0":"=&s"(keep):"v"(gsrc),"s"(lds_dst):"memory");}
__device__ __forceinline__ float max3f(float a,float b,float c){float r;asm("v_max3_f32 %0, %1, %2, %3":"=v"(r):"v"(a),"v"(b),"v"(c));return r;}
__device__ __forceinline__ float max2f(float a,float b){float r;asm("v_max_f32_e32 %0, %1, %2":"=v"(r):"v"(a),"v"(b));return r;}
__device__ __forceinline__ float fadd_s(float a,float b){float r;asm("v_add_f32_e32 %0, %1, %2":"=v"(r):"v"(a),"v"(b));return r;}
__device__ __forceinline__ float fsub_s(float a,float b){float r;asm("v_sub_f32_e32 %0, %1, %2":"=v"(r):"v"(a),"v"(b));return r;}
typedef float f32x2_t __attribute__((ext_vector_type(2))); typedef __bf16 bf16x2_t __attribute__((ext_vector_type(2)));
__device__ __forceinline__ unsigned cvtpk_s(float lo,float hi){f32x2_t v={lo,hi};bf16x2_t b=__builtin_convertvector(v,bf16x2_t);return __builtin_bit_cast(unsigned,b);}
#define WAIT_BAR(N) asm volatile("s_waitcnt vmcnt(" #N ") lgkmcnt(0)\n\ts_barrier":::"memory")

__device__ __forceinline__ void qkt(f32x16&p0,f32x16&p1,const char*Kslot,const bf16x8*qr,const f32x16&negm,int r32,int hi){
  const char*kb=Kslot+hi*1024+r32*16;
  #pragma unroll
  for(int d0=0;d0<4;++d0){
    const bf16x8 b0=*reinterpret_cast<const bf16x8*>(kb+d0*2048);
    const bf16x8 b1=*reinterpret_cast<const bf16x8*>(kb+d0*2048+512);
    if(d0==0){p0=__builtin_amdgcn_mfma_f32_32x32x16_bf16(b0,qr[0],negm,0,0,0);p1=__builtin_amdgcn_mfma_f32_32x32x16_bf16(b1,qr[0],negm,0,0,0);}
    else{p0=__builtin_amdgcn_mfma_f32_32x32x16_bf16(b0,qr[d0],p0,0,0,0);p1=__builtin_amdgcn_mfma_f32_32x32x16_bf16(b1,qr[d0],p1,0,0,0);}}
}
typedef __attribute__((address_space(3))) const char* lds_cptr;
typedef short v4i16_t __attribute__((ext_vector_type(4)));
__device__ __forceinline__ void kload8(bf16x8*kf,lds_cptr kp){
  kf[0]=*(const __attribute__((address_space(3))) bf16x8*)(kp);      kf[1]=*(const __attribute__((address_space(3))) bf16x8*)(kp+512);
  kf[2]=*(const __attribute__((address_space(3))) bf16x8*)(kp+2048); kf[3]=*(const __attribute__((address_space(3))) bf16x8*)(kp+2560);
  kf[4]=*(const __attribute__((address_space(3))) bf16x8*)(kp+4096); kf[5]=*(const __attribute__((address_space(3))) bf16x8*)(kp+4608);
  kf[6]=*(const __attribute__((address_space(3))) bf16x8*)(kp+6144); kf[7]=*(const __attribute__((address_space(3))) bf16x8*)(kp+6656);
}
__device__ __forceinline__ void kload2(bf16x8*kf,lds_cptr kp,int j){ kf[2*j]=*(const __attribute__((address_space(3))) bf16x8*)(kp+j*2048); kf[2*j+1]=*(const __attribute__((address_space(3))) bf16x8*)(kp+j*2048+512); }
__device__ __forceinline__ s16x4 vtr(lds_cptr p){ return __builtin_bit_cast(s16x4,__builtin_amdgcn_ds_read_tr16_b64_v4i16((__attribute__((address_space(3))) v4i16_t*)p)); }
__device__ __forceinline__ float rowmax(const f32x16&p0,const f32x16&p1){
  float a=max3f(p0[0],p0[1],p1[0]),b=max3f(p0[2],p0[3],p1[1]);a=max3f(a,p1[2],p1[3]);
  #pragma unroll
  for(int r=4;r<16;r+=4){a=max3f(a,p0[r],p0[r+1]);b=max3f(b,p0[r+2],p0[r+3]);a=max3f(a,p1[r],p1[r+1]);b=max3f(b,p1[r+2],p1[r+3]);}
  const float m=max2f(a,b);
  auto rr=__builtin_amdgcn_permlane32_swap(__float_as_uint(m),__float_as_uint(m),false,false);
  return max2f(__uint_as_float(rr[0]),__uint_as_float(rr[1]));
}
__device__ __forceinline__ void pv(f32x16*o,int vb,bf16x8 pa0,bf16x8 pa1,bf16x8 pa2,bf16x8 pa3){
  #pragma unroll
  for(int d0=0;d0<2;++d0){s16x4 lo[4],hi[4];
    #pragma unroll
    for(int ks=0;ks<4;++ks){
      asm volatile("ds_read_b64_tr_b16 %0,%1 offset:%c2":"=&v"(lo[ks]):"v"(vb),"i"(d0*4096+ks*1024):"memory");
      asm volatile("ds_read_b64_tr_b16 %0,%1 offset:%c2":"=&v"(hi[ks]):"v"(vb),"i"(d0*4096+ks*1024+512):"memory");}
    asm volatile("s_waitcnt lgkmcnt(0)":::"memory");SBAR();
    #define PK(k) (bf16x8){lo[k][0],lo[k][1],lo[k][2],lo[k][3],hi[k][0],hi[k][1],hi[k][2],hi[k][3]}
    o[d0]=__builtin_amdgcn_mfma_f32_32x32x16_bf16(pa0,PK(0),o[d0],0,0,0);
    o[d0]=__builtin_amdgcn_mfma_f32_32x32x16_bf16(pa1,PK(1),o[d0],0,0,0);
    o[d0]=__builtin_amdgcn_mfma_f32_32x32x16_bf16(pa2,PK(2),o[d0],0,0,0);
    o[d0]=__builtin_amdgcn_mfma_f32_32x32x16_bf16(pa3,PK(3),o[d0],0,0,0);
    #undef PK
  }
}

#ifndef ATTN_STORE16
#define ATTN_STORE16(p,v) (*(u32x4*)(p)=(v))
#endif
template<int THRL> __device__ __forceinline__ void attn_unit(int b,int h,int qb,const bf16*Q,const bf16*__restrict__ K,const bf16*__restrict__ V,bf16*O,const unsigned*__restrict__ MK,char*shm){
  const int tid=threadIdx.x,lane=tid&63,r32=lane&31,hi=lane>>5; const int wid=__builtin_amdgcn_readfirstlane(tid>>6);
  const long rowbase=(long)b*SEQ, kvbase=(long)b*KVROWS; const int q0=qb*QB;
  const bf16*Qw=Q+(rowbase+q0+wid*QBLK)*DM+h*D;
  const bf16*Kh=K+kvbase*DM+h*D,*Vh=V+kvbase*DM+h*D;
  const unsigned lds0=(unsigned)(uintptr_t)shm;
  float*wsf=(float*)(shm+LDS_WS)+wid*64;
  const bf16*ksrc=Kh+(long)lane*DM+wid*8;
  const bf16*vsrc=Vh+(long)(16*(wid&3)+(lane>>2))*DM+(wid>>2)*32+(lane&3)*8;
  const unsigned kdst=lds0+LDS_K+wid*1024, vdst=lds0+LDS_V+wid*1024;
  #define DMA_K(t,slot) glds16(ksrc+(long)(t)*KVBLK*DM,(unsigned)__builtin_amdgcn_readfirstlane(kdst+(slot)))
  #define DMA_V(t,slot) glds16(vsrc+(long)(t)*KVBLK*DM,(unsigned)__builtin_amdgcn_readfirstlane(vdst+(slot)))
  const int vb0=(int)(lds0+LDS_V)+((lane>>4)&1)*32+(lane&3)*8+(4*hi+((lane&15)>>2))*64;
  const char*Kbase=shm+LDS_K; bf16x8 kf[8];
  const lds_cptr shm3=(lds_cptr)shm; const lds_cptr kp0=shm3+LDS_K+hi*1024+r32*16; const lds_cptr vp0=shm3+LDS_V+((lane>>4)&1)*32+(lane&3)*8+(4*hi+((lane&15)>>2))*64;
  const int NT=(q0+QB+128)/KVBLK;
  const char*msrc=(const char*)MK+(((rowbase+q0)/QBLK+wid)*(long)MASKNT)*256+lane*4;
  const unsigned mdst=lds0+LDS_MK+wid*512;
  typedef unsigned u32x2_t __attribute__((ext_vector_type(2)));
  u32x2_t mwc;
  #define MLOAD(S,t) glds4(msrc+256l*(t),(unsigned)__builtin_amdgcn_readfirstlane(mdst+(S)*256))
  #define MROT(S) do{ const u32x2_t w_=*(const __attribute__((address_space(3))) u32x2_t*)((lds_cptr)shm+LDS_MK+wid*512+(S)*256+r32*8); mwc.x=w_.x>>(4*hi); mwc.y=w_.y>>(4*hi); }while(0)
  MLOAD(1,0); MLOAD(0,1);
  DMA_K(0,0);DMA_V(0,0);DMA_K(1,SLOTB);
  bf16x8 qr[4];
  #pragma unroll
  for(int d0=0;d0<4;++d0)qr[d0]=*reinterpret_cast<const bf16x8*>(&Qw[(long)r32*DM+d0*16+hi*8]);
  float mhat=0.f,l_reg=0.f;f32x16 o[2];o[0]=f32x16{};o[1]=f32x16{};f32x16 negm=f32x16{};asm volatile("":"+v"(negm));
  const int qrel=wid*QBLK+r32;
  #define CMASK(P0,P1,t) do{}while(0)
  bool resc=false;
  #define START(P0,P1) do{ const float rm=rowmax(P0,P1); resc=false; \
    { const float dl=rm; mhat=fadd_s(mhat,dl); \
      _Pragma("unroll") for(int r=0;r<16;++r){P0[r]=fsub_s(P0[r],dl);P1[r]=fsub_s(P1[r],dl);} \
      _Pragma("unroll") for(int r=0;r<16;++r)negm[r]=-mhat; asm volatile("":"+v"(negm)); } \
    _Pragma("unroll") for(int r=0;r<16;++r)P0[r]=__builtin_amdgcn_exp2f(P0[r]); }while(0)
  #define RESC() do{ if(resc){ asm volatile("s_waitcnt lgkmcnt(0)":::"memory"); \
      _Pragma("unroll") for(int d_=0;d_<2;++d_) _Pragma("unroll") for(int r=0;r<16;++r)o[d_][r]*=wsf[crow(r,hi)]; } }while(0)
  f32x16 pA0,pA1,pB0,pB1;
  int sl_prev=0,sl_cur=0,sl_next=SLOTB;
  #define ROT() do{sl_prev=sl_cur;sl_cur=sl_next;sl_next=(sl_next==(NSLOT-1)*SLOTB)?0:sl_next+SLOTB;}while(0)
  DMA_K(2,2*SLOTB);
  WAIT_BAR(3); MROT(1);
  qkt(pA0,pA1,Kbase,qr,negm,r32,hi);asm volatile("s_nop 15\n\ts_nop 7":"+v"(pA0),"+v"(pA1));CMASK(pA0,pA1,0);
  START(pA0,pA1);
  _Pragma("unroll") for(int r=0;r<16;++r)pA1[r]=__builtin_amdgcn_exp2f(pA1[r]);
  WAIT_BAR(0);
  DMA_K(3,0);DMA_V(1,SLOTB);
  ROT();
  kload8(kf,kp0+sl_cur);
  WAIT_BAR(2);
  s16x4 vlo[8],vhi[8]; u32x4 pw0,pw1,pw2,pw3;
  #define PKW(P,B) cvtpk_s(P[B],P[B+1])
  #define PAF(k) __builtin_bit_cast(bf16x8,pw##k)
  #define VFR(i) (bf16x8){vlo[i][0],vlo[i][1],vlo[i][2],vlo[i][3],vhi[i][0],vhi[i][1],vhi[i][2],vhi[i][3]}
  #define PIN(x) asm volatile("":"+v"(x))
  #define MX3(a,b,c) __builtin_fmaxf(__builtin_fmaxf((a),(b)),(c))
  #define MK(P,W,r) do{ unsigned m_; asm("v_bfe_i32 %0, %1, %2, 1":"=v"(m_):"v"(W),"n"(((r)&3)+8*((r)>>2))); P[r]=__uint_as_float(__float_as_uint(P[r])&m_); }while(0)
  #define GAPA(MF,M0,M1,M2,M3,A0,A1,A2,A3,W0,W1,PW) do{ MF; M0; M1; M2; M3; sacc+=A0; sacc+=A1; sacc+=A2; sacc+=A3; PIN(sacc); W0; W1; PIN(PW); SBAR(); }while(0)
  #define EX(v) __builtin_amdgcn_exp2f(v)
  #define GAPB(MF,X,B) do{ MF; X[B]=EX(X[B]); X[B+1]=EX(X[B+1]); X[B+2]=EX(X[B+2]); X[B+3]=EX(X[B+3]); PIN(X); SBAR(); }while(0)
  #define VRD(i) do{ vlo[i]=vtr(vp_+(((i)>>2)*4096+((i)&3)*1024)); vhi[i]=vtr(vp_+(((i)>>2)*4096+((i)&3)*1024+512)); }while(0)
  #define KRD(G,j) do{ if(G){ kload2(kf,kp0+sl_next,j); SBAR(); } }while(0)
  #define STEP(C0,C1,P0,P1,t,GK,GV,GL,MR) do{ SBAR(); \
    const lds_cptr vp_=vp0+sl_prev; \
    VRD(0); SBAR(); MK(P0,mwc.x,0); MK(P0,mwc.x,1); float sacc=(P0[0]+P0[1]); \
    GAPA(C0=__builtin_amdgcn_mfma_f32_32x32x16_bf16(kf[0],qr[0],negm,0,0,0), MK(P0,mwc.x,2),MK(P0,mwc.x,3),MK(P0,mwc.x,4),MK(P0,mwc.x,5),     P0[2],P0[3],P0[4],P0[5],     pw0[0]=PKW(P0,0), pw0[1]=PKW(P0,2), pw0); \
    VRD(4); SBAR(); GAPA(C1=__builtin_amdgcn_mfma_f32_32x32x16_bf16(kf[1],qr[0],negm,0,0,0), MK(P0,mwc.x,6),MK(P0,mwc.x,7),MK(P0,mwc.x,8),MK(P0,mwc.x,9),     P0[6],P0[7],P0[8],P0[9],     pw0[2]=PKW(P0,4), pw0[3]=PKW(P0,6), pw0); \
    VRD(1); SBAR(); GAPA(C0=__builtin_amdgcn_mfma_f32_32x32x16_bf16(kf[2],qr[1],C0,0,0,0),   MK(P0,mwc.x,10),MK(P0,mwc.x,11),MK(P0,mwc.x,12),MK(P0,mwc.x,13), P0[10],P0[11],P0[12],P0[13], pw1[0]=PKW(P0,8), pw1[1]=PKW(P0,10), pw1); \
    VRD(5); SBAR(); GAPA(C1=__builtin_amdgcn_mfma_f32_32x32x16_bf16(kf[3],qr[1],C1,0,0,0),   MK(P0,mwc.x,14),MK(P0,mwc.x,15),MK(P1,mwc.y,0),MK(P1,mwc.y,1),   P0[14],P0[15],P1[0],P1[1],   pw1[2]=PKW(P0,12),pw1[3]=PKW(P0,14), pw1); \
    VRD(2); SBAR(); GAPA(C0=__builtin_amdgcn_mfma_f32_32x32x16_bf16(kf[4],qr[2],C0,0,0,0),   MK(P1,mwc.y,2),MK(P1,mwc.y,3),MK(P1,mwc.y,4),MK(P1,mwc.y,5),     P1[2],P1[3],P1[4],P1[5],     pw2[0]=PKW(P1,0), pw2[1]=PKW(P1,2), pw2); \
    VRD(6); SBAR(); GAPA(C1=__builtin_amdgcn_mfma_f32_32x32x16_bf16(kf[5],qr[2],C1,0,0,0),   MK(P1,mwc.y,6),MK(P1,mwc.y,7),MK(P1,mwc.y,8),MK(P1,mwc.y,9),     P1[6],P1[7],P1[8],P1[9],     pw2[2]=PKW(P1,4), pw2[3]=PKW(P1,6), pw2); \
    VRD(3); SBAR(); GAPA(C0=__builtin_amdgcn_mfma_f32_32x32x16_bf16(kf[6],qr[3],C0,0,0,0),   MK(P1,mwc.y,10),MK(P1,mwc.y,11),MK(P1,mwc.y,12),MK(P1,mwc.y,13), P1[10],P1[11],P1[12],P1[13], pw3[0]=PKW(P1,8), pw3[1]=PKW(P1,10), pw3); \
    VRD(7); SBAR(); GAPA(C1=__builtin_amdgcn_mfma_f32_32x32x16_bf16(kf[7],qr[3],C1,0,0,0),   MK(P1,mwc.y,14),MK(P1,mwc.y,15),(void)0,(void)0,                P1[14],P1[15],0.f,0.f,       pw3[2]=PKW(P1,12),pw3[3]=PKW(P1,14), pw3); \
    l_reg+=sacc; \
    if(GK){DMA_K((t)+3,sl_cur);} if(GV){DMA_V((t)+1,sl_next); MLOAD(MR,(t)+1);} \
    CMASK(C0,C1,t); \
    { float a=MX3(C0[0],C0[1],C1[0]),b=MX3(C0[2],C0[3],C1[1]); a=MX3(a,C1[2],C1[3]); \
      _Pragma("unroll") for(int r=4;r<16;r+=4){a=MX3(a,C0[r],C0[r+1]);b=MX3(b,C0[r+2],C0[r+3]);a=MX3(a,C1[r],C1[r+1]);b=MX3(b,C1[r+2],C1[r+3]);} \
      float rm=__builtin_fmaxf(a,b); { auto rr=__builtin_amdgcn_permlane32_swap(__float_as_uint(rm),__float_as_uint(rm),false,false); rm=__builtin_fmaxf(__uint_as_float(rr[0]),__uint_as_float(rr[1])); } \
      resc=false; \
      if(__builtin_expect(__any(rm>(float)THRL),0)){ const float dl=__builtin_fmaxf(rm,0.f); mhat+=dl; \
        _Pragma("unroll") for(int r=0;r<16;++r){C0[r]-=dl;C1[r]-=dl;} \
        _Pragma("unroll") for(int r=0;r<16;++r)negm[r]=-mhat; asm volatile("":"+v"(negm)); \
        const float f=__builtin_amdgcn_exp2f(-dl); l_reg*=f; if(hi==0)wsf[r32]=f; resc=true; } } \
    SBAR(); \
    GAPB(o[0]=__builtin_amdgcn_mfma_f32_32x32x16_bf16(PAF(0),VFR(0),o[0],0,0,0), C0,0); \
    GAPB(o[1]=__builtin_amdgcn_mfma_f32_32x32x16_bf16(PAF(0),VFR(4),o[1],0,0,0), C0,4); \
    KRD(GL,0); GAPB(o[0]=__builtin_amdgcn_mfma_f32_32x32x16_bf16(PAF(1),VFR(1),o[0],0,0,0), C0,8); \
    KRD(GL,1); GAPB(o[1]=__builtin_amdgcn_mfma_f32_32x32x16_bf16(PAF(1),VFR(5),o[1],0,0,0), C0,12); \
    KRD(GL,2); GAPB(o[0]=__builtin_amdgcn_mfma_f32_32x32x16_bf16(PAF(2),VFR(2),o[0],0,0,0), C1,0); \
    KRD(GL,3); GAPB(o[1]=__builtin_amdgcn_mfma_f32_32x32x16_bf16(PAF(2),VFR(6),o[1],0,0,0), C1,4); \
    GAPB(o[0]=__builtin_amdgcn_mfma_f32_32x32x16_bf16(PAF(3),VFR(3),o[0],0,0,0), C1,8); \
    GAPB(o[1]=__builtin_amdgcn_mfma_f32_32x32x16_bf16(PAF(3),VFR(7),o[1],0,0,0), C1,12); \
    }while(0)
  int t=1;
  #undef CMASK
  #define CMASK(P0,P1,t) do{}while(0)
  for(;t+5<NT;t+=2){
    STEP(pB0,pB1,pA0,pA1,t,true,true,true,1);     WAIT_BAR(3); MROT(0); RESC(); ROT();
    STEP(pA0,pA1,pB0,pB1,t+1,true,true,true,0);   WAIT_BAR(3); MROT(1); RESC(); ROT();
  }
  #undef CMASK
  #define CMASK(P0,P1,t) do{}while(0)
  #define ENDW(tt) do{ if((tt)+3<NT){WAIT_BAR(3);} else if((tt)+2<NT){WAIT_BAR(2);} else {WAIT_BAR(0);} }while(0)
  for(;t+1<NT;t+=2){
    STEP(pB0,pB1,pA0,pA1,t,(t+3<NT),(t+1<NT),(t+1<NT),1);       ENDW(t);   MROT(0); RESC(); ROT();
    STEP(pA0,pA1,pB0,pB1,t+1,(t+4<NT),(t+2<NT),(t+2<NT),0);     ENDW(t+1); MROT(1); RESC(); ROT();
  }
  STEP(pB0,pB1,pA0,pA1,NT-1,false,false,false,1); RESC();
  asm volatile("s_waitcnt vmcnt(0)":::"memory"); MROT(0);
  { _Pragma("unroll") for(int r=0;r<16;++r){ MK(pB0,mwc.x,r); MK(pB1,mwc.y,r); } }
  { float sacc=pB0[0]+pB0[1]; _Pragma("unroll") for(int r=2;r<16;++r)sacc+=pB0[r]; _Pragma("unroll") for(int r=0;r<16;++r)sacc+=pB1[r]; l_reg+=sacc;
    pw0=(u32x4){PKW(pB0,0),PKW(pB0,2),PKW(pB0,4),PKW(pB0,6)};pw1=(u32x4){PKW(pB0,8),PKW(pB0,10),PKW(pB0,12),PKW(pB0,14)};pw2=(u32x4){PKW(pB1,0),PKW(pB1,2),PKW(pB1,4),PKW(pB1,6)};pw3=(u32x4){PKW(pB1,8),PKW(pB1,10),PKW(pB1,12),PKW(pB1,14)};
    SBAR(); pv(o,vb0+sl_cur,PAF(0),PAF(1),PAF(2),PAF(3)); }
  #undef PKW
  #undef PAF
  #undef VFR
  #undef PIN
  #undef MX3
  #undef GAPA
  #undef MK
  #undef GAPB
  #undef EX
  #undef VRD
  #undef KRD
  #undef STEP
  #undef ENDW
  {auto rr=__builtin_amdgcn_permlane32_swap(__float_as_uint(l_reg),__float_as_uint(l_reg),false,false);l_reg=__uint_as_float(rr[0])+__uint_as_float(rr[1]);}
  if(hi==0)wsf[32+r32]=l_reg;asm volatile("s_waitcnt lgkmcnt(0)":::"memory");
  float rli[16];
  #pragma unroll
  for(int r=0;r<16;++r)rli[r]=__builtin_amdgcn_rcpf(wsf[32+crow(r,hi)]);
  bf16*Ow=O+(rowbase+q0+wid*QBLK)*DMO+h*D;
  { bf16*stg=(bf16*)(shm+LDS_OST)+wid*2048;
    #pragma unroll
    for(int r=0;r<16;++r){const int orow=crow(r,hi);
      #pragma unroll
      for(int d0=0;d0<2;++d0)stg[orow*64+d0*32+r32]=__float2bfloat16(o[d0][r]*rli[r]);}
    asm volatile("s_waitcnt lgkmcnt(0)":::"memory");
    #pragma unroll
    for(int i=0;i<4;++i){const int row=i*8+(lane>>3),ch=lane&7; const u32x4 v=*(const u32x4*)(stg+row*64+ch*8); ATTN_STORE16(Ow+(long)row*DMO+ch*8,v);} }
  asm volatile("s_waitcnt lgkmcnt(0)\n\ts_barrier":::"memory");
  #undef MLOAD
  #undef MROT
  #undef DMA_K
  #undef DMA_V
  #undef CMASK
  #undef START
  #undef RESC
  #undef ROT
}
constexpr int ATTN_LDS_BYTES=LDS_BYTES;
struct AttnTensors { const bf16* Q; const bf16* K; const bf16* V; bf16* O; const unsigned* MK; };
struct AttnUnit { int bh; int qb; };
struct StaticOrder {
  int vcu, grid;
  __device__ __forceinline__ explicit StaticOrder(int grid_,int block):vcu((grid_%8==0)?(block%8)*(grid_/8)+block/8:block),grid(grid_){}
  __device__ __forceinline__ bool next(int i,AttnUnit&u)const{ const int L=i*grid+vcu; if(L>=512)return false; const int pr=L>>1;
    if(grid==256){ if(i>=2)return false; const int s=vcu&15; u.bh=vcu>>4; u.qb=(i==0)?s:31-s; return true; }
    u.bh=L>>5; u.qb=L&31; (void)pr; return true; }
  __device__ __forceinline__ void a_ready(const AttnUnit&)const{}
  __device__ __forceinline__ void done(const AttnUnit&)const{}
};
template<class Sched,int THRL=8> __device__ __forceinline__ void attn_phase(char*lds,const AttnTensors&T,const Sched&S){
  AttnUnit u;
  for(int i=0;S.next(i,u);++i){ S.a_ready(u); attn_unit<THRL>(u.bh/NHEAD,u.bh%NHEAD,u.qb,T.Q,T.K,T.V,T.O,T.MK,lds); S.done(u); }
}
#undef SBAR
#undef WAIT_BAR
}

typedef _Float16 f16;
__device__ __forceinline__ unsigned short f2h(float f) { const f16 h = (f16)f; return __builtin_bit_cast(unsigned short, h); }
__device__ __forceinline__ float h2f(unsigned short u) { return (float)__builtin_bit_cast(f16, u); }
__device__ __forceinline__ float bflo(unsigned p) { return __uint_as_float(p << 16); }
__device__ __forceinline__ float bfhi(unsigned p) { return __uint_as_float(p & 0xffff0000u); }
constexpr float C2 = 0.125f * 1.4426950408889634f;
constexpr int KIW = 72;
constexpr int MPW = 264, MASKNT = 130;
constexpr int KVROWS = 8320, KVOFF = 112;

struct EpiF32 {
  static constexpr bool PERM = false, AFTER_DRAIN = false;
  float* C; int ldc, Mreal, Nreal;
  __device__ __forceinline__ void operator()(const pg8::f32x4 (&acc)[2][2][4][2], const pg8::Unit& u, int wr, int wc, int fr, int fq) const {
#pragma unroll
    for (int ai = 0; ai < 2; ++ai)
#pragma unroll
      for (int m = 0; m < 4; ++m) {
        const int r = u.pm * 256 + ai * 128 + wr * 64 + m * 16 + fr;
        if (r >= Mreal) continue;
#pragma unroll
        for (int bj = 0; bj < 2; ++bj)
#pragma unroll
          for (int n = 0; n < 2; ++n) {
            const int c = u.pn * 256 + bj * 128 + wc * 32 + n * 16 + 4 * fq;
            if (c < Nreal) *(pg8::f32x4*)(C + (size_t)r * ldc + c) = acc[ai][bj][m][n];
          }
      }
  }
};

struct EpiInProj {
  static constexpr bool PERM = false, AFTER_DRAIN = false;
  bf16_t* ub; bf16_t* qkvq; size_t kstride; float* kiw; const float* ropetab;
  __device__ __forceinline__ void operator()(const pg8::f32x4 (&acc)[2][2][4][2], const pg8::Unit& u, int wr, int wc, int fr, int fq) const {
    const int pn = u.pn;
#pragma unroll
    for (int ai = 0; ai < 2; ++ai)
#pragma unroll
      for (int m = 0; m < 4; ++m) {
        const int r = u.pm * 256 + ai * 128 + wr * 64 + m * 16 + fr;
        const bool rok = r < NROWS;
        int t = r < NR ? (r & (SEQ - 1)) + NMETA : ((r - NR) & 15);
        if (!rok) t = 0;
        if (pn < 4) {
#pragma unroll
          for (int n = 0; n < 2; ++n) {
            const pg8::f32x4 av = acc[ai][0][m][n], gv = acc[ai][1][m][n];
            float o[4];
#pragma unroll
            for (int j = 0; j < 4; ++j) o[j] = av[j] / (1.0f + __expf(-gv[j]));
            const int col = pn * 128 + wc * 32 + n * 16 + 4 * fq;
            if (rok) *(uint2*)(ub + (size_t)r * 512 + col) = make_uint2(pk2(o[0], o[1]), pk2(o[2], o[3]));
          }
        } else if (pn < 12) {
          const int kind = (pn - 4) >> 1, cbase = ((pn - 4) & 1) * 256;
#pragma unroll
          for (int bj = 0; bj < 2; ++bj)
#pragma unroll
            for (int n = 0; n < 2; ++n) {
              pg8::f32x4 v = acc[ai][bj][m][n];
              if (n == 0 && kind != 2 && (wc & 1) == 0) {
                const pg8::f32x4 cs = *(const pg8::f32x4*)(ropetab + t * 16 + 4 * (fq & 1)), sn = *(const pg8::f32x4*)(ropetab + t * 16 + 8 + 4 * (fq & 1));
#pragma unroll
                for (int j = 0; j < 4; ++j) { const float p = __shfl_xor(v[j], 32); v[j] = fq < 2 ? v[j] * cs[j] - p * sn[j] : v[j] * cs[j] + p * sn[j]; }
              }
              const int col = cbase + bj * 128 + wc * 32 + n * 16 + 4 * fq;
              const int bb = r < NR ? (r >> 13) : ((r - NR) >> 4);
              const size_t drow = (kind == 1 || kind == 2) ? (size_t)bb * KVROWS + KVOFF + t : (size_t)r;
              bf16_t* dst = qkvq + (size_t)kind * kstride + drow * 512 + col;
              if (kind == 3) {
                if (rok) *(uint2*)dst = make_uint2((unsigned)f2h(v[0]) | ((unsigned)f2h(v[1]) << 16), (unsigned)f2h(v[2]) | ((unsigned)f2h(v[3]) << 16));
              } else {
                if (kind == 0) v = v * C2;
                if (rok) *(uint2*)dst = make_uint2(pk2(v[0], v[1]), pk2(v[2], v[3]));
              }
            }
        } else {
#pragma unroll
          for (int n = 0; n < 2; ++n) {
            const int col = wc * 32 + n * 16 + 4 * fq;
            if (rok && col < KIW) *(pg8::f32x4*)(kiw + (size_t)r * KIW + col) = acc[ai][0][m][n];
          }
        }
      }
  }
};

__device__ __forceinline__ void transpose_item(const float* __restrict__ W, int K, int N, bf16_t* __restrict__ WT, int ldt, float* scr, int k0, int n0, int drow0, int lane) {
  float rr[32];
#pragma unroll
  for (int i = 0; i < 32; ++i) { const int kk = 2 * i + (lane >> 5), n = n0 + (lane & 31); rr[i] = n < N ? W[(size_t)(k0 + kk) * N + n] : 0.f; }
#pragma unroll
  for (int i = 0; i < 32; ++i) scr[(2 * i + (lane >> 5)) * 33 + (lane & 31)] = rr[i];
  asm volatile("s_waitcnt lgkmcnt(0)" ::: "memory");
  const int c = lane & 7;
#pragma unroll
  for (int j = 0; j < 4; ++j) { const int n = (lane >> 3) + 8 * j; const float* p = scr + (8 * c) * 33 + n;
    uint4 o; o.x = pk2(p[0 * 33], p[1 * 33]); o.y = pk2(p[2 * 33], p[3 * 33]); o.z = pk2(p[4 * 33], p[5 * 33]); o.w = pk2(p[6 * 33], p[7 * 33]);
    *(uint4*)(WT + (size_t)(drow0 + n) * ldt + k0 + 8 * c) = o; }
  asm volatile("s_waitcnt lgkmcnt(0)" ::: "memory");
}
__device__ __forceinline__ int winT_row(int c) {
  if (c < 512) return (c >> 7) * 256 + (c & 127);
  if (c < 1024) return ((c - 512) >> 7) * 256 + 128 + ((c - 512) & 127);
  return c;
}

struct XUnit { int pm, pn, e; };
template <class Epi, class Sched, bool GATHER, int K, unsigned apitch>
__device__ __forceinline__ void gemm_phase_x(PG8_LAS unsigned char* lds, const bf16_t* Abase, const Sched& S, const Epi& E) {
  using namespace pg8;
  int tid = threadIdx.x; asm volatile("" : "+v"(tid));
  const int wid = __builtin_amdgcn_readfirstlane(tid >> 6), lane = tid & 63, wr = wid >> 2, wc = wid & 3, fr = lane & 15, fq = lane >> 4;
  constexpr int nt = K / BK;
  unsigned voffB[2], vAc[2][2], vAn[2][2]; int Rl[2]; unsigned cOff[2];
#pragma unroll
  for (int i = 0; i < 2; ++i) { int R, C; stage_rc(tid * 16 + i * 8192, R, C); Rl[i] = R; cOff[i] = (unsigned)C * 2u; const int Rb = Epi::PERM ? ((R & ~31) + perm32(R & 31)) : R; voffB[i] = (unsigned)(Rb * K + C) * 2u; }
  constexpr size_t kstep = (size_t)(BK * 2), hstepB = (size_t)HALF * K * 2;
  const unsigned ldsw = (unsigned)wid * 1024u;
  const int aoff = lds_byte(wr * 64 + fr, fq * 8), boff = lds_byte(wc * 32 + fr, fq * 8);
#define X_SA(b, h) (((b) * 2 + (h)) * HTB)
#define X_SB(b, h) ((4 + (b) * 2 + (h)) * HTB)
#define X_STAGE(bufoff, gbase, voff) do { _Pragma("unroll") for (int _i = 0; _i < 2; ++_i) \
        __builtin_amdgcn_global_load_lds((const unsigned*)((const char*)(gbase) + (voff)[_i]), (PG8_LAS unsigned*)(lds + (bufoff) + ldsw + _i * 8192), 16, 0, 0); } while (0)
#define X_LDA(dst, b, h) do { _Pragma("unroll") for (int m = 0; m < 4; ++m) _Pragma("unroll") for (int k = 0; k < 2; ++k) dst[m][k] = *(const PG8_LAS bf16x8*)(lds + X_SA(b, h) + aoff + m * 2048 + k * 1024); } while (0)
#define X_LDB(dst, b, h) do { _Pragma("unroll") for (int n = 0; n < 2; ++n) _Pragma("unroll") for (int k = 0; k < 2; ++k) dst[n][k] = *(const PG8_LAS bf16x8*)(lds + X_SB(b, h) + boff + n * 2048 + k * 1024); } while (0)
#define X_MMA(ai, bj, At, Bt) do { __builtin_amdgcn_s_setprio(1); _Pragma("unroll") for (int m = 0; m < 4; ++m) _Pragma("unroll") for (int n = 0; n < 2; ++n) _Pragma("unroll") for (int k = 0; k < 2; ++k) \
        acc[ai][bj][m][n] = __builtin_amdgcn_mfma_f32_16x16x32_bf16(Bt[n][k], At[m][k], acc[ai][bj][m][n], 0, 0, 0); __builtin_amdgcn_s_setprio(0); } while (0)
#define X_WAIT_V(n) asm volatile("s_waitcnt vmcnt(" #n ")" ::: "memory")
#define X_WAIT_L(n) asm volatile("s_waitcnt lgkmcnt(" #n ")" ::: "memory")
#define X_BAR __builtin_amdgcn_s_barrier()
#define X_SCHED __builtin_amdgcn_sched_barrier(0)
#define X_SETV(dst, u) do { if constexpr (GATHER) { const int* rw_ = S.rows(u); _Pragma("unroll") for (int h = 0; h < 2; ++h) _Pragma("unroll") for (int i = 0; i < 2; ++i) dst[h][i] = (unsigned)rw_[h * HALF + Rl[i]] * apitch + cOff[i]; } \
        else { _Pragma("unroll") for (int h = 0; h < 2; ++h) _Pragma("unroll") for (int i = 0; i < 2; ++i) dst[h][i] = (unsigned)(h * HALF + Rl[i]) * apitch + cOff[i]; } } while (0)
  XUnit cur, nxt; int ui = 0;
  if (!S.next(0, cur)) return;
  f32x4 acc[2][2][4][2];
#pragma unroll
  for (int a = 0; a < 2; ++a)
#pragma unroll
    for (int b = 0; b < 2; ++b)
#pragma unroll
      for (int m = 0; m < 4; ++m)
#pragma unroll
        for (int n = 0; n < 2; ++n) acc[a][b][m][n] = (f32x4){0.f, 0.f, 0.f, 0.f};
  bf16x8 At[4][2], B0[2][2], B1[2][2];
  const char* cA = GATHER ? (const char*)Abase : (const char*)S.a_ptr(cur); const char* cB = (const char*)S.b_ptr(cur);
  X_SETV(vAc, cur);
  X_STAGE(X_SB(0, 0), cB, voffB); X_STAGE(X_SB(0, 1), cB + hstepB, voffB); X_STAGE(X_SA(0, 0), cA, vAc[0]); X_STAGE(X_SA(0, 1), cA, vAc[1]);
  if (wr == 1) X_BAR;
  X_WAIT_V(2); X_BAR;
  X_STAGE(X_SB(1, 0), cB + kstep, voffB); X_STAGE(X_SA(1, 0), cA + kstep, vAc[0]); X_STAGE(X_SB(1, 1), cB + hstepB + kstep, voffB);
  X_WAIT_V(6); X_BAR;
  for (;;) {
    const bool has_next = S.next(ui + 1, nxt);
    const char* nA = has_next ? (GATHER ? (const char*)Abase : (const char*)S.a_ptr(nxt)) : cA; const char* nB = has_next ? (const char*)S.b_ptr(nxt) : cB;
    if (has_next) { X_SETV(vAn, nxt); } else {
#pragma unroll
      for (int h = 0; h < 2; ++h)
#pragma unroll
        for (int i = 0; i < 2; ++i) vAn[h][i] = vAc[h][i]; }
#pragma unroll 1
    for (int t = 0; t < nt; t += 2) {
      const bool last = (t == nt - 2);
      const char* a1 = cA + (size_t)(t + 1) * kstep;
      const char* a2 = last ? nA : cA + (size_t)(t + 2) * kstep; const char* b2 = last ? nB : cB + (size_t)(t + 2) * kstep;
      const char* a3 = a2 + kstep; const char* b3 = b2 + kstep;
      unsigned v0[2], v1[2];
#pragma unroll
      for (int i = 0; i < 2; ++i) { v0[i] = last ? vAn[0][i] : vAc[0][i]; v1[i] = last ? vAn[1][i] : vAc[1][i]; }
      X_LDB(B0, 0, 0); X_LDB(B1, 0, 1); X_SCHED; X_LDA(At, 0, 0); X_STAGE(X_SA(1, 1), a1, vAc[1]);
      X_WAIT_V(8); X_WAIT_L(0); X_BAR; X_MMA(0, 0, At, B0); X_MMA(0, 1, At, B1); X_BAR; X_SCHED;
      X_LDA(At, 0, 1); X_STAGE(X_SB(0, 0), b2, voffB); X_STAGE(X_SB(0, 1), b2 + hstepB, voffB); X_STAGE(X_SA(0, 0), a2, v0);
      X_WAIT_V(8); X_WAIT_L(0); X_BAR; X_MMA(1, 0, At, B0); X_MMA(1, 1, At, B1); X_BAR; X_SCHED;
      X_LDB(B0, 1, 0); X_LDB(B1, 1, 1); X_SCHED; X_LDA(At, 1, 0); X_STAGE(X_SA(0, 1), a2, v1);
      X_WAIT_V(8); X_WAIT_L(0); X_BAR; X_MMA(0, 0, At, B0); X_MMA(0, 1, At, B1); X_BAR; X_SCHED;
      X_LDA(At, 1, 1); X_STAGE(X_SB(1, 0), b3, voffB); X_STAGE(X_SB(1, 1), b3 + hstepB, voffB); X_STAGE(X_SA(1, 0), a3, v0);
      X_WAIT_V(8); X_WAIT_L(0); X_BAR; X_MMA(1, 0, At, B0); X_MMA(1, 1, At, B1); X_BAR; X_SCHED;
    }
    if (wr == 0) X_BAR;
    E(acc, cur, wr, wc, fr, fq);
    if (!has_next) break;
#pragma unroll
    for (int a = 0; a < 2; ++a)
#pragma unroll
      for (int b = 0; b < 2; ++b)
#pragma unroll
        for (int m = 0; m < 4; ++m)
#pragma unroll
          for (int n = 0; n < 2; ++n) acc[a][b][m][n] = (f32x4){0.f, 0.f, 0.f, 0.f};
    cur = nxt; cA = nA; cB = nB; ++ui;
#pragma unroll
    for (int h = 0; h < 2; ++h)
#pragma unroll
      for (int i = 0; i < 2; ++i) vAc[h][i] = vAn[h][i];
    if (wr == 1) X_BAR;
  }
  X_WAIT_V(0);
  X_BAR;
#undef X_SA
#undef X_SB
#undef X_STAGE
#undef X_LDA
#undef X_LDB
#undef X_MMA
#undef X_WAIT_V
#undef X_WAIT_L
#undef X_BAR
#undef X_SCHED
#undef X_SETV
}

constexpr int MOE_MAXT = 131072 / 256 + 64;
constexpr size_t wl_al(size_t x) { return (x + 255) & ~(size_t)255; }
struct WL {
  static constexpr int NSLOT = (MOE_MAXT + 64) * 256;
  static constexpr int NSLOT_R = MOE_MAXT * 256;
  static constexpr size_t WGU_E = (size_t)512 * D, WD_E = (size_t)D * DE;
  static constexpr size_t KSTRIDE = (size_t)16640 * 512;
  static constexpr size_t o_ropetab = 65536;
  static constexpr size_t o_st0 = o_ropetab + wl_al((size_t)TP * 16 * 4);
  static constexpr size_t o_ridx = o_st0 + wl_al((size_t)NROWS * 8);
  static constexpr size_t o_rw = o_ridx + wl_al((size_t)NR * TOPE * 4);
  static constexpr size_t o_slotof = o_rw + wl_al((size_t)NR * TOPE * 4);
  static constexpr size_t o_bcnt = o_slotof + wl_al((size_t)NR * TOPE * 4);
  static constexpr size_t o_wrT = o_bcnt + wl_al((size_t)1024 * NE * 4);
  static constexpr size_t o_tokmap = o_wrT + wl_al((size_t)2 * NE * D * 2);
  static constexpr size_t o_wslot = o_tokmap + wl_al((size_t)NSLOT * 4);
  static constexpr size_t o_WdT = o_wslot + wl_al((size_t)NSLOT * 4);
  static constexpr size_t o_zone = o_WdT + wl_al((size_t)(NE + 1) * WD_E * 2);
  static constexpr size_t o_maskb = o_zone;
  static constexpr size_t o_WinT = o_maskb + wl_al((size_t)NR * MPW * 4);
  static constexpr size_t o_WoutT = o_WinT + wl_al((size_t)3328 * D * 2);
  static constexpr size_t o_regionE = o_WoutT + wl_al((size_t)D * D * 2);
  static constexpr size_t o_kiF = o_regionE + wl_al((size_t)(NE + 1) * WGU_E * 2);
  static constexpr size_t o_qlin = o_kiF + wl_al((size_t)NROWS * 64 * 2);
  static constexpr size_t o_wq = o_qlin + wl_al((size_t)NR * 64 * 2);
  static constexpr size_t o_zone_used = o_wq + wl_al((size_t)NR * 8 * 4);
  static constexpr size_t o_ub = (o_zone_used > o_zone + (size_t)NSLOT_R * D ? o_zone_used : o_zone + wl_al((size_t)NSLOT_R * D));
  static constexpr size_t o_qb = o_ub + wl_al((size_t)NROWS * 512 * 2);
  static constexpr size_t o_kiw = o_qb + wl_al(KSTRIDE * 2 * 4);
  static constexpr size_t o_end = o_kiw + wl_al((size_t)NROWS * KIW * 4);
};
static_assert(WL::o_end <= (size_t)289000000, "workspace budget");
static_assert((size_t)WL::NSLOT * 256 * 2 <= WL::o_end - WL::o_ub && (size_t)NR * D * 4 <= WL::o_end - WL::o_ub && WL::o_zone_used <= WL::o_ub, "overlays fit");
template <int NN, int K, size_t BOFF, size_t BSTRIDE_B, size_t AOFF, int E_LO, int E_HI>
struct MoeSched {
  const unsigned char* ws; const int* tstart; int G, c;
  __device__ __forceinline__ bool next(int i, XUnit& u) const {
    const int vcu = (G % 8 == 0) ? (c % 8) * (G / 8) + c / 8 : c;
    const int L = i * G + vcu, t0 = __builtin_amdgcn_readfirstlane(tstart[E_LO]), total = (__builtin_amdgcn_readfirstlane(tstart[E_HI]) - t0) * NN; if (L >= total) return false;
    const int tile = t0 + L / NN;
    int e = E_LO;
#pragma unroll 1
    while (tstart[e + 1] <= tile) ++e;
    u.e = __builtin_amdgcn_readfirstlane(e); u.pn = __builtin_amdgcn_readfirstlane(L % NN); u.pm = __builtin_amdgcn_readfirstlane(tile); return true;
  }
  __device__ __forceinline__ const bf16_t* b_ptr(const XUnit& u) const { return (const bf16_t*)(ws + BOFF + (size_t)u.e * BSTRIDE_B) + (size_t)u.pn * 256 * K; }
  __device__ __forceinline__ const bf16_t* a_ptr(const XUnit& u) const { return (const bf16_t*)(ws + AOFF) + (size_t)u.pm * 256 * K; }
  __device__ __forceinline__ const int* rows(const XUnit& u) const { return (const int*)(ws + WL::o_tokmap) + u.pm * 256; }
};
struct EpiGateUp {
  static constexpr bool PERM = false;
  unsigned char* ws;
  __device__ __forceinline__ void operator()(const pg8::f32x4 (&acc)[2][2][4][2], const XUnit& u, int wr, int wc, int fr, int fq) const {
#pragma unroll
    for (int ai = 0; ai < 2; ++ai)
#pragma unroll
      for (int m = 0; m < 4; ++m) {
        const size_t slot = (size_t)u.pm * 256 + ai * 128 + wr * 64 + m * 16 + fr;
#pragma unroll
        for (int n = 0; n < 2; ++n) {
          const pg8::f32x4 g = acc[ai][0][m][n], up = acc[ai][1][m][n]; float o[4];
#pragma unroll
          for (int j = 0; j < 4; ++j) o[j] = g[j] / (1.0f + __expf(-g[j])) * up[j];
          *(uint2*)((bf16_t*)(ws + WL::o_ub) + slot * DE + u.pn * 128 + wc * 32 + n * 16 + 4 * fq) = make_uint2(pk2(o[0], o[1]), pk2(o[2], o[3]));
        }
      }
  }
};
constexpr float YSCALE = 64.0f;
constexpr int H1P = 2 * D;
struct EpiDownY {
  static constexpr bool PERM = true;
  unsigned char* ws;
  __device__ __forceinline__ void operator()(const pg8::f32x4 (&acc)[2][2][4][2], const XUnit& u, int wr, int wc, int fr, int fq) const {
#pragma unroll
    for (int ai = 0; ai < 2; ++ai)
#pragma unroll
      for (int m = 0; m < 4; ++m) {
        const int slot = u.pm * 256 + ai * 128 + wr * 64 + m * 16 + fr;
        const int col = u.pn * 256 + wc * 32 + 8 * fq;
        const float w = ((const float*)(ws + WL::o_wslot))[slot] * YSCALE;
#pragma unroll
        for (int bj = 0; bj < 2; ++bj) {
          const pg8::f32x4 v0 = acc[ai][bj][m][0] * w, v1 = acc[ai][bj][m][1] * w;
          int lo = 0, hi = 0;
          lo = __builtin_amdgcn_cvt_pk_fp8_f32(v0[0], v0[1], lo, false); lo = __builtin_amdgcn_cvt_pk_fp8_f32(v0[2], v0[3], lo, true);
          hi = __builtin_amdgcn_cvt_pk_fp8_f32(v1[0], v1[1], hi, false); hi = __builtin_amdgcn_cvt_pk_fp8_f32(v1[2], v1[3], hi, true);
          *(uint2*)(ws + WL::o_zone + (size_t)slot * D + col + bj * 128) = make_uint2((unsigned)lo, (unsigned)hi);
        }
      }
  }
};
struct EpiDownS {
  static constexpr bool PERM = true;
  bf16_t* orow; int tile0;
  __device__ __forceinline__ void operator()(const pg8::f32x4 (&acc)[2][2][4][2], const XUnit& u, int wr, int wc, int fr, int fq) const {
#pragma unroll
    for (int ai = 0; ai < 2; ++ai)
#pragma unroll
      for (int m = 0; m < 4; ++m) {
        const int tok = (u.pm - tile0) * 256 + ai * 128 + wr * 64 + m * 16 + fr;
        bf16_t* dst = orow + (size_t)tok * H1P + D + u.pn * 256 + wc * 32 + 8 * fq;
#pragma unroll
        for (int bj = 0; bj < 2; ++bj) {
          const pg8::f32x4 v0 = acc[ai][bj][m][0], v1 = acc[ai][bj][m][1];
          *(uint4*)(dst + bj * 128) = make_uint4(pk2(v0[0], v0[1]), pk2(v0[2], v0[3]), pk2(v1[0], v1[1]), pk2(v1[2], v1[3]));
        }
      }
  }
};

typedef _Float16 f16x8 __attribute__((ext_vector_type(8)));
__device__ __forceinline__ void pk_cnt_gt(unsigned& acc, unsigned x, unsigned tm1, unsigned ones) {
  unsigned d;
  asm("v_pk_sub_u16 %0, %2, %3 clamp\n\tv_pk_min_u16 %0, %0, %4\n\tv_pk_add_u16 %1, %1, %0" : "=&v"(d), "+v"(acc) : "v"(x), "v"(tm1), "s"(ones));
}

constexpr int NTHR = 512, NWAVES = 8;
constexpr int LDS_BYTES = 147456;
constexpr int MISC_OFF = 131072 + 8192;
constexpr size_t CTL_BYTES = 65536;

struct Args {
  const float *x, *meta, *ln_emb_g, *ln_emb_b, *w_in, *conv_w, *conv_b, *lnc_g, *lnc_b, *lnk_g, *lnk_b, *w_out, *ln1_g, *ln1_b, *w_router, *r_bias,
              *w_gate, *w_up, *w_down, *ws_gate, *ws_up, *ws_down, *ln2_g, *ln2_b;
  float* out; unsigned char* ws;
  float ropeinv[8];
};

__device__ __forceinline__ unsigned fkey(float f) { unsigned u = __float_as_uint(f); return (u & 0x80000000u) ? ~u : (u | 0x80000000u); }

__global__ void __launch_bounds__(NTHR, 2) mega_fwd(Args a) {
  extern __shared__ __attribute__((aligned(16))) unsigned char lds_raw[];
  float* lds = (float*)lds_raw;
  const int G = gridDim.x, bid = blockIdx.x, NGW = G * NWAVES;
#define tst ((int*)(lds_raw + MISC_OFF + 256))
#define PHASE_IDS int tid = threadIdx.x; asm volatile("" : "+v"(tid)); const int lane = tid & 63, wave = __builtin_amdgcn_readfirstlane(tid >> 6), gw = bid * NWAVES + wave; (void)lane; (void)wave; (void)gw;
#define WSP(T, O) ((T*)(a.ws + (O)))
#define barw    WSP(unsigned, 0)
#define ecnt    WSP(int, 16384)
#define ecur    WSP(int, 16384 + 256)
#define ropetab WSP(float, WL::o_ropetab)
#define st0     WSP(float2, WL::o_st0)
#define maskb   WSP(unsigned, WL::o_maskb)
#define ridx    WSP(int, WL::o_ridx)
#define rw      WSP(float, WL::o_rw)
#define slotof  WSP(int, WL::o_slotof)
#define bcnt    WSP(int, WL::o_bcnt)
#define wrT     WSP(bf16_t, WL::o_wrT)
#define tokmap  WSP(int, WL::o_tokmap)
#define wslot   WSP(float, WL::o_wslot)
#define WinT    WSP(bf16_t, WL::o_WinT)
#define WoutT   WSP(bf16_t, WL::o_WoutT)
#define h0b     WSP(bf16_t, WL::o_regionE)
#define mixb    WSP(bf16_t, WL::o_regionE)
#define WguT    WSP(bf16_t, WL::o_regionE)
#define WdT     WSP(bf16_t, WL::o_WdT)
#define y8      WSP(unsigned char, WL::o_zone)
#define kiF     WSP(unsigned short, WL::o_kiF)
#define qlin    WSP(unsigned short, WL::o_qlin)
#define wq      WSP(float, WL::o_wq)
#define h1b     ((bf16_t*)a.out)
#define ub      WSP(bf16_t, WL::o_ub)
#define qb      WSP(bf16_t, WL::o_qb)
#define kb      WSP(bf16_t, WL::o_qb + WL::KSTRIDE * 2)
#define vb      WSP(bf16_t, WL::o_qb + WL::KSTRIDE * 4)
#define qih     WSP(unsigned short, WL::o_qb + WL::KSTRIDE * 6)
#define kiw     WSP(float, WL::o_kiw)
#define tmp     WSP(float, WL::o_ub)
#define hdn     WSP(bf16_t, WL::o_ub)
  constexpr size_t WGU_E = WL::WGU_E, WD_E = WL::WD_E, KSTRIDE = WL::KSTRIDE;
  float* const out = a.out;

  volatile LAS unsigned* misc = (volatile LAS unsigned*)((LAS unsigned char*)lds_raw + MISC_OFF);
  if (threadIdx.x < 16) misc[threadIdx.x] = 0u;
  __syncthreads();
  XcdBarrier bar = xcd_barrier_post(barw, misc);

  { PHASE_IDS
  {
    for (int i = bid * NTHR + tid; i < TP * 8; i += G * NTHR) {
      const int t = i >> 3, j = i & 7; float sn, cs; sincosf((float)t * a.ropeinv[j], &sn, &cs);
      ropetab[t * 16 + j] = cs; ropetab[t * 16 + 8 + j] = sn;
    }
    for (int i = bid * NTHR + tid; i < 2 * 2 * KVOFF * 64; i += G * NTHR) {
      const int c16 = i & 63, rr = (i >> 6) % KVOFF, bb = ((i >> 6) / KVOFF) & 1, kv = (i >> 6) / (2 * KVOFF);
      *(uint4*)((kv ? vb : kb) + ((size_t)bb * KVROWS + rr) * 512 + c16 * 8) = make_uint4(0u, 0u, 0u, 0u);
    }
    for (int m = gw; m < NROWS; m += NGW) {
      const float* src = m < NR ? a.x + (size_t)m * D : a.meta + (size_t)((m - NR) & 15) * D;
      float v[16]; float s = 0.f;
#pragma unroll
      for (int i = 0; i < 16; ++i) { v[i] = src[i * 64 + lane]; s += v[i]; }
      const float mu = wave_sum(s) * (1.0f / D);
      float q = 0.f;
#pragma unroll
      for (int i = 0; i < 16; ++i) { const float d = v[i] - mu; q += d * d; }
      const float rstd = rsqrtf(wave_sum(q) * (1.0f / D) + LN_EPS);
#pragma unroll
      for (int i = 0; i < 16; ++i) { const int c = i * 64 + lane; h0b[(size_t)m * D + c] = (bf16_t)f2bf((v[i] - mu) * rstd * a.ln_emb_g[c] + a.ln_emb_b[c]); }
      if (lane == 0) st0[m] = make_float2(mu, rstd);
    }
    for (int i = bid * NTHR + tid; i < NE * D; i += G * NTHR) {
      const int e = i & (NE - 1), k = i >> 6; const float w = a.w_router[i];
      const unsigned hb = f2bf(w); const float lo = w - __uint_as_float(hb << 16);
      wrT[(size_t)e * D + k] = (bf16_t)hb; wrT[(size_t)(NE + e) * D + k] = (bf16_t)f2bf(lo);
    }
    {
      float* scr = lds + wave * 2304;
      constexpr int NB_IN = (IN_W + 31) / 32, I_IN = (D / 64) * NB_IN, I_OUT = (D / 64) * (D / 32);
      for (int it = gw; it < I_IN + I_OUT; it += NGW) {
        if (it < I_IN) { const int kb_ = it / NB_IN, nb = it % NB_IN; transpose_item(a.w_in, D, IN_W, WinT, D, scr, 64 * kb_, 32 * nb, winT_row(32 * nb), lane); }
        else { const int r = it - I_IN, kb_ = r / (D / 32), nb = r % (D / 32); transpose_item(a.w_out, D, D, WoutT, D, scr, 64 * kb_, 32 * nb, 32 * nb, lane); }
      }
    }
  }
  }
  xcd_barrier(bar);
  { PHASE_IDS
  {
    pg8::Gemm g{h0b, WinT, 16640, 3328, D}; pg8::StaticOrder S; S.init(16640, 3328, G, bid);
    EpiInProj E{ub, qb, KSTRIDE, kiw, ropetab};
    pg8::gemm_phase<EpiInProj, pg8::StaticOrder, true, true>((PG8_LAS unsigned char*)lds_raw, g, S, E);
  }
  }
  xcd_barrier(bar);
  { PHASE_IDS
  for (int m = gw; m < NROWS; m += NGW) {
    const int t = m < NR ? (m & (SEQ - 1)) + NMETA : ((m - NR) & 15);
    const float xk = kiw[(size_t)m * KIW + lane];
    const float mu = wave_sum(xk) * (1.0f / IDD), dv = xk - mu;
    const float rstd = rsqrtf(wave_sum(dv * dv) * (1.0f / IDD) + LN_EPS);
    float y = dv * rstd * a.lnk_g[lane] + a.lnk_b[lane];
    const float p = __shfl_xor(y, 8);
    if (lane < 16) { const float cs = ropetab[t * 16 + (lane & 7)], sn = ropetab[t * 16 + 8 + (lane & 7)]; y = lane < 8 ? y * cs - p * sn : y * cs + p * sn; }
    kiF[(size_t)m * 64 + lane] = f2h(y);
    if (m < NR) {
      float wl = 0.f;
      if (lane < 8) { wl = kiw[(size_t)m * KIW + 64 + lane] * (0.35355339059327373f * 0.125f * 0.5f); wq[(size_t)m * 8 + lane] = wl; }
      float ql = 0.f;
#pragma unroll
      for (int h = 0; h < IH; ++h) ql += __shfl(wl, h) * h2f(qih[(size_t)m * 512 + h * 64 + lane]);
      qlin[(size_t)m * 64 + lane] = f2h(ql);
    }
  }
  }
  { PHASE_IDS
  for (int tile = bid; tile < NR / 32; tile += G) {
    const int m0 = tile * 32, b = m0 >> 13, s0 = m0 & (SEQ - 1);
    bf16_t* ubuf = (bf16_t*)lds_raw;
    float* res = (float*)(lds_raw + 65536);
    __syncthreads();
    for (int i = tid; i < 62 * 64; i += NTHR) {
      const int rr = i >> 6, cc = i & 63, s = s0 - 30 + rr, t = s + NMETA;
      uint4 v = make_uint4(0u, 0u, 0u, 0u);
      if (t >= 0) { const int row = t < NMETA ? NR + b * NMETA + t : b * SEQ + s; v = *(const uint4*)(ub + (size_t)row * 512 + cc * 8); }
      *(uint4*)(ubuf + rr * 512 + cc * 8) = v;
    }
    __syncthreads();
    {
      const int hf = tid >> 8, cp = tid & 255;
      float cw0[CONV_W], cw1[CONV_W];
#pragma unroll
      for (int w = 0; w < CONV_W; ++w) { const float2 c2 = *(const float2*)(a.conv_w + w * CONV_CH + 2 * cp); cw0[w] = c2.x; cw1[w] = c2.y; }
      const float2 cb = *(const float2*)(a.conv_b + 2 * cp);
#pragma unroll 1
      for (int rr = 0; rr < 16; ++rr) {
        const int r = hf * 16 + rr; float a0 = cb.x, a1 = cb.y;
#pragma unroll
        for (int w = 0; w < CONV_W; ++w) { const unsigned pr = *(const unsigned*)(ubuf + (r + w) * 512 + 2 * cp); a0 += cw0[w] * bflo(pr); a1 += cw1[w] * bfhi(pr); }
        *(float2*)(res + r * 512 + 2 * cp) = make_float2(a0, a1);
      }
    }
    __syncthreads();
#pragma unroll 1
    for (int rr = 0; rr < 4; ++rr) {
      const int r = wave + 8 * rr; float v[8]; float s = 0.f;
#pragma unroll
      for (int j = 0; j < 8; ++j) { v[j] = res[r * 512 + j * 64 + lane]; s += v[j]; }
      const float mu = wave_sum(s) * (1.0f / CONV_CH); float q = 0.f;
#pragma unroll
      for (int j = 0; j < 8; ++j) { v[j] -= mu; q += v[j] * v[j]; }
      const float rstd = rsqrtf(wave_sum(q) * (1.0f / CONV_CH) + LN_EPS);
#pragma unroll
      for (int j = 0; j < 8; ++j) { const int c = j * 64 + lane; const float y = v[j] * rstd * a.lnc_g[c] + a.lnc_b[c]; mixb[(size_t)(m0 + r) * D + c] = (bf16_t)f2bf(y / (1.0f + __expf(-y))); }
    }
  }
  }
  xcd_barrier(bar);
  { PHASE_IDS
  {
    unsigned char* ql = lds_raw;
    int* cl = (int*)(lds_raw + 18432);
    int* tl = cl + 256;
    const int q = lane & 15, kg = lane >> 4;
    for (int pi = bid; pi < 512; pi += G)
#pragma unroll 1
      for (int hf = 0; hf < 2; ++hf) {
        const int blk = hf ? 1023 - pi : pi;
        const int m0 = blk * 16, b = m0 >> 13, s0 = m0 & (SEQ - 1), m = m0 + q;
        const int ntile = (s0 >> 4) + 2;
        const int nsl = (ntile + 7) >> 3;
        __syncthreads();
        if (wave == 0) {
#pragma unroll
          for (int h = 0; h < 9; ++h)
#pragma unroll
            for (int ks = 0; ks < 2; ++ks) {
              const unsigned short* src = h < 8 ? qih + (size_t)m * 512 + h * 64 + ks * 32 + kg * 8 : qlin + (size_t)m * 64 + ks * 32 + kg * 8;
              *(uint4*)(ql + ((h * 2 + ks) * 64 + lane) * 16) = *(const uint4*)src;
            }
        }
        float wv[8];
#pragma unroll
        for (int h = 0; h < 8; ++h) wv[h] = wq[(size_t)m * 8 + h];
        __syncthreads();
        unsigned sc[130];
#define LOADA(g_, x0, x1) do { const int krow_ = (g_) == 0 ? NR + 16 * b + q : b * SEQ + 16 * ((g_) - 1) + q; \
          x0 = *(const f16x8*)(kiF + (size_t)krow_ * 64 + kg * 8); x1 = *(const f16x8*)(kiF + (size_t)krow_ * 64 + 32 + kg * 8); } while (0)
        f16x8 na0 = {}, na1 = {};
        if (wave < ntile) LOADA(wave, na0, na1);
#pragma unroll
        for (int slot = 0; slot < 65; ++slot) {
          const int g = slot * 8 + wave;
          unsigned p0 = 0u, p1 = 0u;
          if (g < ntile) {
            const f16x8 a0 = na0, a1 = na1;
            if (g + 8 < ntile) LOADA(g + 8, na0, na1);
            unsigned qo = (unsigned)lane * 16u; asm volatile("" : "+v"(qo));
            const unsigned char* qlp = ql + qo;
            pg8::f32x4 tv[9];
#pragma unroll
            for (int h = 0; h < 9; ++h) tv[h] = __builtin_amdgcn_mfma_f32_16x16x32_f16(a0, *(const f16x8*)(qlp + (h * 2 + 0) * 1024), (pg8::f32x4){0.f, 0.f, 0.f, 0.f}, 0, 0, 0);
#pragma unroll
            for (int h = 0; h < 9; ++h) tv[h] = __builtin_amdgcn_mfma_f32_16x16x32_f16(a1, *(const f16x8*)(qlp + (h * 2 + 1) * 1024), tv[h], 0, 0, 0);
            pg8::f32x4 sv = tv[8];
#pragma unroll
            for (int h = 0; h < 8; ++h)
#pragma unroll
              for (int r = 0; r < 4; ++r) sv[r] = fmaf(fabsf(tv[h][r]), wv[h], sv[r]);
            unsigned h01 = __builtin_bit_cast(unsigned, __builtin_amdgcn_cvt_pkrtz(sv[0], sv[1])), h23 = __builtin_bit_cast(unsigned, __builtin_amdgcn_cvt_pkrtz(sv[2], sv[3]));
            h01 ^= (((h01 >> 15) & 0x00010001u) * 0x7FFFu) | 0x80008000u;
            h23 ^= (((h23 >> 15) & 0x00010001u) * 0x7FFFu) | 0x80008000u;
            if (g == ntile - 1) {
              const int lim = q - 4 * kg;
              h01 &= (lim >= 0 ? 0x0000FFFFu : 0u) | (lim >= 1 ? 0xFFFF0000u : 0u);
              h23 &= (lim >= 2 ? 0x0000FFFFu : 0u) | (lim >= 3 ? 0xFFFF0000u : 0u);
            }
            p0 = h01; p1 = h23;
          }
          sc[2 * slot] = p0; sc[2 * slot + 1] = p1;
        }
#undef LOADA
        unsigned lo = 0u; int par = 0; const unsigned ones16 = 0x00010001u;
#define CNT_GE(dst, T1) do { const unsigned tm_ = (unsigned)(T1) * 0x00010001u; unsigned ac_ = 0u; \
          _Pragma("unroll") for (int gp = 0; gp < 9; ++gp) if (gp * 8 < nsl) { _Pragma("unroll") for (int i = gp * 16; i < (gp == 8 ? 130 : gp * 16 + 16); ++i) pk_cnt_gt(ac_, sc[i], tm_, ones16); } \
          dst = (int)((ac_ & 0xffffu) + (ac_ >> 16)); } while (0)
#pragma unroll 1
        for (int bit = 15; bit >= 0; --bit) {
          const unsigned cand = lo | (1u << bit);
          int c0; CNT_GE(c0, cand - 1u);
          c0 += __shfl_xor(c0, 16); c0 += __shfl_xor(c0, 32);
          if (kg == 0) cl[(par * 8 + wave) * 16 + q] = c0;
          __syncthreads();
          int tot = 0;
#pragma unroll
          for (int w = 0; w < 8; ++w) tot += cl[(par * 8 + w) * 16 + q];
          if (tot >= TOPK) lo = cand;
          par ^= 1;
        }
        const unsigned T = lo;
        int cge = 0, cgt = 0;
        if (T > 0u) { CNT_GE(cge, T - 1u); }
        if (T < 0xFFFFu) { CNT_GE(cgt, T); }
        if (T == 0u) cge = cgt;
        const int eq = cge - cgt;
        int e0 = __shfl(eq, q), e1 = __shfl(eq, q + 16), e2 = __shfl(eq, q + 32), e3 = __shfl(eq, q + 48);
        int g4 = cgt; g4 += __shfl_xor(g4, 16); g4 += __shfl_xor(g4, 32);
        const int pre_l = (kg > 0 ? e0 : 0) + (kg > 1 ? e1 : 0) + (kg > 2 ? e2 : 0);
        if (kg == 0) { tl[wave * 16 + q] = e0 + e1 + e2 + e3; cl[(par * 8 + wave) * 16 + q] = g4; }
        __syncthreads();
        int totgt = 0, prew = 0;
#pragma unroll
        for (int w = 0; w < 8; ++w) { totgt += cl[(par * 8 + w) * 16 + q]; prew += (w < wave) ? tl[w * 16 + q] : 0; }
        par ^= 1;
        const int need = T > 0u ? TOPK - totgt : 0;
        const int budget = min(max(need - (prew + pre_l), 0), eq);
        int tc = 0;
        unsigned short* mrow = (unsigned short*)maskb + ((size_t)(m >> 5) * MASKNT * 32 + (m & 31)) * 4;
#pragma unroll
        for (int slot = 0; slot < 65; ++slot) {
          const unsigned p0 = sc[2 * slot], p1 = sc[2 * slot + 1];
          unsigned nib = 0u;
          if (slot < nsl) {
            const unsigned v0 = p0 & 0xffffu, v1 = p0 >> 16, v2 = p1 & 0xffffu, v3 = p1 >> 16;
            bool e;
            e = v0 == T; nib |= ((v0 > T) | (e & (tc < budget))) ? 1u : 0u; tc += e ? 1 : 0;
            e = v1 == T; nib |= ((v1 > T) | (e & (tc < budget))) ? 2u : 0u; tc += e ? 1 : 0;
            e = v2 == T; nib |= ((v2 > T) | (e & (tc < budget))) ? 4u : 0u; tc += e ? 1 : 0;
            e = v3 == T; nib |= ((v3 > T) | (e & (tc < budget))) ? 8u : 0u; tc += e ? 1 : 0;
            nib <<= 4 * kg;
            nib |= __shfl_xor(nib, 16); nib |= __shfl_xor(nib, 32);
          }
          if (kg == 0) { const int hwi = slot * 8 + wave + KVOFF / 16; mrow[(size_t)(hwi >> 2) * 128 + (hwi & 3)] = (unsigned short)nib; }
        }
        if (wave == 0 && kg == 0) {
#pragma unroll
          for (int i = 0; i < KVOFF / 16; ++i) mrow[(size_t)(i >> 2) * 128 + (i & 3)] = 0;
        }
#undef CNT_GE
      }
  }
  }
  xcd_barrier(bar);
  { PHASE_IDS
  {
    const attn_body::AttnTensors AT{(const attn_body::bf16*)qb, (const attn_body::bf16*)kb, (const attn_body::bf16*)vb, (attn_body::bf16*)(mixb + CONV_CH), maskb};
    const attn_body::StaticOrder S(G, bid);
    attn_body::attn_phase<attn_body::StaticOrder>((char*)lds_raw, AT, S);
  }
  }
  xcd_barrier(bar);
  { PHASE_IDS
  {
    pg8::Gemm g{mixb, WoutT, NR, D, D}; pg8::StaticOrder S; S.init(NR, D, G, bid);
    EpiF32 E{tmp, D, NR, D};
    pg8::gemm_phase<EpiF32, pg8::StaticOrder, true, true>((PG8_LAS unsigned char*)lds_raw, g, S, E);
  }
  }
  xcd_barrier(bar);
  { PHASE_IDS
  {
    float* scr = lds + wave * 2304;
    for (int it = gw; it < (NE + 1) * 384; it += NGW) {
      const int e = it / 384, r = it % 384, which = r >> 7, q = r & 127;
      if (which < 2) {
        const float* W = e < NE ? (which ? a.w_up : a.w_gate) + (size_t)e * D * DE : (which ? a.ws_up : a.ws_gate);
        const int kb_ = q >> 3, nb = q & 7, n0 = 32 * nb;
        transpose_item(W, D, DE, WguT + (size_t)e * WGU_E, D, scr, 64 * kb_, n0, (n0 >> 7) * 256 + which * 128 + (n0 & 127), lane);
      } else {
        const float* W = e < NE ? a.w_down + (size_t)e * DE * D : a.ws_down;
        const int kb_ = q >> 5, nb = q & 31;
        transpose_item(W, DE, D, WdT + (size_t)e * WD_E, DE, scr, 64 * kb_, 32 * nb, 32 * nb, lane);
      }
    }
  }
  {
    constexpr int APITCH = 2048 + 16;
    unsigned char* ahi = lds_raw;
    unsigned char* alo = lds_raw + 16 * APITCH;
    float* red = (float*)(lds_raw + 2 * 16 * APITCH);
    int* lcnt = (int*)(red + 8 * 16 * 64);
    if (tid < NE) lcnt[tid] = 0;
    pg8::bf16x8 bh[4][4], bl[4][4];
    {
      const int col = lane & 15, kq = lane >> 4;
#pragma unroll
      for (int ks = 0; ks < 4; ++ks)
#pragma unroll
        for (int nt = 0; nt < 4; ++nt) {
          const size_t o = (size_t)(16 * nt + col) * D + 128 * wave + 32 * ks + 8 * kq;
          bh[ks][nt] = *(const pg8::bf16x8*)(wrT + o); bl[ks][nt] = *(const pg8::bf16x8*)(wrT + (size_t)NE * D + o);
        }
    }
    const float rb = a.r_bias[lane];
    for (int task = bid; task < NR / 16; task += G) {
      __syncthreads();
#pragma unroll 1
      for (int rr = 0; rr < 2; ++rr) {
        const int lr = 2 * wave + rr, m = task * 16 + lr;
        const float2 st = st0[m];
        float v[16]; float sum = 0.f;
#pragma unroll
        for (int j = 0; j < 4; ++j) {
          const int c = j * 256 + lane * 4;
          const float4 xv = *(const float4*)(a.x + (size_t)m * D + c), tv = *(const float4*)(tmp + (size_t)m * D + c), eg = *(const float4*)(a.ln_emb_g + c), eb = *(const float4*)(a.ln_emb_b + c);
          v[4 * j + 0] = DN_ALPHA * ((xv.x - st.x) * st.y * eg.x + eb.x) + tv.x; v[4 * j + 1] = DN_ALPHA * ((xv.y - st.x) * st.y * eg.y + eb.y) + tv.y;
          v[4 * j + 2] = DN_ALPHA * ((xv.z - st.x) * st.y * eg.z + eb.z) + tv.z; v[4 * j + 3] = DN_ALPHA * ((xv.w - st.x) * st.y * eg.w + eb.w) + tv.w;
          sum += (v[4 * j] + v[4 * j + 1]) + (v[4 * j + 2] + v[4 * j + 3]);
        }
        const float mu = wave_sum(sum) * (1.0f / D);
        float q = 0.f;
#pragma unroll
        for (int i = 0; i < 16; ++i) { v[i] -= mu; q += v[i] * v[i]; }
        const float rstd = rsqrtf(wave_sum(q) * (1.0f / D) + LN_EPS);
#pragma unroll
        for (int j = 0; j < 4; ++j) {
          const int c = j * 256 + lane * 4;
          const float4 g4 = *(const float4*)(a.ln1_g + c), b4 = *(const float4*)(a.ln1_b + c);
          const float y0 = v[4 * j] * rstd * g4.x + b4.x, y1 = v[4 * j + 1] * rstd * g4.y + b4.y, y2 = v[4 * j + 2] * rstd * g4.z + b4.z, y3 = v[4 * j + 3] * rstd * g4.w + b4.w;
          const unsigned h0 = f2bf(y0), h1_ = f2bf(y1), h2 = f2bf(y2), h3 = f2bf(y3);
          const uint2 hi2 = make_uint2(h0 | (h1_ << 16), h2 | (h3 << 16));
          const uint2 lo2 = make_uint2(pk2(y0 - __uint_as_float(h0 << 16), y1 - __uint_as_float(h1_ << 16)), pk2(y2 - __uint_as_float(h2 << 16), y3 - __uint_as_float(h3 << 16)));
          *(uint2*)(h1b + (size_t)m * H1P + c) = hi2;
          *(uint2*)(ahi + lr * APITCH + c * 2) = hi2; *(uint2*)(alo + lr * APITCH + c * 2) = lo2;
        }
      }
      __syncthreads();
      {
        const int row = lane & 15, kq = lane >> 4;
        pg8::f32x4 acc[4];
#pragma unroll
        for (int nt = 0; nt < 4; ++nt) acc[nt] = (pg8::f32x4){0.f, 0.f, 0.f, 0.f};
#pragma unroll
        for (int ks = 0; ks < 4; ++ks) {
          const int kb_ = (128 * wave + 32 * ks + 8 * kq) * 2;
          const pg8::bf16x8 fh = *(const pg8::bf16x8*)(ahi + row * APITCH + kb_), fl = *(const pg8::bf16x8*)(alo + row * APITCH + kb_);
#pragma unroll
          for (int nt = 0; nt < 4; ++nt) {
            acc[nt] = __builtin_amdgcn_mfma_f32_16x16x32_bf16(fh, bh[ks][nt], acc[nt], 0, 0, 0);
            acc[nt] = __builtin_amdgcn_mfma_f32_16x16x32_bf16(fl, bh[ks][nt], acc[nt], 0, 0, 0);
            acc[nt] = __builtin_amdgcn_mfma_f32_16x16x32_bf16(fh, bl[ks][nt], acc[nt], 0, 0, 0);
          }
        }
#pragma unroll
        for (int nt = 0; nt < 4; ++nt)
#pragma unroll
          for (int r = 0; r < 4; ++r) red[(wave * 16 + 4 * kq + r) * 64 + 16 * nt + row] = acc[nt][r];
      }
      __syncthreads();
#pragma unroll 1
      for (int rr = 0; rr < 2; ++rr) {
        const int lr = 2 * wave + rr, m = task * 16 + lr;
        float lgt = 0.f;
#pragma unroll
        for (int w = 0; w < 8; ++w) lgt += red[(w * 16 + lr) * 64 + lane];
        const float score = sigmoidf_(lgt), biased = score + rb;
        float m1 = -INFINITY, m2 = -INFINITY;
        for (int j = 0; j < 8; ++j) { const float vv = __shfl(biased, (lane & ~7) + j); if (vv > m1) { m2 = m1; m1 = vv; } else if (vv > m2) m2 = vv; }
        const float gs = m1 + m2; const int g = lane >> 3;
        int grank = 0;
        for (int j = 0; j < 8; ++j) { const float vv = __shfl(gs, j * 8); grank += (vv > gs || (vv == gs && j < g)) ? 1 : 0; }
        const float val = grank < 4 ? biased : -INFINITY;
        int rank = 0;
        for (int j = 0; j < 64; ++j) { const float vv = __shfl(val, j); rank += (vv > val || (vv == val && j < lane)) ? 1 : 0; }
        const bool selq = rank < TOPE;
        const float ssum = wave_sum(selq ? score : 0.f);
        if (selq) { ridx[m * TOPE + rank] = lane; rw[m * TOPE + rank] = score / ssum * ROUTED_SCALE; atomicAdd(&lcnt[lane], 1); }
      }
    }
    __syncthreads();
    if (tid < NE) bcnt[bid * NE + tid] = lcnt[tid];
  }
  }
  xcd_barrier(bar);
  { PHASE_IDS
  {
    int* etot = (int*)lds_raw; int* eboff = etot + 64; int* lcur = eboff + 64;
    __syncthreads();
    if (tid < NE) { int tot = 0, mine = 0; for (int b2 = 0; b2 < G; ++b2) { const int c = bcnt[b2 * NE + tid]; mine += b2 < bid ? c : 0; tot += c; } etot[tid] = tot; eboff[tid] = mine; lcur[tid] = 0; }
    __syncthreads();
    if (tid == 0) { int aa = 0; for (int e = 0; e < NE; ++e) { tst[e] = aa; aa += (etot[e] + 255) >> 8; } tst[NE] = aa; tst[NE + 1] = aa + NR / 256; }
    __syncthreads();
    for (int task = bid; task < NR / 16; task += G)
      if (tid < 16 * TOPE) {
        const int i = task * 16 * TOPE + tid, e = ridx[i];
        const int p = tst[e] * 256 + eboff[e] + atomicAdd(&lcur[e], 1);
        tokmap[p] = i / TOPE; wslot[p] = rw[i]; slotof[i] = p;
      }
    for (int e = bid; e < NE; e += G) {
      const int lo = tst[e] * 256 + etot[e], hi = tst[e + 1] * 256;
      for (int p = lo + tid; p < hi; p += NTHR) { tokmap[p] = 0; wslot[p] = 0.f; }
    }
    const int sb = tst[NE] * 256;
    for (int i = bid * NTHR + tid; i < NR; i += G * NTHR) { tokmap[sb + i] = i; wslot[sb + i] = 1.0f; }
  }
  }
  xcd_barrier(bar);
  { PHASE_IDS
  {
    typedef MoeSched<2, D, WL::o_regionE, WL::WGU_E * 2, 0, 0, NE + 1> SchedGU;
    SchedGU S{a.ws, tst, G, bid};
    EpiGateUp E{a.ws};
    gemm_phase_x<EpiGateUp, SchedGU, true, D, (unsigned)(H1P * 2)>((PG8_LAS unsigned char*)lds_raw, h1b, S, E);
  }
  }
  xcd_barrier(bar);
  { PHASE_IDS
  {
    {
      typedef MoeSched<4, DE, WL::o_WdT, WL::WD_E * 2, WL::o_ub, 0, NE> SchedD;
      SchedD S{a.ws, tst, G, bid};
      EpiDownY E{a.ws};
      gemm_phase_x<EpiDownY, SchedD, false, DE, (unsigned)(DE * 2)>((PG8_LAS unsigned char*)lds_raw, nullptr, S, E);
    }
    {
      typedef MoeSched<4, DE, WL::o_WdT, WL::WD_E * 2, WL::o_ub, NE, NE + 1> SchedD;
      SchedD S{a.ws, tst, G, bid};
      EpiDownS E{h1b, __builtin_amdgcn_readfirstlane(tst[NE])};
      gemm_phase_x<EpiDownS, SchedD, false, DE, (unsigned)(DE * 2)>((PG8_LAS unsigned char*)lds_raw, nullptr, S, E);
    }
  }
  }
  xcd_barrier(bar);
  { PHASE_IDS
  for (int m = gw; m < NR; m += NGW) {
    const bf16_t* hrow = h1b + (size_t)m * H1P;
    float v[16];
#pragma unroll
    for (int j = 0; j < 4; ++j) {
      const int c = j * 256 + lane * 4;
      const uint2 hh = *(const uint2*)(hrow + c), ss = *(const uint2*)(hrow + D + c);
      v[4 * j + 0] = DN_ALPHA * bflo(hh.x) + bflo(ss.x); v[4 * j + 1] = DN_ALPHA * bfhi(hh.x) + bfhi(ss.x);
      v[4 * j + 2] = DN_ALPHA * bflo(hh.y) + bflo(ss.y); v[4 * j + 3] = DN_ALPHA * bfhi(hh.y) + bfhi(ss.y);
    }
    float racc[16];
#pragma unroll
    for (int i = 0; i < 16; ++i) racc[i] = 0.f;
#pragma unroll
    for (int k = 0; k < TOPE; ++k) {
      const unsigned char* yr = y8 + (size_t)slotof[m * TOPE + k] * D;
#pragma unroll
      for (int j = 0; j < 4; ++j) {
        const unsigned w = *(const unsigned*)(yr + j * 256 + lane * 4);
        const auto lo2 = __builtin_amdgcn_cvt_pk_f32_fp8((int)w, false), hi2 = __builtin_amdgcn_cvt_pk_f32_fp8((int)w, true);
        racc[4 * j + 0] += lo2[0]; racc[4 * j + 1] += lo2[1]; racc[4 * j + 2] += hi2[0]; racc[4 * j + 3] += hi2[1];
      }
    }
    float s = 0.f;
#pragma unroll
    for (int i = 0; i < 16; ++i) { v[i] += racc[i] * (1.0f / YSCALE); s += v[i]; }
    const float mu = wave_sum(s) * (1.0f / D);
    float q = 0.f;
#pragma unroll
    for (int i = 0; i < 16; ++i) { v[i] -= mu; q += v[i] * v[i]; }
    const float rstd = rsqrtf(wave_sum(q) * (1.0f / D) + LN_EPS);
#pragma unroll
    for (int j = 0; j < 4; ++j) {
      const int c = j * 256 + lane * 4;
      const float4 g4 = *(const float4*)(a.ln2_g + c), b4 = *(const float4*)(a.ln2_b + c);
      *(float4*)(out + (size_t)m * D + c) = make_float4(v[4 * j] * rstd * g4.x + b4.x, v[4 * j + 1] * rstd * g4.y + b4.y, v[4 * j + 2] * rstd * g4.z + b4.z, v[4 * j + 3] * rstd * g4.w + b4.w);
    }
  }
  }
}

extern "C" void kernel_launch(void* const* d_in, const int* in_sizes, int n_in, void* d_out, int out_size, void* d_ws, size_t ws_size, hipStream_t stream) {
  static int grid = 0;
  if (grid == 0) {
    int dev = 0, cus = 0, per_cu = 0;
    if (hipGetDevice(&dev) != hipSuccess || hipDeviceGetAttribute(&cus, hipDeviceAttributeMultiprocessorCount, dev) != hipSuccess) { fprintf(stderr, "kernel_launch: device query failed\n"); grid = -1; return; }
    if (hipFuncSetAttribute((const void*)mega_fwd, hipFuncAttributeMaxDynamicSharedMemorySize, LDS_BYTES) != hipSuccess) { fprintf(stderr, "kernel_launch: hipFuncSetAttribute failed\n"); grid = -1; return; }
    if (hipOccupancyMaxActiveBlocksPerMultiprocessor(&per_cu, (const void*)mega_fwd, NTHR, LDS_BYTES) != hipSuccess || per_cu < 1) { fprintf(stderr, "kernel_launch: occupancy query says %d\n", per_cu); }
    (void)hipGetLastError();
    grid = cus;
  }
  if (grid < 0) return;
  (void)in_sizes; (void)n_in; (void)out_size; (void)ws_size;
  if (hipMemsetAsync(d_ws, 0, CTL_BYTES, stream) != hipSuccess) { fprintf(stderr, "kernel_launch: memset failed\n"); return; }
  Args a{};
  const float** pp = (const float**)&a;
  for (int i = 0; i < 24; ++i) pp[i] = (const float*)d_in[i];
  a.out = (float*)d_out; a.ws = (unsigned char*)d_ws;
  for (int i = 0; i < 8; ++i) a.ropeinv[i] = (float)pow(500000.0, -2.0 * i / 16.0);
  hipLaunchKernelGGL(mega_fwd, dim3(grid), dim3(NTHR), LDS_BYTES, stream, a);
  const hipError_t le = hipPeekAtLastError();
  if (le != hipSuccess) fprintf(stderr, "kernel_launch: launch failed: %s\n", hipGetErrorName(le));
}
```
